# Optimizing an MI355X kernel written in HIP

```python
import math
import jax, jax.numpy as jnp
from jax import lax
import numpy as np

D_MODEL = 1024
BATCH = 4
SEQ = 8192
DEPTH = 2

MEM_LEN = 256
BLK = 128
EPS = 1e-6
A_HEADS = 8
A_HEAD_DIM = 64
A_PATTERNS = ((128, 1), (512, 4), (2048, 16))
B_CHANNELS = 512
B_CONV_WIDTH = 31
C_HEADS = 4
C_HEAD_DIM = 64
D_HEADS = 8
D_NOPE_DIM = 64
D_ROPE_DIM = 32
D_V_DIM = 64
D_Q_RANK = 384
D_KV_RANK = 256
ROPE_THETA = 10000.0
X_HEADS = 4
X_HEAD_DIM = 128
D_FF = 4 * D_MODEL

A_WIDTH = A_HEADS * A_HEAD_DIM
AB_IN = 3 * A_WIDTH + 2 * B_CHANNELS
AB_OUT = A_WIDTH + B_CHANNELS
C_WIDTH = C_HEADS * 2 * C_HEAD_DIM
CD_IN = 3 * C_WIDTH + D_Q_RANK + D_KV_RANK + D_ROPE_DIM
CD_OUT = C_WIDTH + D_HEADS * D_V_DIM
N_EVEN = (DEPTH + 1) // 2
N_ODD = DEPTH // 2

kernel_name = 'hybrid_dilated_conformer_diff_mla'


def rms_norm(x, g):
    x32 = x.astype(jnp.float32)
    y = x32 * lax.rsqrt(jnp.mean(x32 * x32, axis=-1, keepdims=True) + EPS)
    return (y * g.astype(jnp.float32)).astype(x.dtype)


def layer_norm(x, g, b):
    x32 = x.astype(jnp.float32)
    mu = jnp.mean(x32, axis=-1, keepdims=True)
    var = jnp.mean(jnp.square(x32 - mu), axis=-1, keepdims=True)
    y = (x32 - mu) * lax.rsqrt(var + EPS)
    return (y * g.astype(jnp.float32) + b.astype(jnp.float32)).astype(x.dtype)


def rope(x, positions):
    half = x.shape[-1] // 2
    inv_freq = ROPE_THETA ** (-jnp.arange(half, dtype=jnp.float32) / half)
    ang = positions.astype(jnp.float32)[..., None] * inv_freq
    cos, sin = jnp.cos(ang)[:, :, None, :], jnp.sin(ang)[:, :, None, :]
    x1, x2 = x[..., :half].astype(jnp.float32), x[..., half:].astype(jnp.float32)
    return jnp.concatenate([x1 * cos - x2 * sin, x2 * cos + x1 * sin], axis=-1).astype(x.dtype)


def dilated_window_attention(q, k, v, dilation, steps):
    B, S, H, Dh = q.shape
    assert steps <= BLK
    span = dilation * BLK
    s_pad = -(-S // span) * span
    n_blk = s_pad // span

    def to_sub(t):
        t = jnp.pad(t, ((0, 0), (0, s_pad - S), (0, 0), (0, 0)))
        return t.reshape(B, n_blk, BLK, dilation, H, Dh).transpose(0, 4, 3, 1, 2, 5)

    def with_prev(t):
        prev = jnp.pad(t, ((0, 0), (0, 0), (0, 0), (1, 0), (0, 0), (0, 0)))[:, :, :, :-1]
        return jnp.concatenate([prev, t], axis=4)

    qs = to_sub(q)
    kb, vb = with_prev(to_sub(k)), with_prev(to_sub(v))
    s = jnp.einsum('bhrnqd,bhrnkd->bhrnqk', qs, kb).astype(jnp.float32) * (Dh ** -0.5)
    qi = jnp.arange(BLK)[:, None]
    kj = jnp.arange(2 * BLK)[None, :]
    dist = qi + BLK - kj
    blk = jnp.arange(n_blk)[:, None, None]
    valid = (dist >= 0) & (dist <= steps) & (blk * BLK + kj >= BLK)
    s = jnp.where(valid, s, -jnp.inf)
    lse = jax.nn.logsumexp(s, axis=-1)
    p = jnp.exp(s - lse[..., None]).astype(v.dtype)
    o = jnp.einsum('bhrnqk,bhrnkd->bhrnqd', p, vb)
    o = o.transpose(0, 3, 4, 2, 1, 5).reshape(B, s_pad, H, Dh)[:, :S]
    lse = lse.transpose(0, 3, 4, 2, 1).reshape(B, s_pad, H)[:, :S]
    return o, lse


def dilated_mixture_attention(q, k, v):
    outs, lses = [], []
    for window, dilation in A_PATTERNS:
        o, l = dilated_window_attention(q, k, v, dilation, window // dilation)
        outs.append(o)
        lses.append(l)
    w = jax.nn.softmax(jnp.stack(lses), axis=0)
    return jnp.einsum('gbsh,gbshd->bshd', w, jnp.stack(outs).astype(jnp.float32)).astype(q.dtype)


def causal_attention(q, k, v, scale):
    B, H, S, Dk = q.shape
    Dv = v.shape[-1]
    nb = S // BLK
    qb = q.reshape(B, H, nb, BLK, Dk).transpose(2, 0, 1, 3, 4)
    kpos = jnp.arange(S)

    def one_block(args):
        qblk, idx = args
        s = jnp.einsum('bhqd,bhkd->bhqk', qblk, k).astype(jnp.float32) * scale
        qpos = idx * BLK + jnp.arange(BLK)
        s = jnp.where(kpos[None, :] <= qpos[:, None], s, -jnp.inf)
        p = jax.nn.softmax(s, axis=-1).astype(v.dtype)
        return jnp.einsum('bhqk,bhkd->bhqd', p, v)

    out = lax.map(one_block, (qb, jnp.arange(nb)))
    return out.transpose(1, 2, 0, 3, 4).reshape(B, H, S, Dv)


def mixer_ab(h, w_in, w_out, conv_w, conv_b, ln_g, ln_b):
    B, S, _ = h.shape
    z = h @ w_in
    qa, ka, va, u, g = jnp.split(
        z, [A_WIDTH, 2 * A_WIDTH, 3 * A_WIDTH, 3 * A_WIDTH + B_CHANNELS], axis=-1)
    heads = lambda t: t.reshape(B, S, A_HEADS, A_HEAD_DIM)
    ya = dilated_mixture_attention(heads(qa), heads(ka), heads(va)).reshape(B, S, A_WIDTH)
    glu = u * jax.nn.sigmoid(g)
    conv = lax.conv_general_dilated(
        glu, conv_w, window_strides=(1,), padding=[(B_CONV_WIDTH - 1, 0)],
        dimension_numbers=('NWC', 'WIO', 'NWC'), feature_group_count=B_CHANNELS) + conv_b
    yb = jax.nn.silu(layer_norm(conv, ln_g, ln_b))
    return jnp.concatenate([ya, yb], axis=-1) @ w_out


def mixer_cd(h, positions, layer_idx, w_in, w_out, lq1, lk1, lq2, lk2, subln_g,
             q_norm_g, kv_norm_g, w_uq, w_uk, w_uv):
    B, S, _ = h.shape
    z = h @ w_in
    o1 = C_WIDTH
    o2 = 2 * C_WIDTH
    o3 = 3 * C_WIDTH
    o4 = o3 + D_Q_RANK
    o5 = o4 + D_KV_RANK
    qc, kc, vc, cq, ckv, kr = jnp.split(z, [o1, o2, o3, o4, o5], axis=-1)

    def two_maps(t):
        t = t.reshape(B, S, C_HEADS, 2, C_HEAD_DIM)
        return t.transpose(0, 3, 2, 1, 4).reshape(B, 2 * C_HEADS, S, C_HEAD_DIM)
    vch = vc.reshape(B, S, C_HEADS, 2 * C_HEAD_DIM).transpose(0, 2, 1, 3)
    a = causal_attention(two_maps(qc), two_maps(kc), jnp.concatenate([vch, vch], axis=1),
                         C_HEAD_DIM ** -0.5)
    lam_init = 0.8 - 0.6 * math.exp(-0.3 * layer_idx)
    lam = jnp.exp(jnp.sum(lq1 * lk1)) - jnp.exp(jnp.sum(lq2 * lk2)) + lam_init
    yc = rms_norm(a[:, :C_HEADS] - lam * a[:, C_HEADS:], subln_g) * (1.0 - lam_init)
    yc = yc.transpose(0, 2, 1, 3).reshape(B, S, C_WIDTH)

    q = (rms_norm(cq, q_norm_g) @ w_uq).reshape(B, S, D_HEADS, D_NOPE_DIM + D_ROPE_DIM)
    qd = jnp.concatenate([q[..., :D_NOPE_DIM], rope(q[..., D_NOPE_DIM:], positions)], axis=-1)
    ckv = rms_norm(ckv, kv_norm_g)
    k_nope = (ckv @ w_uk).reshape(B, S, D_HEADS, D_NOPE_DIM)
    vd = (ckv @ w_uv).reshape(B, S, D_HEADS, D_V_DIM)
    k_rope = rope(kr[:, :, None, :], positions)
    kd = jnp.concatenate(
        [k_nope, jnp.broadcast_to(k_rope, (B, S, D_HEADS, D_ROPE_DIM))], axis=-1)
    yd = causal_attention(qd.transpose(0, 2, 1, 3), kd.transpose(0, 2, 1, 3),
                          vd.transpose(0, 2, 1, 3), (D_NOPE_DIM + D_ROPE_DIM) ** -0.5)
    yd = yd.transpose(0, 2, 1, 3).reshape(B, S, D_HEADS * D_V_DIM)
    return jnp.concatenate([yc, yd], axis=-1) @ w_out


def memory_cross_attention(h, mem, mem_norm_g, wq, wkv, wo):
    B, S, _ = h.shape
    M = mem.shape[1]
    q = (h @ wq).reshape(B, S, X_HEADS, X_HEAD_DIM)
    k, v = jnp.split(rms_norm(mem, mem_norm_g) @ wkv, 2, axis=-1)
    k = k.reshape(B, M, X_HEADS, X_HEAD_DIM)
    v = v.reshape(B, M, X_HEADS, X_HEAD_DIM)
    s = jnp.einsum('bshd,bmhd->bhsm', q, k).astype(jnp.float32) * (X_HEAD_DIM ** -0.5)
    p = jax.nn.softmax(s, axis=-1).astype(v.dtype)
    o = jnp.einsum('bhsm,bmhd->bshd', p, v).reshape(B, S, X_HEADS * X_HEAD_DIM)
    return o @ wo


def squared_relu_mlp(h, w1, w2):
    return jnp.square(jax.nn.relu(h @ w1)) @ w2


def setup_inputs(seed: int = 0) -> dict:
    key = jax.random.key(seed)
    keys = iter(jax.random.split(key, 64))
    nrm = lambda shape, scale: jax.random.normal(next(keys), shape, jnp.float32) * scale
    gain = lambda shape: 1.0 + nrm(shape, 0.02)
    L, E, O, D = DEPTH, N_EVEN, N_ODD, D_MODEL
    offset = jax.random.randint(next(keys), (BATCH, 1), 0, 4096, dtype=jnp.int32)
    return {
        'x': nrm((BATCH, SEQ, D), 1.0),
        'mem': nrm((BATCH, MEM_LEN, D), 1.0),
        'positions': offset + jnp.arange(SEQ, dtype=jnp.int32)[None, :],
        'norm_mix_g': gain((L, D)),
        'norm_cross_g': gain((L, D)),
        'norm_mem_g': gain((L, D)),
        'cross_wq': nrm((L, D, X_HEADS * X_HEAD_DIM), D ** -0.5),
        'cross_wkv': nrm((L, D, 2 * X_HEADS * X_HEAD_DIM), D ** -0.5),
        'cross_wo': nrm((L, X_HEADS * X_HEAD_DIM, D), (X_HEADS * X_HEAD_DIM) ** -0.5),
        'norm_mlp_g': gain((L, D)),
        'mlp_w1': nrm((L, D, D_FF), D ** -0.5),
        'mlp_w2': nrm((L, D_FF, D), D_FF ** -0.5),
        'ab_w_in': nrm((E, D, AB_IN), D ** -0.5),
        'ab_w_out': nrm((E, AB_OUT, D), AB_OUT ** -0.5),
        'ab_conv_w': nrm((E, B_CONV_WIDTH, 1, B_CHANNELS), B_CONV_WIDTH ** -0.5),
        'ab_conv_b': nrm((E, B_CHANNELS), 0.02),
        'ab_ln_g': gain((E, B_CHANNELS)),
        'ab_ln_b': nrm((E, B_CHANNELS), 0.02),
        'cd_w_in': nrm((O, D, CD_IN), D ** -0.5),
        'cd_w_out': nrm((O, CD_OUT, D), CD_OUT ** -0.5),
        'diff_lq1': nrm((O, C_HEAD_DIM), 0.1),
        'diff_lk1': nrm((O, C_HEAD_DIM), 0.1),
        'diff_lq2': nrm((O, C_HEAD_DIM), 0.1),
        'diff_lk2': nrm((O, C_HEAD_DIM), 0.1),
        'diff_subln_g': gain((O, 2 * C_HEAD_DIM)),
        'mla_q_norm_g': gain((O, D_Q_RANK)),
        'mla_kv_norm_g': gain((O, D_KV_RANK)),
        'mla_w_uq': nrm((O, D_Q_RANK, D_HEADS * (D_NOPE_DIM + D_ROPE_DIM)), D_Q_RANK ** -0.5),
        'mla_w_uk': nrm((O, D_KV_RANK, D_HEADS * D_NOPE_DIM), D_KV_RANK ** -0.5),
        'mla_w_uv': nrm((O, D_KV_RANK, D_HEADS * D_V_DIM), D_KV_RANK ** -0.5),
        'final_norm_g': gain((D,)),
    }


def reference(x, mem, positions, norm_mix_g, norm_cross_g, norm_mem_g, cross_wq, cross_wkv,
              cross_wo, norm_mlp_g, mlp_w1, mlp_w2, ab_w_in, ab_w_out, ab_conv_w, ab_conv_b,
              ab_ln_g, ab_ln_b, cd_w_in, cd_w_out, diff_lq1, diff_lk1, diff_lq2, diff_lk2,
              diff_subln_g, mla_q_norm_g, mla_kv_norm_g, mla_w_uq, mla_w_uk, mla_w_uv,
              final_norm_g):
    for i in range(DEPTH):
        j = i // 2
        h = rms_norm(x, norm_mix_g[i])
        if i % 2 == 0:
            x = x + mixer_ab(h, ab_w_in[j], ab_w_out[j], ab_conv_w[j], ab_conv_b[j],
                             ab_ln_g[j], ab_ln_b[j])
        else:
            x = x + mixer_cd(h, positions, i, cd_w_in[j], cd_w_out[j], diff_lq1[j], diff_lk1[j],
                             diff_lq2[j], diff_lk2[j], diff_subln_g[j], mla_q_norm_g[j],
                             mla_kv_norm_g[j], mla_w_uq[j], mla_w_uk[j], mla_w_uv[j])
        x = x + memory_cross_attention(rms_norm(x, norm_cross_g[i]), mem, norm_mem_g[i],
                                       cross_wq[i], cross_wkv[i], cross_wo[i])
        x = x + squared_relu_mlp(rms_norm(x, norm_mlp_g[i]), mlp_w1[i], mlp_w2[i])
    return rms_norm(x, final_norm_g)
```

```cpp
#include <hip/hip_runtime.h>
#include <hip/hip_cooperative_groups.h>
#include <cstdio>
#include <cstdint>
namespace cg = cooperative_groups;

#define LAS __attribute__((address_space(3)))
#define GAS __attribute__((address_space(1)))
#define TOG(T, p) ((T*)(GAS T*)(p))
typedef unsigned short bf16_t;
typedef short bf16x8 __attribute__((ext_vector_type(8)));
typedef short s16x4 __attribute__((ext_vector_type(4)));
typedef float f32x4 __attribute__((ext_vector_type(4)));
typedef float f32x16 __attribute__((ext_vector_type(16)));
typedef unsigned u32x4 __attribute__((ext_vector_type(4)));
typedef unsigned u32x2 __attribute__((ext_vector_type(2)));
typedef float f32x2_t __attribute__((ext_vector_type(2)));
typedef __bf16 bf16x2_t __attribute__((ext_vector_type(2)));

__device__ __forceinline__ unsigned pk2(float lo, float hi) { f32x2_t v = {lo, hi}; bf16x2_t b = __builtin_convertvector(v, bf16x2_t); return __builtin_bit_cast(unsigned, b); }
__device__ __forceinline__ float bf2f(unsigned h) { return __uint_as_float(h << 16); }

constexpr int NB = 4, SEQ = 8192, T = NB * SEQ, D = 1024;
constexpr float EPS = 1e-6f;
constexpr float LOG2E = 1.4426950408889634f;
constexpr float NEGBIG = -1e30f;

constexpr size_t MiB = 1u << 20;
constexpr size_t WS_W = 0, WS_XB = 56 * MiB, WS_BIG = 120 * MiB, WS_Y = 376 * MiB, WS_SMALL = 440 * MiB;
constexpr size_t WS_KVMEM = WS_SMALL, WS_MN = WS_SMALL + 4 * MiB, WS_SSQX = WS_SMALL + 8 * MiB, WS_SSQZ = WS_SMALL + 10 * MiB,
                 WS_ROPE = WS_SMALL + 20 * MiB, WS_LSE = WS_SMALL + 24 * MiB, WS_MISC = WS_SMALL + 28 * MiB, WS_END = WS_SMALL + 29 * MiB;
constexpr size_t M1 = 1048576;
constexpr size_t LW = 10 * M1, OW_Q = 0, OW_KV = M1 / 2, OW_O = M1 + M1 / 2, OW_1 = 2 * M1, OW_2 = 6 * M1;
constexpr size_t OW_ABIN = 20 * M1, OW_ABOUT = OW_ABIN + 2560 * 1024, OW_CDIN = OW_ABOUT + M1, OW_CDOUT = OW_CDIN + 2304 * 1024,
                 OW_UQ = OW_CDOUT + M1, OW_UKV = OW_UQ + 768 * 384, OW_END = OW_UKV + 1024 * 256;
static_assert(OW_END * 2 <= 56 * MiB, "weights");
constexpr size_t OB_Z = 0;
constexpr size_t OB_OA = 160 * MiB;
constexpr size_t OB_QD = 144 * MiB;
constexpr size_t OB_KVD = 192 * MiB;
constexpr size_t OB_H = 0;

constexpr int LDS_BYTES = 147456;
#ifndef PHMASK
#define PHMASK 0xFF
#endif
#ifndef DUPMASK
#define DUPMASK 0
#endif

namespace pg8 {
constexpr int BM = 256, BK = 64, HALF = 128, HTB = HALF * BK * 2, STAGE_BYTES = 8 * HTB, NXCD = 8, WGM = 8;
__host__ __device__ __forceinline__ int lds_byte(int r, int c) { const int st = (r >> 4) * 2 + (c >> 5), rr = r & 15, cc = c & 31, ob = rr * 64 + cc * 2; return st * 1024 + (ob ^ (((ob >> 9) & 1) << 5)); }
__host__ __device__ __forceinline__ void stage_rc(int b, int& R, int& C) { const int st = b / 1024, sb = b % 1024, swz = sb ^ (((sb >> 9) & 1) << 5); R = (st >> 1) * 16 + swz / 64; C = (st & 1) * 32 + (swz % 64) / 2; }
__host__ __device__ __forceinline__ int perm32(int rho) { const int n = rho >> 4, i = rho & 15; return 8 * (i >> 2) + 4 * n + (i & 3); }

struct Unit { int pm, pn; };
struct Gemm { const bf16_t* A; const bf16_t* Bt; int M, N, K, lda; };

struct StaticOrder {
    int nM, nN, nwg, G, c;
    __device__ void init(int M, int N, int G_, int c_) { nM = M / BM; nN = N / BM; nwg = nM * nN; G = G_; c = c_; }
    __device__ bool next(int i, Unit& u) const {
        const long L = (long)i * G + c; if (L >= nwg) return false;
        int wgid = (int)L; { const int q = nwg / NXCD, r = nwg % NXCD, xcd = wgid % NXCD, off = wgid / NXCD; wgid = (xcd < r ? xcd * (q + 1) : r * (q + 1) + (xcd - r) * q) + off; }
        const int nig = WGM * nN, gid = wgid / nig, fm = gid * WGM, gsz = (nM - fm) < WGM ? (nM - fm) : WGM;
        u.pm = fm + ((wgid % nig) % gsz); u.pn = (wgid % nig) / gsz; return true;
    }
};


struct EpiZ {
    static constexpr bool PERM = true;
    bf16_t* O; int ldc;
    const float* rs; int rs_stride, rs_off, rs_n4; float rs_inv;
    int qs_end; float qscale;
    int act;
    int rope, rope_g;
    const float* rcos; const float* rsin;
    float* ssq; int ssq_stride;
    __device__ __forceinline__ void operator()(const f32x4 (&acc)[2][2][4][2], const Unit& u, int wr, int wc, int fr, int fq) const {
        const int row0 = u.pm * BM + wr * 64 + fr;
#pragma unroll
        for (int ai = 0; ai < 2; ++ai)
#pragma unroll
            for (int m = 0; m < 4; ++m) {
                const int row = row0 + ai * HALF + m * 16;
                float r = 1.f;
                if (rs) { f32x4 s = {0.f, 0.f, 0.f, 0.f}; const float* p = rs + (size_t)row * rs_stride + rs_off;
                    for (int k = 0; k < rs_n4; ++k) s += *(const f32x4*)(p + 4 * k);
                    r = __builtin_amdgcn_rsqf(((s.x + s.y) + (s.z + s.w)) * rs_inv + EPS); }
#pragma unroll
                for (int bj = 0; bj < 2; ++bj) {
                    const int colg = u.pn * BM + bj * HALF + wc * 32, gidx = colg >> 5, col = colg + 8 * fq;
                    f32x4 v0 = acc[ai][bj][m][0] * r, v1 = acc[ai][bj][m][1] * r;
                    if (act == 1) {
#pragma unroll
                        for (int e = 0; e < 4; ++e) { float a = fmaxf(v0[e], 0.f), b = fmaxf(v1[e], 0.f); v0[e] = a * a; v1[e] = b * b; }
                    }
                    if (ssq) {
                        float ss = (v0[0] * v0[0] + v0[1] * v0[1]) + (v0[2] * v0[2] + v0[3] * v0[3]) + (v1[0] * v1[0] + v1[1] * v1[1]) + (v1[2] * v1[2] + v1[3] * v1[3]);
                        ss += __shfl_xor(ss, 16); ss += __shfl_xor(ss, 32);
                        if (fq == 0) ssq[(size_t)row * ssq_stride + gidx] = ss;
                    }
                    if (colg < qs_end) { v0 = v0 * qscale; v1 = v1 * qscale; }
                    const bool rg = (rope == 1) ? (gidx == rope_g) : ((rope == 2) ? (gidx % 3 == 2) : false);
                    if (rg) {
                        const int ci = 8 * (fq & 1);
                        const f32x4 c0 = *(const f32x4*)(rcos + (size_t)row * 16 + ci), c1 = *(const f32x4*)(rcos + (size_t)row * 16 + ci + 4);
                        const f32x4 s0 = *(const f32x4*)(rsin + (size_t)row * 16 + ci), s1 = *(const f32x4*)(rsin + (size_t)row * 16 + ci + 4);
                        const float sg = (fq < 2) ? -1.f : 1.f;
#pragma unroll
                        for (int e = 0; e < 4; ++e) {
                            const float p0 = __shfl_xor(v0[e], 32), p1 = __shfl_xor(v1[e], 32);
                            v0[e] = v0[e] * c0[e] + sg * p0 * s0[e];
                            v1[e] = v1[e] * c1[e] + sg * p1 * s1[e];
                        }
                    }
                    u32x4 w; w.x = pk2(v0[0], v0[1]); w.y = pk2(v0[2], v0[3]); w.z = pk2(v1[0], v1[1]); w.w = pk2(v1[2], v1[3]);
                    *(u32x4*)(O + (size_t)row * ldc + col) = w;
                }
            }
    }
};
struct EpiRes {
    static constexpr bool PERM = false;
    const float* base; float* out; bf16_t* xb; float* ssq;
    __device__ __forceinline__ void operator()(const f32x4 (&acc)[2][2][4][2], const Unit& u, int wr, int wc, int fr, int fq) const {
        const int row0 = u.pm * BM + wr * 64 + fr;
#pragma unroll
        for (int ai = 0; ai < 2; ++ai)
#pragma unroll
            for (int m = 0; m < 4; ++m) {
                const int row = row0 + ai * HALF + m * 16; float ss = 0.f;
#pragma unroll
                for (int bj = 0; bj < 2; ++bj)
#pragma unroll
                    for (int n = 0; n < 2; ++n) {
                        const size_t off = (size_t)row * D + u.pn * BM + bj * HALF + wc * 32 + 16 * n + 4 * fq;
                        const f32x4 v = *(const f32x4*)(base + off) + acc[ai][bj][m][n];
                        *(f32x4*)(out + off) = v;
                        u32x2 w; w.x = pk2(v[0], v[1]); w.y = pk2(v[2], v[3]); *(u32x2*)(xb + off) = w;
                        ss += (v[0] * v[0] + v[1] * v[1]) + (v[2] * v[2] + v[3] * v[3]);
                    }
                ss += __shfl_xor(ss, 16); ss += __shfl_xor(ss, 32);
                if (fq == 0) ssq[(size_t)row * 16 + u.pn * 4 + wc] = ss;
            }
    }
};

template <class Epi>
__device__ __forceinline__ void gemm_phase(LAS unsigned char* lds, const Gemm g, const StaticOrder& S, const Epi& E) {
    int tid = threadIdx.x; asm volatile("" : "+v"(tid));
    const int wid = __builtin_amdgcn_readfirstlane(tid >> 6), lane = tid & 63, wr = wid >> 2, wc = wid & 3, fr = lane & 15, fq = lane >> 4;
    const int K = g.K, nt = K / BK, lda = g.lda;
    unsigned voffA[2], voffB[2];
#pragma unroll
    for (int i = 0; i < 2; ++i) { int R, C; stage_rc(tid * 16 + i * 8192, R, C); const int Rb = Epi::PERM ? ((R & ~31) + perm32(R & 31)) : R;
        voffA[i] = (unsigned)(R * lda + C) * 2u; voffB[i] = (unsigned)(Rb * K + C) * 2u; }
    const size_t kstep = (size_t)(BK * 2);
    const size_t hstepA = (size_t)HALF * lda * 2, hstepB = (size_t)HALF * K * 2;
    const size_t tstepA = 2 * hstepA, tstepB = 2 * hstepB;
    const unsigned ldsw = (unsigned)wid * 1024u;
    const int aoff = lds_byte(wr * 64 + fr, fq * 8), boff = lds_byte(wc * 32 + fr, fq * 8);
#define PG8_SA(b, h) (((b) * 2 + (h)) * HTB)
#define PG8_SB(b, h) ((4 + (b) * 2 + (h)) * HTB)
#define PG8_STAGE(bufoff, gbase, voff) do { _Pragma("unroll") for (int _i = 0; _i < 2; ++_i) \
        __builtin_amdgcn_global_load_lds((const unsigned*)((const char*)(gbase) + (voff)[_i]), (LAS unsigned*)(lds + (bufoff) + ldsw + _i * 8192), 16, 0, 0); } while (0)
#define PG8_LDA(dst, b, h) do { _Pragma("unroll") for (int m = 0; m < 4; ++m) _Pragma("unroll") for (int k = 0; k < 2; ++k) dst[m][k] = *(const LAS bf16x8*)(lds + PG8_SA(b, h) + aoff + m * 2048 + k * 1024); } while (0)
#define PG8_LDB(dst, b, h) do { _Pragma("unroll") for (int n = 0; n < 2; ++n) _Pragma("unroll") for (int k = 0; k < 2; ++k) dst[n][k] = *(const LAS bf16x8*)(lds + PG8_SB(b, h) + boff + n * 2048 + k * 1024); } while (0)
#define PG8_MMA(ai, bj, At, Bt) do { __builtin_amdgcn_s_setprio(1); _Pragma("unroll") for (int m = 0; m < 4; ++m) _Pragma("unroll") for (int n = 0; n < 2; ++n) _Pragma("unroll") for (int k = 0; k < 2; ++k) \
        acc[ai][bj][m][n] = __builtin_amdgcn_mfma_f32_16x16x32_bf16(Bt[n][k], At[m][k], acc[ai][bj][m][n], 0, 0, 0); __builtin_amdgcn_s_setprio(0); } while (0)
#define PG8_WAIT_V(n) asm volatile("s_waitcnt vmcnt(" #n ")" ::: "memory")
#define PG8_WAIT_L(n) asm volatile("s_waitcnt lgkmcnt(" #n ")" ::: "memory")
#define PG8_BAR __builtin_amdgcn_s_barrier()
#define PG8_SCHED __builtin_amdgcn_sched_barrier(0)
    Unit cur, nxt; int ui = 0;
    if (!S.next(0, cur)) return;
    f32x4 acc[2][2][4][2];
#pragma unroll
    for (int a = 0; a < 2; ++a)
#pragma unroll
        for (int b = 0; b < 2; ++b)
#pragma unroll
            for (int m = 0; m < 4; ++m)
#pragma unroll
                for (int n = 0; n < 2; ++n) acc[a][b][m][n] = (f32x4){0.f, 0.f, 0.f, 0.f};
    bf16x8 At[4][2], B0[2][2], B1[2][2];
    const char* cA = (const char*)g.A + (size_t)cur.pm * tstepA; const char* cB = (const char*)g.Bt + (size_t)cur.pn * tstepB;
    PG8_STAGE(PG8_SB(0, 0), cB, voffB); PG8_STAGE(PG8_SB(0, 1), cB + hstepB, voffB); PG8_STAGE(PG8_SA(0, 0), cA, voffA); PG8_STAGE(PG8_SA(0, 1), cA + hstepA, voffA);
    if (wr == 1) PG8_BAR;
    PG8_WAIT_V(2); PG8_BAR;
    PG8_STAGE(PG8_SB(1, 0), cB + kstep, voffB); PG8_STAGE(PG8_SA(1, 0), cA + kstep, voffA); PG8_STAGE(PG8_SB(1, 1), cB + hstepB + kstep, voffB);
    PG8_WAIT_V(6); PG8_BAR;
    for (;;) {
        const bool has_next = S.next(ui + 1, nxt);
        const char* nA = has_next ? (const char*)g.A + (size_t)nxt.pm * tstepA : cA; const char* nB = has_next ? (const char*)g.Bt + (size_t)nxt.pn * tstepB : cB;
        for (int t = 0; t < nt; t += 2) {
            const bool last = (t == nt - 2);
            const char* a1 = cA + (size_t)(t + 1) * kstep;
            const char* a2 = last ? nA : cA + (size_t)(t + 2) * kstep; const char* b2 = last ? nB : cB + (size_t)(t + 2) * kstep;
            const char* a3 = a2 + kstep; const char* b3 = b2 + kstep;
            PG8_LDB(B0, 0, 0); PG8_LDB(B1, 0, 1); PG8_SCHED; PG8_LDA(At, 0, 0); PG8_STAGE(PG8_SA(1, 1), a1 + hstepA, voffA);
            PG8_WAIT_V(8); PG8_WAIT_L(0); PG8_BAR; PG8_MMA(0, 0, At, B0); PG8_MMA(0, 1, At, B1); PG8_BAR; PG8_SCHED;
            PG8_LDA(At, 0, 1); PG8_STAGE(PG8_SB(0, 0), b2, voffB); PG8_STAGE(PG8_SB(0, 1), b2 + hstepB, voffB); PG8_STAGE(PG8_SA(0, 0), a2, voffA);
            PG8_WAIT_V(8); PG8_WAIT_L(0); PG8_BAR; PG8_MMA(1, 0, At, B0); PG8_MMA(1, 1, At, B1); PG8_BAR; PG8_SCHED;
            PG8_LDB(B0, 1, 0); PG8_LDB(B1, 1, 1); PG8_SCHED; PG8_LDA(At, 1, 0); PG8_STAGE(PG8_SA(0, 1), a2 + hstepA, voffA);
            PG8_WAIT_V(8); PG8_WAIT_L(0); PG8_BAR; PG8_MMA(0, 0, At, B0); PG8_MMA(0, 1, At, B1); PG8_BAR; PG8_SCHED;
            PG8_LDA(At, 1, 1); PG8_STAGE(PG8_SB(1, 0), b3, voffB); PG8_STAGE(PG8_SB(1, 1), b3 + hstepB, voffB); PG8_STAGE(PG8_SA(1, 0), a3, voffA);
            PG8_WAIT_V(8); PG8_WAIT_L(0); PG8_BAR; PG8_MMA(1, 0, At, B0); PG8_MMA(1, 1, At, B1); PG8_BAR; PG8_SCHED;
        }
        if (wr == 0) PG8_BAR;
        E(acc, cur, wr, wc, fr, fq);
        if (!has_next) break;
#pragma unroll
        for (int a = 0; a < 2; ++a)
#pragma unroll
            for (int b = 0; b < 2; ++b)
#pragma unroll
                for (int m = 0; m < 4; ++m)
#pragma unroll
                    for (int n = 0; n < 2; ++n) acc[a][b][m][n] = (f32x4){0.f, 0.f, 0.f, 0.f};
        cur = nxt; cA = nA; cB = nB; ++ui;
        if (wr == 1) PG8_BAR;
    }
    PG8_WAIT_V(0);
    PG8_BAR;
#undef PG8_SA
#undef PG8_SB
#undef PG8_STAGE
#undef PG8_LDA
#undef PG8_LDB
#undef PG8_MMA
#undef PG8_WAIT_V
#undef PG8_WAIT_L
#undef PG8_BAR
#undef PG8_SCHED
}
}

template <int VS, int D> __device__ __forceinline__ void tr_block(unsigned a, s16x4 (&l)[4], s16x4 (&h)[4]) {
    asm volatile("ds_read_b64_tr_b16 %0, %1 offset:%2" : "=v"(l[0]) : "v"(a), "i"(0 * VS + D * 64) : "memory");
    asm volatile("ds_read_b64_tr_b16 %0, %1 offset:%2" : "=v"(h[0]) : "v"(a), "i"(4 * VS + D * 64) : "memory");
    asm volatile("ds_read_b64_tr_b16 %0, %1 offset:%2" : "=v"(l[1]) : "v"(a), "i"(16 * VS + D * 64) : "memory");
    asm volatile("ds_read_b64_tr_b16 %0, %1 offset:%2" : "=v"(h[1]) : "v"(a), "i"(20 * VS + D * 64) : "memory");
    asm volatile("ds_read_b64_tr_b16 %0, %1 offset:%2" : "=v"(l[2]) : "v"(a), "i"(32 * VS + D * 64) : "memory");
    asm volatile("ds_read_b64_tr_b16 %0, %1 offset:%2" : "=v"(h[2]) : "v"(a), "i"(36 * VS + D * 64) : "memory");
    asm volatile("ds_read_b64_tr_b16 %0, %1 offset:%2" : "=v"(l[3]) : "v"(a), "i"(48 * VS + D * 64) : "memory");
    asm volatile("ds_read_b64_tr_b16 %0, %1 offset:%2" : "=v"(h[3]) : "v"(a), "i"(52 * VS + D * 64) : "memory");
}
#define TR_WAIT8(l, h) asm volatile("s_waitcnt lgkmcnt(8)" : "+v"(l[0]), "+v"(l[1]), "+v"(l[2]), "+v"(l[3]), "+v"(h[0]), "+v"(h[1]), "+v"(h[2]), "+v"(h[3]) :: "memory")
#define TR_WAIT0(l, h) asm volatile("s_waitcnt lgkmcnt(0)" : "+v"(l[0]), "+v"(l[1]), "+v"(l[2]), "+v"(l[3]), "+v"(h[0]), "+v"(h[1]), "+v"(h[2]), "+v"(h[3]) :: "memory")
#define PV4(d, l, h) do { _Pragma("unroll") for (int cc = 0; cc < 4; ++cc) { \
        const bf16x8 vf = (bf16x8){l[cc][0], l[cc][1], l[cc][2], l[cc][3], h[cc][0], h[cc][1], h[cc][2], h[cc][3]}; \
        o[d] = __builtin_amdgcn_mfma_f32_32x32x16_bf16(vf, __builtin_bit_cast(bf16x8, pw[cc]), o[d], 0, 0, 0); } } while (0)

__device__ __forceinline__ float fadd_s(float a, float b) { float r; asm("v_add_f32_e32 %0, %1, %2" : "=v"(r) : "v"(a), "v"(b)); return r; }
template <int DK, int DK1, int DV, bool MASK, bool NEGM = true, bool PF2 = false, int VAH = 1, bool SHIFT = false>
__device__ __forceinline__ void attn_core(LAS unsigned char* lds,
        const bf16_t* Qp, long ldq, const bf16_t* K1p, long ldk1, const bf16_t* K2p, long ldk2, const bf16_t* Vp, long ldv,
        int q0, int kt0, int kt1, int W, f32x16 (&o)[DV / 32], float& m_out, float& l_out) {
    constexpr int KS = DK * 2 + 16, VS = DV * 2 + 64, KBUF = 64 * KS, VBUF = 64 * VS;
    constexpr int KCH1 = DK1 / 8, NKC1 = 64 * KCH1, KPT1 = (NKC1 + 511) / 512, KCH2 = (DK - DK1) / 8, NKC2 = 64 * KCH2, KPT2 = (NKC2 + 511) / 512, KPT = KPT1 + KPT2;
    constexpr int VCH = DV / 8, NVC = 64 * VCH, VPT = (NVC + 511) / 512;
    static_assert(3 * KBUF + 3 * VBUF <= 131072, "attn lds");
    int tid = threadIdx.x; asm volatile("" : "+v"(tid));
    const int lane = tid & 63, wid = __builtin_amdgcn_readfirstlane(tid >> 6), r32 = lane & 31, hi = lane >> 5;
    LAS unsigned char* kbuf = lds; LAS unsigned char* vbuf = lds + 3 * KBUF;
    const int qlo = q0 + wid * 32, qrow = qlo + r32;
    bf16x8 qf[DK / 16];
#pragma unroll
    for (int c = 0; c < DK / 16; ++c) qf[c] = *(const bf16x8*)(Qp + (long)qrow * ldq + 16 * c + 8 * hi);
#pragma unroll
    for (int d = 0; d < DV / 32; ++d) o[d] = f32x16{};
    float mrun = 0.f, lrun = 0.f;
    u32x4 kreg0[KPT], vreg0[VPT], kreg1[KPT], vreg1[VPT];
#pragma unroll
    for (int i = 0; i < KPT; ++i) { kreg0[i] = (u32x4){0u, 0u, 0u, 0u}; kreg1[i] = kreg0[i]; }
#pragma unroll
    for (int i = 0; i < VPT; ++i) { vreg0[i] = (u32x4){0u, 0u, 0u, 0u}; vreg1[i] = vreg0[i]; }
    unsigned kgo[KPT], vgo[VPT]; int klo_[KPT], vlo_[VPT];
#pragma unroll
    for (int i = 0; i < KPT1; ++i) { const int e = (tid + 512 * i) % NKC1, row = e / KCH1, ch = e % KCH1; kgo[i] = (unsigned)(row * (int)ldk1 + ch * 8) * 2u; klo_[i] = row * KS + ch * 16; }
#pragma unroll
    for (int i = 0; i < KPT2; ++i) { const int e = (tid + 512 * i) % (NKC2 ? NKC2 : 1), row = e / (KCH2 ? KCH2 : 1), ch = e % (KCH2 ? KCH2 : 1); kgo[KPT1 + i] = (unsigned)(row * (int)ldk2 + ch * 8) * 2u; klo_[KPT1 + i] = row * KS + (KCH1 + ch) * 16; }
#pragma unroll
    for (int i = 0; i < VPT; ++i) { const int e = (tid + 512 * i) % NVC, row = e / VCH, ch = e % VCH; vgo[i] = (unsigned)(row * (int)ldv + ch * 8) * 2u; vlo_[i] = row * VS + ch * 16; }
#define ATT_LOAD(t, kreg, vreg) do { \
    const char* k1t_ = (const char*)(K1p + 64L * (t) * ldk1); const char* k2t_ = (const char*)(K2p + 64L * (t) * ldk2); const char* vt_ = (const char*)(Vp + 64L * (t) * ldv); \
    _Pragma("unroll") for (int i_ = 0; i_ < KPT1; ++i_) { kreg[i_] = *(const u32x4*)(k1t_ + (size_t)kgo[i_]); } \
    _Pragma("unroll") for (int i_ = 0; i_ < KPT2; ++i_) { kreg[KPT1 + i_] = *(const u32x4*)(k2t_ + (size_t)kgo[KPT1 + i_]); } \
    _Pragma("unroll") for (int i_ = 0; i_ < VPT; ++i_) { vreg[i_] = *(const u32x4*)(vt_ + (size_t)vgo[i_]); } } while (0)
#define ATT_STORE(b) do { \
    _Pragma("unroll") for (int i_ = 0; i_ < KPT1; ++i_) { if ((NKC1 % 512 == 0) || tid + 512 * i_ < NKC1) *(LAS u32x4*)(kbuf + (b) * KBUF + klo_[i_]) = kreg[i_]; } \
    _Pragma("unroll") for (int i_ = 0; i_ < KPT2; ++i_) { if ((NKC2 % 512 == 0) || tid + 512 * i_ < NKC2) *(LAS u32x4*)(kbuf + (b) * KBUF + klo_[KPT1 + i_]) = kreg[KPT1 + i_]; } \
    _Pragma("unroll") for (int i_ = 0; i_ < VPT; ++i_) { if ((NVC % 512 == 0) || tid + 512 * i_ < NVC) *(LAS u32x4*)(vbuf + (b) * VBUF + vlo_[i_]) = vreg[i_]; } } while (0)
#define ATT_STOREKV(kb_, vb_, kreg, vreg) do { \
    _Pragma("unroll") for (int i_ = 0; i_ < KPT1; ++i_) { if ((NKC1 % 512 == 0) || tid + 512 * i_ < NKC1) *(LAS u32x4*)(kbuf + (kb_) * KBUF + klo_[i_]) = kreg[i_]; } \
    _Pragma("unroll") for (int i_ = 0; i_ < KPT2; ++i_) { if ((NKC2 % 512 == 0) || tid + 512 * i_ < NKC2) *(LAS u32x4*)(kbuf + (kb_) * KBUF + klo_[KPT1 + i_]) = kreg[KPT1 + i_]; } \
    _Pragma("unroll") for (int i_ = 0; i_ < VPT; ++i_) { if ((NVC % 512 == 0) || tid + 512 * i_ < NVC) *(LAS u32x4*)(vbuf + (vb_) * VBUF + vlo_[i_]) = vreg[i_]; } } while (0)
    ATT_LOAD(kt0, kreg0, vreg0); ATT_STOREKV(0, 0, kreg0, vreg0);
    if (PF2) ATT_LOAD((kt0 + 1 < kt1 ? kt0 + 1 : kt1 - 1), kreg1, vreg1);
    __syncthreads();
    const int pr = (r32 & 0x13) | ((r32 & 8) >> 1) | ((r32 & 4) << 1);
    const int koff = pr * KS + hi * 16;
    const int voff = (8 * hi + ((lane & 15) >> 2)) * VS + (16 * ((lane >> 4) & 1) + 4 * (lane & 3)) * 2;
    int ta = kt0, tb = kt1;
    if (MASK) { int lo = (qlo - W) >> 6; if (qlo - W < 0) lo = 0; if (lo > ta) ta = lo; const int hi_t = ((qlo + 31) >> 6) + 1; if (hi_t < tb) tb = hi_t; }
    constexpr int NQ = 2 * (DK / 16), NPV = 4 * (DV / 32), VA = (36 + NQ - 1) / NQ, VC = 32 / NPV;
    f32x16 negm = f32x16{};
    f32x16 sA0 = f32x16{}, sA1 = f32x16{};
    u32x4 pw[4];
#pragma unroll
    for (int i = 0; i < 4; ++i) pw[i] = (u32x4){0u, 0u, 0u, 0u};
    s16x4 va_l[4], va_h[4], vb_l[4], vb_h[4];
#pragma unroll
    for (int i = 0; i < 4; ++i) { va_l[i] = (s16x4){0, 0, 0, 0}; va_h[i] = va_l[i]; vb_l[i] = va_l[i]; vb_h[i] = va_l[i]; }
    bool has_pend = false, started = false;
    int kb_cur = 0, vb_cur = 0, vb_prev = 0;
#define ATT_X1(t, S0, S1) do { if (doqk_) { \
                if (NEGM) { S0 = negm; S1 = negm; } else { S0 = f32x16{}; S1 = f32x16{}; } \
                const LAS unsigned char* kb = kbuf + kb_cur * KBUF + koff; \
                bf16x8 ka0 = *(const LAS bf16x8*)(kb), ka1 = *(const LAS bf16x8*)(kb + 32 * KS); \
                __builtin_amdgcn_s_setprio(1); \
                _Pragma("unroll") for (int c = 0; c < DK / 16; ++c) { \
                    bf16x8 kn0 = ka0, kn1 = ka1; \
                    if (c + 1 < DK / 16) { kn0 = *(const LAS bf16x8*)(kb + (c + 1) * 32); kn1 = *(const LAS bf16x8*)(kb + 32 * KS + (c + 1) * 32); } \
                    S0 = __builtin_amdgcn_mfma_f32_32x32x16_bf16(ka0, qf[c], S0, 0, 0, 0); \
                    S1 = __builtin_amdgcn_mfma_f32_32x32x16_bf16(ka1, qf[c], S1, 0, 0, 0); \
                    __builtin_amdgcn_sched_barrier(0); \
                    ka0 = kn0; ka1 = kn1; } \
                __builtin_amdgcn_s_setprio(0); \
                if (!NEGM) { _Pragma("unroll") for (int r = 0; r < 16; ++r) { S0[r] -= mrun; S1[r] -= mrun; } } \
            } } while (0)
#define ATT_X2(P0, P1) do { if (dopv_) { \
                float rs0_ = P0[0], rs1_ = P1[0], rs2_ = P0[1], rs3_ = P1[1]; \
                _Pragma("unroll") for (int r = 2; r < 16; r += 2) { rs0_ = fadd_s(rs0_, P0[r]); rs1_ = fadd_s(rs1_, P1[r]); rs2_ = fadd_s(rs2_, P0[r + 1]); rs3_ = fadd_s(rs3_, P1[r + 1]); } \
                lrun += (rs0_ + rs1_) + (rs2_ + rs3_); \
                u32x4 w; \
                w.x = pk2(P0[0], P0[1]); w.y = pk2(P0[2], P0[3]); w.z = pk2(P0[4], P0[5]); w.w = pk2(P0[6], P0[7]); pw[0] = w; \
                w.x = pk2(P0[8], P0[9]); w.y = pk2(P0[10], P0[11]); w.z = pk2(P0[12], P0[13]); w.w = pk2(P0[14], P0[15]); pw[1] = w; \
                w.x = pk2(P1[0], P1[1]); w.y = pk2(P1[2], P1[3]); w.z = pk2(P1[4], P1[5]); w.w = pk2(P1[6], P1[7]); pw[2] = w; \
                w.x = pk2(P1[8], P1[9]); w.y = pk2(P1[10], P1[11]); w.z = pk2(P1[12], P1[13]); w.w = pk2(P1[14], P1[15]); pw[3] = w; \
            } } while (0)
#define ATT_X3(t, S0, S1) do { if (doqk_) { \
                const int klo = 64 * (t); \
                if (MASK && ((klo + 63 > qlo) || (klo < qlo + 31 - W))) { \
                    const int rel = qrow - klo - 8 * hi, rel2 = rel - W; \
                    _Pragma("unroll") for (int r = 0; r < 16; ++r) { const int i = r >> 2, j = r & 3; const int c0 = 16 * (i >> 1) + 4 * (i & 1) + j, c1 = c0 + 32; \
                        S0[r] = (c0 <= rel && c0 >= rel2) ? S0[r] : NEGBIG; S1[r] = (c1 <= rel && c1 >= rel2) ? S1[r] : NEGBIG; } \
                } \
                float rm = fmaxf(fmaxf(S0[0], S1[0]), S0[1]); \
                _Pragma("unroll") for (int r = 1; r < 15; r += 2) { rm = fmaxf(fmaxf(rm, S1[r]), S0[r + 1]); rm = fmaxf(fmaxf(rm, S1[r + 1]), S0[r + 2 > 15 ? 15 : r + 2]); } \
                rm = fmaxf(rm, S1[15]); \
                { auto rr_ = __builtin_amdgcn_permlane32_swap(__float_as_uint(rm), __float_as_uint(rm), false, false); rm = fmaxf(__uint_as_float(rr_[0]), __uint_as_float(rr_[1])); } \
                const float dl = started ? ((rm > 8.f) ? rm : 0.f) : rm; \
                if (__builtin_amdgcn_ballot_w64(dl != 0.f) != 0ull) { \
                    mrun += dl; \
                    _Pragma("unroll") for (int r = 0; r < 16; ++r) { S0[r] -= dl; S1[r] -= dl; } \
                    if (NEGM) { _Pragma("unroll") for (int r = 0; r < 16; ++r) negm[r] = -mrun; } \
                    if (started) { fsc_ = __builtin_amdgcn_exp2f(-dl); lrun *= fsc_; resc_ = true; } \
                } \
            } } while (0)
#define ATT_X4() do { if (dopv_) { \
                const unsigned va_ = (unsigned)(size_t)(vbuf + vb_prev * VBUF + voff); \
                __builtin_amdgcn_s_setprio(1); \
                tr_block<VS, 0>(va_, va_l, va_h); \
                tr_block<VS, 1>(va_, vb_l, vb_h); \
                if (DV == 64) { TR_WAIT8(va_l, va_h); PV4(0, va_l, va_h); TR_WAIT0(vb_l, vb_h); PV4(1, vb_l, vb_h); } \
                else { TR_WAIT8(va_l, va_h); PV4(0, va_l, va_h); \
                    tr_block<VS, 2>(va_, va_l, va_h); TR_WAIT8(vb_l, vb_h); PV4(1, vb_l, vb_h); \
                    tr_block<VS, 3>(va_, vb_l, vb_h); TR_WAIT8(va_l, va_h); PV4(DV == 64 ? 0 : 2, va_l, va_h); \
                    TR_WAIT0(vb_l, vb_h); PV4(DV == 64 ? 1 : 3, vb_l, vb_h); } \
                __builtin_amdgcn_s_setprio(0); \
            } } while (0)
#define ATT_X5(S0, S1) do { if (doqk_) { \
                _Pragma("unroll") for (int r = 0; r < 16; ++r) { S0[r] = __builtin_amdgcn_exp2f(S0[r]); S1[r] = __builtin_amdgcn_exp2f(S1[r]); } \
            } } while (0)
#define ATT_STEP(t, KL, VL, KST, VST) do { \
        const bool more_ = ((t) + 1 < kt1); \
        { const int tl_ = (t) + (PF2 ? 2 : 1); ATT_LOAD((tl_ < kt1 ? tl_ : kt1 - 1), KL, VL); }     \
        __builtin_amdgcn_sched_barrier(0);     \
        const bool doqk_ = ((t) >= ta) && ((t) < tb); \
        const bool dopv_ = has_pend; \
        float fsc_ = 1.f; bool resc_ = false; \
        ATT_X2(sA0, sA1); ATT_X4(); \
        const int sl_n_ = (kb_cur == 2) ? 0 : kb_cur + 1; \
        if (grp2) { asm volatile("s_waitcnt lgkmcnt(0)" ::: "memory"); __builtin_amdgcn_s_barrier(); asm volatile("" ::: "memory"); } \
        ATT_X1(t, sA0, sA1); ATT_X3(t, sA0, sA1); ATT_X5(sA0, sA1); \
        if (resc_) { \
            _Pragma("unroll") for (int d = 0; d < DV / 32; ++d) _Pragma("unroll") for (int r = 0; r < 16; ++r) o[d][r] *= fsc_; \
        } \
        has_pend = doqk_; started = started || doqk_; \
        __builtin_amdgcn_sched_barrier(0); \
        ATT_STOREKV(sl_n_, sl_n_, KST, VST); \
        vb_prev = kb_cur; kb_cur = sl_n_; \
        if (!grp2) { asm volatile("s_waitcnt lgkmcnt(0)" ::: "memory"); __builtin_amdgcn_s_barrier(); asm volatile("" ::: "memory"); } \
    } while (0)
    const bool grp2 = SHIFT && (wid >= 4);
    for (int t = kt0; t <= kt1; t += 2) {
        if (PF2) { ATT_STEP(t, kreg0, vreg0, kreg1, vreg1); if (t + 1 <= kt1) ATT_STEP(t + 1, kreg1, vreg1, kreg0, vreg0); }
        else { ATT_STEP(t, kreg0, vreg0, kreg0, vreg0); if (t + 1 <= kt1) ATT_STEP(t + 1, kreg0, vreg0, kreg0, vreg0); }
    }
#undef ATT_STEP
#undef ATT_X1
#undef ATT_X2
#undef ATT_X3
#undef ATT_X4
#undef ATT_X5
#undef ATT_STOREKV
#undef ATT_LOAD
#undef ATT_STORE
    lrun += __shfl_xor(lrun, 32);
    m_out = mrun; l_out = lrun;
}

#define XB_TMO      128
#define XB_XCNT(j)  (256  + 64 * (j))
#define XB_XSUB(j)  (1280 + 64 * (j))
#define XB_XGEN(j)  (2304 + 64 * (j))
#define XB_TOP      3328
#define XB_TOPGEN   3392
#define XCD_BAR_WORDS 3456
#define XB_SPIN_CAP (1u << 20)
__device__ __forceinline__ unsigned xb_ld(unsigned* p)              { return __hip_atomic_load(p, __ATOMIC_RELAXED, __HIP_MEMORY_SCOPE_AGENT); }
__device__ __forceinline__ unsigned xb_add(unsigned* p, unsigned v) { return __hip_atomic_fetch_add(p, v, __ATOMIC_RELAXED, __HIP_MEMORY_SCOPE_AGENT); }
__device__ __forceinline__ unsigned xb_xcc_id() { return (unsigned)__builtin_amdgcn_s_getreg((3 << 11) | 20) & 0xFu; }
#define XB_SPIN(cond, bar) do { unsigned _sp = 0; while (cond) { __builtin_amdgcn_s_sleep(1); \
    if ((++_sp & 255u) == 0u) { if (xb_ld(&(bar)[XB_TMO])) break; if (_sp > XB_SPIN_CAP) { atomicAdd(&(bar)[XB_TMO], 1u); break; } } } } while (0)
struct XcdBarrier { unsigned* bar; unsigned x; volatile LAS unsigned* st; };
__device__ __forceinline__ XcdBarrier xcd_barrier_post(unsigned* bar, volatile LAS unsigned* st) {
    XcdBarrier b; b.bar = bar; b.x = xb_xcc_id(); b.st = st;
    if (threadIdx.x == 0) (void)xb_add(&bar[XB_XCNT(b.x)], 1u);
    return b;
}
__device__ __forceinline__ void xcd_barrier_complete(unsigned* bar, unsigned x, unsigned& nloc, unsigned& nx) {
    const unsigned G = gridDim.x * gridDim.y * gridDim.z;
    unsigned sum, cnt, mine, sp = 0u;
    for (;;) {
        sum = 0u; cnt = 0u; mine = 0u;
#pragma unroll
        for (unsigned j = 0; j < 16; ++j) { const unsigned c = xb_ld(&bar[XB_XCNT(j)]); sum += c; cnt += (c > 0u) ? 1u : 0u; mine = (j == x) ? c : mine; }
        if (sum == G) break;
        __builtin_amdgcn_s_sleep(1);
        if ((++sp & 255u) == 0u) { if (xb_ld(&bar[XB_TMO])) break; if (sp > XB_SPIN_CAP) { atomicAdd(&bar[XB_TMO], 1u); break; } }
    }
    nloc = mine > 0u ? mine : 1u; nx = cnt > 0u ? cnt : 1u;
}
__device__ __forceinline__ void xcd_barrier(const XcdBarrier& b) {
    asm volatile("s_waitcnt vmcnt(0)" ::: "memory");
    __syncthreads();
    if (threadIdx.x == 0) {
        unsigned* bar = b.bar;
        __builtin_amdgcn_s_waitcnt(0);
        unsigned nloc = b.st[0], nx = b.st[1];
        if (nloc == 0u) { xcd_barrier_complete(bar, b.x, nloc, nx); b.st[0] = nloc; b.st[1] = nx; }
        const unsigned old = xb_add(&bar[XB_XSUB(b.x)], 1u);
        const unsigned gen = old / nloc;
        if (old + 1u == (gen + 1u) * nloc) {
            __builtin_amdgcn_fence(__ATOMIC_RELEASE, "agent");
            asm volatile("s_waitcnt vmcnt(0)" ::: "memory");
            const unsigned og = xb_add(&bar[XB_TOP], 1u);
            const unsigned tg = og / nx;
            if (og + 1u == (tg + 1u) * nx) xb_add(&bar[XB_TOPGEN], 1u);
            else XB_SPIN(xb_ld(&bar[XB_TOPGEN]) == tg, bar);
            __builtin_amdgcn_fence(__ATOMIC_ACQUIRE, "agent");
            xb_add(&bar[XB_XGEN(b.x)], 1u);
            asm volatile("s_waitcnt vmcnt(0)" ::: "memory");
        } else {
            XB_SPIN(xb_ld(&bar[XB_XGEN(b.x)]) == gen, bar);
            __builtin_amdgcn_fence(__ATOMIC_ACQUIRE, "agent");
            asm volatile("s_waitcnt vmcnt(0)" ::: "memory");
        }
    }
    __syncthreads();
}

struct Args { const void* in[31]; float* out; unsigned char* ws; int ph_lo, ph_hi; };

__device__ __forceinline__ float wave_sum(float v) {
#pragma unroll
    for (int o = 1; o < 64; o <<= 1) v += __shfl_xor(v, o);
    return v;
}

__device__ __forceinline__ void transpose_items(const float* W, int K, int N, const float* gain, bf16_t* WT, int ldt, int row_off, LAS float* scr, int gw, int NGW, int lane) {
    const int nblk = N / 32, nitems = (K / 64) * nblk;
    for (int item = gw; item < nitems; item += NGW) {
        const int kb = item / nblk, nb = item % nblk, k0 = 64 * kb, n0 = 32 * nb;
        float tmp[32];
#pragma unroll
        for (int i = 0; i < 32; ++i) { const int kk = 2 * i + (lane >> 5); tmp[i] = W[(size_t)(k0 + kk) * N + n0 + (lane & 31)]; }
#pragma unroll
        for (int i = 0; i < 32; ++i) { const int kk = 2 * i + (lane >> 5); scr[kk * 33 + (lane & 31)] = tmp[i]; }
        asm volatile("s_waitcnt lgkmcnt(0)" ::: "memory");
        const int c = lane & 7;
        f32x4 g0 = {1.f, 1.f, 1.f, 1.f}, g1 = g0;
        if (gain) { g0 = *(const f32x4*)(gain + k0 + 8 * c); g1 = *(const f32x4*)(gain + k0 + 8 * c + 4); }
#pragma unroll
        for (int j = 0; j < 4; ++j) { const int n = (lane >> 3) + 8 * j; const LAS float* sp = scr + (8 * c) * 33 + n;
            u32x4 o; o.x = pk2(sp[0 * 33] * g0.x, sp[1 * 33] * g0.y); o.y = pk2(sp[2 * 33] * g0.z, sp[3 * 33] * g0.w); o.z = pk2(sp[4 * 33] * g1.x, sp[5 * 33] * g1.y); o.w = pk2(sp[6 * 33] * g1.z, sp[7 * 33] * g1.w);
            *(u32x4*)(WT + (size_t)(row_off + n0 + n) * ldt + k0 + 8 * c) = o; }
        asm volatile("s_waitcnt lgkmcnt(0)" ::: "memory");
    }
}

__global__ void __launch_bounds__(512) mk_fwd(Args args) {
    extern __shared__ __attribute__((aligned(16))) unsigned char lds_raw[];
    LAS unsigned char* lds = (LAS unsigned char*)lds_raw;
    cg::grid_group grid = cg::this_grid();
    volatile LAS unsigned* bst = (volatile LAS unsigned*)(lds + 131072 + 256);
    unsigned* barw = (unsigned*)(GAS unsigned*)(args.ws + WS_MISC + 65536);
    if (threadIdx.x < 2) bst[threadIdx.x] = 0u;
    if (blockIdx.x == 0) { for (int i = threadIdx.x; i < XCD_BAR_WORDS; i += 512) barw[i] = 0u; }
    __syncthreads();
    XcdBarrier xbar; xbar.bar = barw; xbar.x = 0; xbar.st = bst;
    bool posted = false;
    int rep = 0;
    for (int ph = args.ph_lo; ph < args.ph_hi; ++ph) {
    int tid = threadIdx.x; asm volatile("" : "+v"(tid));
    const int lane = tid & 63, wave = __builtin_amdgcn_readfirstlane(tid >> 6);
    const int G = gridDim.x, bid = blockIdx.x;
    const int gw = bid * 8 + wave, NGW = G * 8;
    const int vcu = (G % 8 == 0) ? (bid % 8) * (G / 8) + bid / 8 : bid;
    unsigned long long wsi_ = (unsigned long long)args.ws; asm volatile("" : "+s"(wsi_));
    unsigned char* ws = (unsigned char*)(GAS unsigned char*)wsi_;
    const float* x_in = TOG(const float, args.in[0]);
    float* outp = TOG(float, args.out);
    bf16_t* Wt = (bf16_t*)(ws + WS_W);
    bf16_t* XB = (bf16_t*)(ws + WS_XB);
    float* O1S = (float*)(ws + WS_XB);
    unsigned char* BIG = ws + WS_BIG;
    bf16_t* Z = (bf16_t*)(BIG + OB_Z);
    bf16_t* OA = (bf16_t*)(BIG + OB_OA);
    bf16_t* QD = (bf16_t*)(BIG + OB_QD);
    bf16_t* KVD = (bf16_t*)(BIG + OB_KVD);
    bf16_t* Hb = (bf16_t*)(BIG + OB_H);
    bf16_t* Y = (bf16_t*)(ws + WS_Y);
    bf16_t* QX = (bf16_t*)(ws + WS_Y);
    bf16_t* OX = (bf16_t*)(ws + WS_Y + 32 * MiB);
    bf16_t* KVMEM = (bf16_t*)(ws + WS_KVMEM);
    bf16_t* MN = (bf16_t*)(ws + WS_MN);
    float* SSQX = (float*)(ws + WS_SSQX);
    float* SSQZ = (float*)(ws + WS_SSQZ);
    float* RCOS = (float*)(ws + WS_ROPE);
    float* RSIN = RCOS + (size_t)T * 16;
    float* LSE = (float*)(ws + WS_LSE);
    float* MISC = (float*)(ws + WS_MISC);

        const int layer = (ph >= 14) ? 1 : 0;
        if (ph == 0 && (PHMASK & 1)) {
            LAS float* scr = (LAS float*)(lds + wave * 16384);
            const float* g_mix = TOG(const float, args.in[3]); const float* g_cross = TOG(const float, args.in[4]); const float* g_mlp = TOG(const float, args.in[9]);
            for (int l = 0; l < 2; ++l) {
                bf16_t* wl = Wt + l * LW;
                transpose_items(TOG(const float, args.in[6]) + (size_t)l * 1024 * 512, 1024, 512, g_cross + l * 1024, wl + OW_Q, 1024, 0, scr, gw, NGW, lane);
                transpose_items(TOG(const float, args.in[7]) + (size_t)l * 1024 * 1024, 1024, 1024, nullptr, wl + OW_KV, 1024, 0, scr, gw, NGW, lane);
                transpose_items(TOG(const float, args.in[8]) + (size_t)l * 512 * 1024, 512, 1024, nullptr, wl + OW_O, 512, 0, scr, gw, NGW, lane);
                transpose_items(TOG(const float, args.in[10]) + (size_t)l * 1024 * 4096, 1024, 4096, g_mlp + l * 1024, wl + OW_1, 1024, 0, scr, gw, NGW, lane);
                transpose_items(TOG(const float, args.in[11]) + (size_t)l * 4096 * 1024, 4096, 1024, nullptr, wl + OW_2, 4096, 0, scr, gw, NGW, lane);
            }
            transpose_items(TOG(const float, args.in[12]), 1024, 2560, g_mix, Wt + OW_ABIN, 1024, 0, scr, gw, NGW, lane);
            transpose_items(TOG(const float, args.in[13]), 1024, 1024, nullptr, Wt + OW_ABOUT, 1024, 0, scr, gw, NGW, lane);
            transpose_items(TOG(const float, args.in[18]), 1024, 2208, g_mix + 1024, Wt + OW_CDIN, 1024, 0, scr, gw, NGW, lane);
            transpose_items(TOG(const float, args.in[19]), 1024, 1024, nullptr, Wt + OW_CDOUT, 1024, 0, scr, gw, NGW, lane);
            transpose_items(TOG(const float, args.in[27]), 384, 768, TOG(const float, args.in[25]), Wt + OW_UQ, 384, 0, scr, gw, NGW, lane);
            transpose_items(TOG(const float, args.in[28]), 256, 512, TOG(const float, args.in[26]), Wt + OW_UKV, 256, 0, scr, gw, NGW, lane);
            transpose_items(TOG(const float, args.in[29]), 256, 512, TOG(const float, args.in[26]), Wt + OW_UKV, 256, 512, scr, gw, NGW, lane);
            { u32x4* zp = (u32x4*)(Wt + OW_CDIN + (size_t)2208 * 1024); const int n16 = 96 * 1024 * 2 / 16;
              for (int i = bid * 512 + tid; i < n16; i += G * 512) zp[i] = (u32x4){0u, 0u, 0u, 0u}; }
            for (int m = gw; m < T; m += NGW) {
                const f32x4* xr = (const f32x4*)(x_in + (size_t)m * D) + lane; float s = 0.f;
                unsigned long long* o8 = (unsigned long long*)(XB + (size_t)m * D) + lane;
#pragma unroll
                for (int j = 0; j < 4; ++j) { const f32x4 v = xr[64 * j]; s += (v.x * v.x + v.y * v.y) + (v.z * v.z + v.w * v.w);
                    o8[64 * j] = (unsigned long long)pk2(v.x, v.y) | ((unsigned long long)pk2(v.z, v.w) << 32); }
                s = wave_sum(s);
                if (lane < 16) SSQX[(size_t)m * 16 + lane] = (lane == 0) ? s : 0.f;
            }
            for (int mm = gw; mm < 2 * 1024; mm += NGW) {
                const int l = mm >> 10, m = mm & 1023;
                const f32x4* xr = (const f32x4*)(TOG(const float, args.in[1]) + (size_t)m * D) + lane; const f32x4* gr = (const f32x4*)(TOG(const float, args.in[5]) + l * D) + lane;
                f32x4 v[4]; float s = 0.f;
#pragma unroll
                for (int j = 0; j < 4; ++j) { v[j] = xr[64 * j]; s += (v[j].x * v[j].x + v[j].y * v[j].y) + (v[j].z * v[j].z + v[j].w * v[j].w); }
                const float r = 1.0f / sqrtf(wave_sum(s) * (1.f / D) + EPS);
                unsigned long long* o8 = (unsigned long long*)(MN + ((size_t)l * 1024 + m) * D) + lane;
#pragma unroll
                for (int j = 0; j < 4; ++j) { const f32x4 gg = gr[64 * j]; o8[64 * j] = (unsigned long long)pk2(v[j].x * r * gg.x, v[j].y * r * gg.y) | ((unsigned long long)pk2(v[j].z * r * gg.z, v[j].w * r * gg.w) << 32); }
            }
            for (int i = bid * 512 + tid; i < T * 16; i += G * 512) {
                const int row = i >> 4, fi = i & 15;
                const float invf = __builtin_amdgcn_exp2f(-(float)fi * 0.83048202372184058696f);
                const double rev = (double)(TOG(const int, args.in[2]))[row] * (double)invf * 0.15915494309189533577;
                const float fr = (float)(rev - rint(rev));
                RCOS[i] = __builtin_amdgcn_cosf(fr); RSIN[i] = __builtin_amdgcn_sinf(fr);
            }
            if (bid == 0 && wave == 0) {
                const float a = (TOG(const float, args.in[20]))[lane] * (TOG(const float, args.in[21]))[lane], b2 = (TOG(const float, args.in[22]))[lane] * (TOG(const float, args.in[23]))[lane];
                const float sa = wave_sum(a), sb = wave_sum(b2);
                if (lane == 0) MISC[0] = __expf(sa) - __expf(sb) + 0.35550906759097f;
            }
        }
        if ((PHMASK & 2) && (ph == 1 || ph == 5 || ph == 8 || ph == 10 || ph == 11 || ph == 14 || ph == 17)) {
            const int njobs = (ph == 1 || ph == 10 || ph == 11) ? 2 : 1;
            for (int j = 0; j < njobs; ++j) {
                pg8::Gemm g; pg8::EpiZ E;
                E.rs = SSQX; E.rs_stride = 16; E.rs_off = 0; E.rs_n4 = 4; E.rs_inv = 1.f / 1024.f; E.qs_end = 0; E.qscale = 1.f; E.act = 0; E.rope = 0; E.rope_g = -1;
                E.rcos = RCOS; E.rsin = RSIN; E.ssq = nullptr; E.ssq_stride = 0;
                int rot = 0;
                if (ph == 1 && j == 0) { g = pg8::Gemm{XB, Wt + OW_ABIN, T, 2560, 1024, 1024}; E.O = Z; E.ldc = 2560; E.qs_end = 512; E.qscale = 0.125f * LOG2E; }
                else if (ph == 1 || (ph == 10 && j == 1)) { const int l = (ph == 1) ? 0 : 1; g = pg8::Gemm{MN + (size_t)l * 1024 * 1024, Wt + l * LW + OW_KV, 1024, 1024, 1024, 1024}; E.O = KVMEM + (size_t)l * 1024 * 1024; E.ldc = 1024; E.rs = nullptr; rot = (ph == 1) ? 0 : 128; }
                else if (ph == 5 || ph == 14) { g = pg8::Gemm{XB, Wt + layer * LW + OW_Q, T, 512, 1024, 1024}; E.O = QX; E.ldc = 512; E.qs_end = 512; E.qscale = 0.08838834764831845f * LOG2E; }
                else if (ph == 8 || ph == 17) { g = pg8::Gemm{XB, Wt + layer * LW + OW_1, T, 4096, 1024, 1024}; E.O = Hb; E.ldc = 4096; E.act = 1; }
                else if (ph == 10) { g = pg8::Gemm{XB, Wt + OW_CDIN, T, 2304, 1024, 1024}; E.O = Z; E.ldc = 2304; E.qs_end = 512; E.qscale = 0.125f * LOG2E; E.rope = 1; E.rope_g = 68; E.ssq = SSQZ; E.ssq_stride = 72; }
                else if (ph == 11 && j == 0) { g = pg8::Gemm{Z + 1536, Wt + OW_UQ, T, 768, 384, 2304}; E.O = QD; E.ldc = 768; E.rs = SSQZ; E.rs_stride = 72; E.rs_off = 48; E.rs_n4 = 3; E.rs_inv = 1.f / 384.f;
                    E.qs_end = 768; E.qscale = 0.10206207261596577f * LOG2E; E.rope = 2; }
                else { g = pg8::Gemm{Z + 1920, Wt + OW_UKV, T, 1024, 256, 2304}; E.O = KVD; E.ldc = 1024; E.rs = SSQZ; E.rs_stride = 72; E.rs_off = 60; E.rs_n4 = 2; E.rs_inv = 1.f / 256.f; rot = 128; }
                pg8::StaticOrder S; S.init(g.M, g.N, G, (bid + rot) % G);
                pg8::gemm_phase<pg8::EpiZ>(lds, g, S, E);
            }
        }
        if ((PHMASK & 4) && (ph == 4 || ph == 7 || ph == 9 || ph == 13 || ph == 16 || ph == 18)) {
            pg8::Gemm g; pg8::EpiRes E; E.base = outp; E.out = outp; E.xb = XB; E.ssq = SSQX;
            if (ph == 4) { g = pg8::Gemm{Y, Wt + OW_ABOUT, T, 1024, 1024, 1024}; E.base = x_in; }
            else if (ph == 13) { g = pg8::Gemm{Y, Wt + OW_CDOUT, T, 1024, 1024, 1024}; }
            else if (ph == 7 || ph == 16) { g = pg8::Gemm{OX, Wt + layer * LW + OW_O, T, 1024, 512, 512}; }
            else { g = pg8::Gemm{Hb, Wt + layer * LW + OW_2, T, 1024, 4096, 4096}; }
            pg8::StaticOrder S; S.init(g.M, g.N, G, bid);
            pg8::gemm_phase<pg8::EpiRes>(lds, g, S, E);
        }
        if (ph == 2 && (PHMASK & 8)) {
            const int r32 = lane & 31, hi = lane >> 5;
            for (int u = vcu; u < 3072; u += G) {
                const int gp = u >> 10, v = u & 1023, bh = v >> 5, w = v & 31, b = bh >> 3, h = bh & 7;
                const int dil = (gp == 0) ? 1 : (gp == 1) ? 4 : 16, nu = 32 / dil, res = w / nu, n = w % nu;
                const bf16_t* base = Z + ((size_t)b * SEQ + res) * 2560 + h * 64;
                const long ld = 2560L * dil;
                f32x16 o[2]; float mr, lr;
                attn_core<64, 64, 64, true, true, true, 1, false>(lds, base, ld, base + 512, ld, base + 512, ld, base + 1024, ld, 256 * n, (4 * n - 2 < 0) ? 0 : 4 * n - 2, 4 * n + 4, 128, o, mr, lr);
                const float inv = 1.0f / lr;
                const int qrow = 256 * n + wave * 32 + r32;
                const size_t tok = (size_t)b * SEQ + res + (size_t)qrow * dil;
                bf16_t* op = OA + (size_t)gp * T * 512 + tok * 512 + h * 64;
#pragma unroll
                for (int d = 0; d < 2; ++d)
#pragma unroll
                    for (int i = 0; i < 4; ++i) { u32x2 wv; wv.x = pk2(o[d][4 * i] * inv, o[d][4 * i + 1] * inv); wv.y = pk2(o[d][4 * i + 2] * inv, o[d][4 * i + 3] * inv);
                        *(u32x2*)(op + 32 * d + 8 * i + 4 * hi) = wv; }
                if (hi == 0) LSE[(size_t)gp * T * 8 + tok * 8 + h] = mr + __builtin_amdgcn_logf(lr);
            }
            const float* cw = TOG(const float, args.in[14]); const float* cb = TOG(const float, args.in[15]); const float* lg = TOG(const float, args.in[16]); const float* lb = TOG(const float, args.in[17]);
            LAS float* gl = (LAS float*)lds;
            for (int cu = bid; cu < T / 32; cu += G) {
                const int t0 = cu * 32, bstart = (t0 / SEQ) * SEQ;
                for (int e = tid; e < 62 * 64; e += 512) {
                    const int row = e >> 6, ch = e & 63, tk = t0 - 30 + row;
                    f32x4 g0 = {0.f, 0.f, 0.f, 0.f}, g1 = g0;
                    if (tk >= bstart) {
                        const u32x4 uu = *(const u32x4*)(Z + (size_t)tk * 2560 + 1536 + ch * 8), gg = *(const u32x4*)(Z + (size_t)tk * 2560 + 2048 + ch * 8);
#pragma unroll
                        for (int q = 0; q < 4; ++q) {
                            const float u0 = bf2f(uu[q] & 0xffffu), u1 = bf2f(uu[q] >> 16), a0 = bf2f(gg[q] & 0xffffu), a1 = bf2f(gg[q] >> 16);
                            const float r0 = u0 * __builtin_amdgcn_rcpf(1.f + __expf(-a0)), r1 = u1 * __builtin_amdgcn_rcpf(1.f + __expf(-a1));
                            if (q < 2) { g0[2 * q] = r0; g0[2 * q + 1] = r1; } else { g1[2 * (q - 2)] = r0; g1[2 * (q - 2) + 1] = r1; }
                        }
                    }
                    *(LAS f32x4*)(gl + row * 512 + ch * 8) = g0; *(LAS f32x4*)(gl + row * 512 + ch * 8 + 4) = g1;
                }
                __syncthreads();
                {
                    float wv[31];
#pragma unroll
                    for (int j = 0; j < 31; ++j) wv[j] = cw[j * 512 + tid];
                    const float bias = cb[tid];
                    float res[32];
#pragma unroll
                    for (int blk = 0; blk < 4; ++blk) {
                        float in[38];
#pragma unroll
                        for (int j = 0; j < 38; ++j) in[j] = gl[(blk * 8 + j) * 512 + tid];
#pragma unroll
                        for (int i = 0; i < 8; ++i) { float a = bias;
#pragma unroll
                            for (int j = 0; j < 31; ++j) a += wv[j] * in[i + j];
                            res[blk * 8 + i] = a; }
                        __builtin_amdgcn_sched_barrier(0);
                    }
#pragma unroll
                    for (int i = 0; i < 32; ++i) gl[i * 512 + tid] = res[i];
                }
                __syncthreads();
#pragma unroll
                for (int k = 0; k < 4; ++k) {
                    const int tr = wave * 4 + k;
                    const f32x4 a = *(LAS f32x4*)(gl + tr * 512 + lane * 8), c = *(LAS f32x4*)(gl + tr * 512 + lane * 8 + 4);
                    const float mu = wave_sum((a.x + a.y) + (a.z + a.w) + (c.x + c.y) + (c.z + c.w)) * (1.f / 512.f);
                    const f32x4 da = a - mu, dc = c - mu;
                    const float var = wave_sum((da.x * da.x + da.y * da.y) + (da.z * da.z + da.w * da.w) + (dc.x * dc.x + dc.y * dc.y) + (dc.z * dc.z + dc.w * dc.w)) * (1.f / 512.f);
                    const float rstd = 1.0f / sqrtf(var + EPS);
                    const f32x4 ga = *(const f32x4*)(lg + lane * 8), gc = *(const f32x4*)(lg + lane * 8 + 4), ba = *(const f32x4*)(lb + lane * 8), bc = *(const f32x4*)(lb + lane * 8 + 4);
                    f32x4 ya = da * rstd * ga + ba, yc = dc * rstd * gc + bc;
#pragma unroll
                    for (int e = 0; e < 4; ++e) { ya[e] = ya[e] * __builtin_amdgcn_rcpf(1.f + __expf(-ya[e])); yc[e] = yc[e] * __builtin_amdgcn_rcpf(1.f + __expf(-yc[e])); }
                    u32x4 wv; wv.x = pk2(ya[0], ya[1]); wv.y = pk2(ya[2], ya[3]); wv.z = pk2(yc[0], yc[1]); wv.w = pk2(yc[2], yc[3]);
                    *(u32x4*)(Y + (size_t)(t0 + tr) * 1024 + 512 + lane * 8) = wv;
                }
                __syncthreads();
            }
        }
        if (ph == 3 && (PHMASK & 16)) {
            for (size_t i = (size_t)bid * 512 + tid; i < (size_t)T * 64; i += (size_t)G * 512) {
                const size_t tok = i >> 6; const int ch = (int)(i & 63), h = ch >> 3;
                const float l0 = LSE[tok * 8 + h], l1 = LSE[(size_t)T * 8 + tok * 8 + h], l2 = LSE[(size_t)2 * T * 8 + tok * 8 + h];
                const float mx = fmaxf(l0, fmaxf(l1, l2));
                float w0 = __builtin_amdgcn_exp2f(l0 - mx), w1 = __builtin_amdgcn_exp2f(l1 - mx), w2 = __builtin_amdgcn_exp2f(l2 - mx);
                const float inv = 1.0f / (w0 + w1 + w2); w0 *= inv; w1 *= inv; w2 *= inv;
                const u32x4 a = *(const u32x4*)(OA + tok * 512 + ch * 8), b = *(const u32x4*)(OA + (size_t)T * 512 + tok * 512 + ch * 8), c = *(const u32x4*)(OA + (size_t)2 * T * 512 + tok * 512 + ch * 8);
                u32x4 r;
#pragma unroll
                for (int q = 0; q < 4; ++q) {
                    const float lo = w0 * bf2f(a[q] & 0xffffu) + w1 * bf2f(b[q] & 0xffffu) + w2 * bf2f(c[q] & 0xffffu);
                    const float hh = w0 * bf2f(a[q] >> 16) + w1 * bf2f(b[q] >> 16) + w2 * bf2f(c[q] >> 16);
                    r[q] = pk2(lo, hh);
                }
                *(u32x4*)(Y + tok * 1024 + ch * 8) = r;
            }
        }
        if ((PHMASK & 32) && (ph == 6 || ph == 15)) {
            const int r32 = lane & 31, hi = lane >> 5;
            const bf16_t* KVl = KVMEM + (size_t)layer * 1024 * 1024;
            for (int u = vcu; u < 512; u += G) {
                const int bh = u >> 5, qb = u & 31, b = bh >> 2, h = bh & 3;
                const bf16_t* qp = QX + (size_t)b * SEQ * 512 + h * 128;
                const bf16_t* kp = KVl + (size_t)b * 256 * 1024 + h * 128;
                f32x16 o[4]; float mr, lr;
                attn_core<128, 128, 128, false, false, false, 1, false>(lds, qp, 512, kp, 1024, kp, 1024, kp + 512, 1024, 256 * qb, 0, 4, 1 << 30, o, mr, lr);
                const float inv = 1.0f / lr;
                bf16_t* op = OX + ((size_t)b * SEQ + 256 * qb + wave * 32 + r32) * 512 + h * 128;
#pragma unroll
                for (int d = 0; d < 4; ++d)
#pragma unroll
                    for (int i = 0; i < 4; ++i) { u32x2 wv; wv.x = pk2(o[d][4 * i] * inv, o[d][4 * i + 1] * inv); wv.y = pk2(o[d][4 * i + 2] * inv, o[d][4 * i + 3] * inv);
                        *(u32x2*)(op + 32 * d + 8 * i + 4 * hi) = wv; }
            }
        }
        if (ph == 12 && (PHMASK & 64)) {
            const int r32 = lane & 31, hi = lane >> 5;
            const float lam = MISC[0], osc = 0.64449093240903f;
            const float* sg = TOG(const float, args.in[24]);
#ifndef NO_C
            for (int p = vcu; p < 256; p += G) {
                const int bh = p >> 4, s = p & 15, b = bh >> 2, h = bh & 3;
                for (int half = 0; half < 2; ++half) {
                    const int qb = half ? 31 - s : s;
                    const size_t row = (size_t)b * SEQ + 256 * qb + wave * 32 + r32;
                    for (int mp = 0; mp < 2; ++mp) {
                        const bf16_t* zb = Z + (size_t)b * SEQ * 2304 + h * 128;
                        f32x16 o[4]; float mr, lr;
                        attn_core<64, 64, 128, true, false, true, 1, false>(lds, zb + mp * 64, 2304, zb + 512 + mp * 64, 2304, zb, 2304, zb + 1024, 2304, 256 * qb, 0, 4 * qb + 4, 1 << 30, o, mr, lr);
                        const float inv = 1.0f / lr;
                        float* sp = O1S + row * 512 + h * 128;
                        if (mp == 0) {
#pragma unroll
                            for (int d = 0; d < 4; ++d) {
#pragma unroll
                                for (int i = 0; i < 4; ++i) *(f32x4*)(sp + 32 * d + 8 * i + 4 * hi) = (f32x4){o[d][4 * i] * inv, o[d][4 * i + 1] * inv, o[d][4 * i + 2] * inv, o[d][4 * i + 3] * inv};
                                __builtin_amdgcn_sched_barrier(0); }
                        } else {
                            float ss = 0.f;
#pragma unroll
                            for (int d = 0; d < 4; ++d) {
#pragma unroll
                                for (int i = 0; i < 4; ++i) { const f32x4 a1 = *(const f32x4*)(sp + 32 * d + 8 * i + 4 * hi);
#pragma unroll
                                    for (int e = 0; e < 4; ++e) { const float dv = a1[e] - lam * (o[d][4 * i + e] * inv); o[d][4 * i + e] = dv; ss += dv * dv; } }
                                __builtin_amdgcn_sched_barrier(0); }
                            ss += __shfl_xor(ss, 32);
                            const float rn = osc / sqrtf(ss * (1.f / 128.f) + EPS);
                            bf16_t* op = Y + row * 1024 + h * 128;
#pragma unroll
                            for (int d = 0; d < 4; ++d) {
#pragma unroll
                                for (int i = 0; i < 4; ++i) { const f32x4 gg = *(const f32x4*)(sg + 32 * d + 8 * i + 4 * hi);
                                    u32x2 wv; wv.x = pk2(o[d][4 * i] * rn * gg[0], o[d][4 * i + 1] * rn * gg[1]); wv.y = pk2(o[d][4 * i + 2] * rn * gg[2], o[d][4 * i + 3] * rn * gg[3]);
                                    *(u32x2*)(op + 32 * d + 8 * i + 4 * hi) = wv; }
                                __builtin_amdgcn_sched_barrier(0); }
                        }
                    }
                }
            }
#endif
#ifndef NO_D
            for (int p = vcu; p < 512; p += G) {
                const int bh = p >> 4, s = p & 15, b = bh >> 3, h = bh & 7;
                for (int half = 0; half < 2; ++half) {
                    const int qb = half ? 31 - s : s;
                    const size_t row = (size_t)b * SEQ + 256 * qb + wave * 32 + r32;
                    f32x16 o[2]; float mr, lr;
                    attn_core<96, 64, 64, true, true, true, 1, false>(lds, QD + (size_t)b * SEQ * 768 + h * 96, 768, KVD + (size_t)b * SEQ * 1024 + h * 64, 1024, Z + (size_t)b * SEQ * 2304 + 2176, 2304,
                                                KVD + (size_t)b * SEQ * 1024 + 512 + h * 64, 1024, 256 * qb, 0, 4 * qb + 4, 1 << 30, o, mr, lr);
                    const float inv = 1.0f / lr;
                    bf16_t* op = Y + row * 1024 + 512 + h * 64;
#pragma unroll
                    for (int d = 0; d < 2; ++d)
#pragma unroll
                        for (int i = 0; i < 4; ++i) { u32x2 wv; wv.x = pk2(o[d][4 * i] * inv, o[d][4 * i + 1] * inv); wv.y = pk2(o[d][4 * i + 2] * inv, o[d][4 * i + 3] * inv);
                            *(u32x2*)(op + 32 * d + 8 * i + 4 * hi) = wv; }
                }
            }
#endif
        }
        if (ph == 19 && (PHMASK & 128)) {
            const float* fg = TOG(const float, args.in[30]);
            for (int m = gw; m < T; m += NGW) {
                float s = (lane < 16) ? SSQX[(size_t)m * 16 + lane] : 0.f;
                s = wave_sum(s);
                const float r = 1.0f / sqrtf(s * (1.f / D) + EPS);
                const u32x2* xr = (const u32x2*)(XB + (size_t)m * D) + lane; f32x4* orow = (f32x4*)(outp + (size_t)m * D) + lane; const f32x4* gr = (const f32x4*)fg + lane;
#pragma unroll
                for (int j = 0; j < 4; ++j) { const u32x2 w = xr[64 * j]; const f32x4 gg = gr[64 * j];
                    const f32x4 v = {bf2f(w.x & 0xffffu), bf2f(w.x >> 16), bf2f(w.y & 0xffffu), bf2f(w.y >> 16)}; orow[64 * j] = v * r * gg; }
            }
        }
        if (ph + 1 < args.ph_hi) {
            if (!posted) { grid.sync(); xbar = xcd_barrier_post(barw, bst); posted = true; }
            else xcd_barrier(xbar);
        }
        if (DUPMASK != 0) { if (((DUPMASK >> ph) & 1) && !rep) { rep = 1; --ph; } else rep = 0; }
    }
}

#ifndef MK_SPLIT
#define MK_SPLIT 0
#endif
extern "C" void kernel_launch(void* const* d_in, const int* in_sizes, int n_in, void* d_out, int out_size, void* d_ws, size_t ws_size, hipStream_t stream) {
    static int grid = 0;
    if (grid == 0) {
        if (n_in != 31 || ws_size < WS_END) { fprintf(stderr, "kernel_launch: unexpected n_in %d / ws %zu\n", n_in, ws_size); grid = -1; return; }
        int dev = 0, cus = 0, per_cu = 0;
        hipGetDevice(&dev);
        hipDeviceGetAttribute(&cus, hipDeviceAttributeMultiprocessorCount, dev);
        if (hipFuncSetAttribute((const void*)mk_fwd, hipFuncAttributeMaxDynamicSharedMemorySize, LDS_BYTES) != hipSuccess) { fprintf(stderr, "kernel_launch: hipFuncSetAttribute failed\n"); }
        if (hipOccupancyMaxActiveBlocksPerMultiprocessor(&per_cu, (const void*)mk_fwd, 512, LDS_BYTES) != hipSuccess || per_cu < 1) { fprintf(stderr, "kernel_launch: occupancy query gave %d\n", per_cu); per_cu = 1; }
        (void)hipGetLastError();
        grid = cus * per_cu;
        if (grid > 256) grid = 256;
        fprintf(stderr, "kernel_launch: grid %d (cus %d per_cu %d)\n", grid, cus, per_cu);
    }
    if (grid < 0) return;
    Args a{};
    for (int i = 0; i < 31; ++i) a.in[i] = d_in[i];
    a.out = (float*)d_out; a.ws = (unsigned char*)d_ws;
#if MK_SPLIT
    for (int ph = 0; ph < 20; ++ph) { a.ph_lo = ph; a.ph_hi = ph + 1; hipLaunchKernelGGL(mk_fwd, dim3(grid), dim3(512), LDS_BYTES, stream, a); }
#else
    a.ph_lo = 0; a.ph_hi = 20;
    void* kargs[] = {&a};
    hipError_t e = hipLaunchCooperativeKernel((const void*)mk_fwd, dim3(grid), dim3(512), kargs, LDS_BYTES, stream);
    if (e != hipSuccess) fprintf(stderr, "cooperative launch failed: %s (grid %d)\n", hipGetErrorString(e), grid);
#endif
}
```

```cpp
#include <hip/hip_runtime.h>
#include <hip/hip_cooperative_groups.h>
#include <cstdio>
#include <cstdint>
namespace cg = cooperative_groups;

#define LAS __attribute__((address_space(3)))
#define GAS __attribute__((address_space(1)))
#define TOG(T, p) ((T*)(GAS T*)(p))
typedef unsigned short bf16_t;
typedef short bf16x8 __attribute__((ext_vector_type(8)));
typedef short s16x4 __attribute__((ext_vector_type(4)));
typedef float f32x4 __attribute__((ext_vector_type(4)));
typedef float f32x16 __attribute__((ext_vector_type(16)));
typedef unsigned u32x4 __attribute__((ext_vector_type(4)));
typedef unsigned u32x2 __attribute__((ext_vector_type(2)));
typedef float f32x2_t __attribute__((ext_vector_type(2)));
typedef __bf16 bf16x2_t __attribute__((ext_vector_type(2)));

__device__ __forceinline__ unsigned pk2(float lo, float hi) { f32x2_t v = {lo, hi}; bf16x2_t b = __builtin_convertvector(v, bf16x2_t); return __builtin_bit_cast(unsigned, b); }
__device__ __forceinline__ float bf2f(unsigned h) { return __uint_as_float(h << 16); }

constexpr int NB = 4, SEQ = 8192, T = NB * SEQ, D = 1024;
constexpr float EPS = 1e-6f;
constexpr float LOG2E = 1.4426950408889634f;
constexpr float NEGBIG = -1e30f;

constexpr size_t MiB = 1u << 20;
constexpr size_t WS_W = 0, WS_XB = 56 * MiB, WS_BIG = 120 * MiB, WS_Y = 376 * MiB, WS_SMALL = 440 * MiB;
constexpr size_t WS_KVMEM = WS_SMALL, WS_MN = WS_SMALL + 4 * MiB, WS_SSQX = WS_SMALL + 8 * MiB, WS_SSQZ = WS_SMALL + 10 * MiB,
                 WS_ROPE = WS_SMALL + 20 * MiB, WS_LSE = WS_SMALL + 24 * MiB, WS_MISC = WS_SMALL + 28 * MiB, WS_END = WS_SMALL + 29 * MiB;
constexpr size_t M1 = 1048576;
constexpr size_t LW = 10 * M1, OW_Q = 0, OW_KV = M1 / 2, OW_O = M1 + M1 / 2, OW_1 = 2 * M1, OW_2 = 6 * M1;
constexpr size_t OW_ABIN = 20 * M1, OW_ABOUT = OW_ABIN + 2560 * 1024, OW_CDIN = OW_ABOUT + M1, OW_CDOUT = OW_CDIN + 2304 * 1024,
                 OW_UQ = OW_CDOUT + M1, OW_UKV = OW_UQ + 768 * 384, OW_END = OW_UKV + 1024 * 256;
static_assert(OW_END * 2 <= 56 * MiB, "weights");
constexpr size_t OB_Z = 0;
constexpr size_t OB_OA = 160 * MiB;
constexpr size_t OB_QD = 144 * MiB;
constexpr size_t OB_KVD = 192 * MiB;
constexpr size_t OB_H = 0;

constexpr int LDS_BYTES = 147456;
#ifndef PHMASK
#define PHMASK 0xFF
#endif
#ifndef DUPMASK
#define DUPMASK 0
#endif

namespace pg8 {
constexpr int BM = 256, BK = 64, HALF = 128, HTB = HALF * BK * 2, STAGE_BYTES = 8 * HTB, NXCD = 8, WGM = 8;
__host__ __device__ __forceinline__ int lds_byte(int r, int c) { const int st = (r >> 4) * 2 + (c >> 5), rr = r & 15, cc = c & 31, ob = rr * 64 + cc * 2; return st * 1024 + (ob ^ (((ob >> 9) & 1) << 5)); }
__host__ __device__ __forceinline__ void stage_rc(int b, int& R, int& C) { const int st = b / 1024, sb = b % 1024, swz = sb ^ (((sb >> 9) & 1) << 5); R = (st >> 1) * 16 + swz / 64; C = (st & 1) * 32 + (swz % 64) / 2; }
__host__ __device__ __forceinline__ int perm32(int rho) { const int n = rho >> 4, i = rho & 15; return 8 * (i >> 2) + 4 * n + (i & 3); }

struct Unit { int pm, pn; };
struct Gemm { const bf16_t* A; const bf16_t* Bt; int M, N, K, lda; };

struct StaticOrder {
    int nM, nN, nwg, G, c;
    __device__ void init(int M, int N, int G_, int c_) { nM = M / BM; nN = N / BM; nwg = nM * nN; G = G_; c = c_; }
    __device__ bool next(int i, Unit& u) const {
        const long L = (long)i * G + c; if (L >= nwg) return false;
        int wgid = (int)L; { const int q = nwg / NXCD, r = nwg % NXCD, xcd = wgid % NXCD, off = wgid / NXCD; wgid = (xcd < r ? xcd * (q + 1) : r * (q + 1) + (xcd - r) * q) + off; }
        const int nig = WGM * nN, gid = wgid / nig, fm = gid * WGM, gsz = (nM - fm) < WGM ? (nM - fm) : WGM;
        u.pm = fm + ((wgid % nig) % gsz); u.pn = (wgid % nig) / gsz; return true;
    }
};


struct EpiZ {
    static constexpr bool PERM = true;
    bf16_t* O; int ldc;
    const float* rs; int rs_stride, rs_off, rs_n4; float rs_inv;
    int qs_end; float qscale;
    int act;
    int rope, rope_g;
    const float* rcos; const float* rsin;
    float* ssq; int ssq_stride;
    __device__ __forceinline__ void operator()(const f32x4 (&acc)[2][2][4][2], const Unit& u, int wr, int wc, int fr, int fq) const {
        const int row0 = u.pm * BM + wr * 64 + fr;
#pragma unroll
        for (int ai = 0; ai < 2; ++ai)
#pragma unroll
            for (int m = 0; m < 4; ++m) {
                const int row = row0 + ai * HALF + m * 16;
                float r = 1.f;
                if (rs) { f32x4 s = {0.f, 0.f, 0.f, 0.f}; const float* p = rs + (size_t)row * rs_stride + rs_off;
                    for (int k = 0; k < rs_n4; ++k) s += *(const f32x4*)(p + 4 * k);
                    r = __builtin_amdgcn_rsqf(((s.x + s.y) + (s.z + s.w)) * rs_inv + EPS); }
#pragma unroll
                for (int bj = 0; bj < 2; ++bj) {
                    const int colg = u.pn * BM + bj * HALF + wc * 32, gidx = colg >> 5, col = colg + 8 * fq;
                    f32x4 v0 = acc[ai][bj][m][0] * r, v1 = acc[ai][bj][m][1] * r;
                    if (act == 1) {
#pragma unroll
                        for (int e = 0; e < 4; ++e) { float a = fmaxf(v0[e], 0.f), b = fmaxf(v1[e], 0.f); v0[e] = a * a; v1[e] = b * b; }
                    }
                    if (ssq) {
                        float ss = (v0[0] * v0[0] + v0[1] * v0[1]) + (v0[2] * v0[2] + v0[3] * v0[3]) + (v1[0] * v1[0] + v1[1] * v1[1]) + (v1[2] * v1[2] + v1[3] * v1[3]);
                        ss += __shfl_xor(ss, 16); ss += __shfl_xor(ss, 32);
                        if (fq == 0) ssq[(size_t)row * ssq_stride + gidx] = ss;
                    }
                    if (colg < qs_end) { v0 = v0 * qscale; v1 = v1 * qscale; }
                    const bool rg = (rope == 1) ? (gidx == rope_g) : ((rope == 2) ? (gidx % 3 == 2) : false);
                    if (rg) {
                        const int ci = 8 * (fq & 1);
                        const f32x4 c0 = *(const f32x4*)(rcos + (size_t)row * 16 + ci), c1 = *(const f32x4*)(rcos + (size_t)row * 16 + ci + 4);
                        const f32x4 s0 = *(const f32x4*)(rsin + (size_t)row * 16 + ci), s1 = *(const f32x4*)(rsin + (size_t)row * 16 + ci + 4);
                        const float sg = (fq < 2) ? -1.f : 1.f;
#pragma unroll
                        for (int e = 0; e < 4; ++e) {
                            const float p0 = __shfl_xor(v0[e], 32), p1 = __shfl_xor(v1[e], 32);
                            v0[e] = v0[e] * c0[e] + sg * p0 * s0[e];
                            v1[e] = v1[e] * c1[e] + sg * p1 * s1[e];
                        }
                    }
                    u32x4 w; w.x = pk2(v0[0], v0[1]); w.y = pk2(v0[2], v0[3]); w.z = pk2(v1[0], v1[1]); w.w = pk2(v1[2], v1[3]);
                    *(u32x4*)(O + (size_t)row * ldc + col) = w;
                }
            }
    }
};
struct EpiRes {
    static constexpr bool PERM = false;
    const float* base32; const bf16_t* base16; bf16_t* xb; float* ssq;
    __device__ __forceinline__ void operator()(const f32x4 (&acc)[2][2][4][2], const Unit& u, int wr, int wc, int fr, int fq) const {
        const int row0 = u.pm * BM + wr * 64 + fr;
#pragma unroll
        for (int ai = 0; ai < 2; ++ai)
#pragma unroll
            for (int m = 0; m < 4; ++m) {
                const int row = row0 + ai * HALF + m * 16; float ss = 0.f;
#pragma unroll
                for (int bj = 0; bj < 2; ++bj)
#pragma unroll
                    for (int n = 0; n < 2; ++n) {
                        const size_t off = (size_t)row * D + u.pn * BM + bj * HALF + wc * 32 + 16 * n + 4 * fq;
                        f32x4 bv;
                        if (base32) bv = *(const f32x4*)(base32 + off);
                        else { const u32x2 bw = *(const u32x2*)(base16 + off); bv = (f32x4){bf2f(bw.x & 0xffffu), bf2f(bw.x >> 16), bf2f(bw.y & 0xffffu), bf2f(bw.y >> 16)}; }
                        const f32x4 v = bv + acc[ai][bj][m][n];
                        u32x2 w; w.x = pk2(v[0], v[1]); w.y = pk2(v[2], v[3]); *(u32x2*)(xb + off) = w;
                        ss += (v[0] * v[0] + v[1] * v[1]) + (v[2] * v[2] + v[3] * v[3]);
                    }
                ss += __shfl_xor(ss, 16); ss += __shfl_xor(ss, 32);
                if (fq == 0) ssq[(size_t)row * 16 + u.pn * 4 + wc] = ss;
            }
    }
};

template <class Epi>
__device__ __forceinline__ void gemm_phase(LAS unsigned char* lds, const Gemm g, const StaticOrder& S, const Epi& E) {
    int tid = threadIdx.x; asm volatile("" : "+v"(tid));
    const int wid = __builtin_amdgcn_readfirstlane(tid >> 6), lane = tid & 63, wr = wid >> 2, wc = wid & 3, fr = lane & 15, fq = lane >> 4;
    const int K = g.K, nt = K / BK, lda = g.lda;
    unsigned voffA[2], voffB[2];
#pragma unroll
    for (int i = 0; i < 2; ++i) { int R, C; stage_rc(tid * 16 + i * 8192, R, C); const int Rb = Epi::PERM ? ((R & ~31) + perm32(R & 31)) : R;
        voffA[i] = (unsigned)(R * lda + C) * 2u; voffB[i] = (unsigned)(Rb * K + C) * 2u; }
    const size_t kstep = (size_t)(BK * 2);
    const size_t hstepA = (size_t)HALF * lda * 2, hstepB = (size_t)HALF * K * 2;
    const size_t tstepA = 2 * hstepA, tstepB = 2 * hstepB;
    const unsigned ldsw = (unsigned)wid * 1024u;
    const int aoff = lds_byte(wr * 64 + fr, fq * 8), boff = lds_byte(wc * 32 + fr, fq * 8);
#define PG8_SA(b, h) (((b) * 2 + (h)) * HTB)
#define PG8_SB(b, h) ((4 + (b) * 2 + (h)) * HTB)
#define PG8_STAGE(bufoff, gbase, voff) do { _Pragma("unroll") for (int _i = 0; _i < 2; ++_i) \
        __builtin_amdgcn_global_load_lds((const unsigned*)((const char*)(gbase) + (voff)[_i]), (LAS unsigned*)(lds + (bufoff) + ldsw + _i * 8192), 16, 0, 0); } while (0)
#define PG8_LDA(dst, b, h) do { _Pragma("unroll") for (int m = 0; m < 4; ++m) _Pragma("unroll") for (int k = 0; k < 2; ++k) dst[m][k] = *(const LAS bf16x8*)(lds + PG8_SA(b, h) + aoff + m * 2048 + k * 1024); } while (0)
#define PG8_LDB(dst, b, h) do { _Pragma("unroll") for (int n = 0; n < 2; ++n) _Pragma("unroll") for (int k = 0; k < 2; ++k) dst[n][k] = *(const LAS bf16x8*)(lds + PG8_SB(b, h) + boff + n * 2048 + k * 1024); } while (0)
#define PG8_MMA(ai, bj, At, Bt) do { __builtin_amdgcn_s_setprio(1); _Pragma("unroll") for (int m = 0; m < 4; ++m) _Pragma("unroll") for (int n = 0; n < 2; ++n) _Pragma("unroll") for (int k = 0; k < 2; ++k) \
        acc[ai][bj][m][n] = __builtin_amdgcn_mfma_f32_16x16x32_bf16(Bt[n][k], At[m][k], acc[ai][bj][m][n], 0, 0, 0); __builtin_amdgcn_s_setprio(0); } while (0)
#define PG8_WAIT_V(n) asm volatile("s_waitcnt vmcnt(" #n ")" ::: "memory")
#define PG8_WAIT_L(n) asm volatile("s_waitcnt lgkmcnt(" #n ")" ::: "memory")
#define PG8_BAR __builtin_amdgcn_s_barrier()
#define PG8_SCHED __builtin_amdgcn_sched_barrier(0)
    Unit cur, nxt; int ui = 0;
    if (!S.next(0, cur)) return;
    f32x4 acc[2][2][4][2];
#pragma unroll
    for (int a = 0; a < 2; ++a)
#pragma unroll
        for (int b = 0; b < 2; ++b)
#pragma unroll
            for (int m = 0; m < 4; ++m)
#pragma unroll
                for (int n = 0; n < 2; ++n) acc[a][b][m][n] = (f32x4){0.f, 0.f, 0.f, 0.f};
    bf16x8 At[4][2], B0[2][2], B1[2][2];
    const char* cA = (const char*)g.A + (size_t)cur.pm * tstepA; const char* cB = (const char*)g.Bt + (size_t)cur.pn * tstepB;
    PG8_STAGE(PG8_SB(0, 0), cB, voffB); PG8_STAGE(PG8_SB(0, 1), cB + hstepB, voffB); PG8_STAGE(PG8_SA(0, 0), cA, voffA); PG8_STAGE(PG8_SA(0, 1), cA + hstepA, voffA);
    if (wr == 1) PG8_BAR;
    PG8_WAIT_V(2); PG8_BAR;
    PG8_STAGE(PG8_SB(1, 0), cB + kstep, voffB); PG8_STAGE(PG8_SA(1, 0), cA + kstep, voffA); PG8_STAGE(PG8_SB(1, 1), cB + hstepB + kstep, voffB);
    PG8_WAIT_V(6); PG8_BAR;
    for (;;) {
        const bool has_next = S.next(ui + 1, nxt);
        const char* nA = has_next ? (const char*)g.A + (size_t)nxt.pm * tstepA : cA; const char* nB = has_next ? (const char*)g.Bt + (size_t)nxt.pn * tstepB : cB;
        for (int t = 0; t < nt; t += 2) {
            const bool last = (t == nt - 2);
            const char* a1 = cA + (size_t)(t + 1) * kstep;
            const char* a2 = last ? nA : cA + (size_t)(t + 2) * kstep; const char* b2 = last ? nB : cB + (size_t)(t + 2) * kstep;
            const char* a3 = a2 + kstep; const char* b3 = b2 + kstep;
            PG8_LDB(B0, 0, 0); PG8_LDB(B1, 0, 1); PG8_SCHED; PG8_LDA(At, 0, 0); PG8_STAGE(PG8_SA(1, 1), a1 + hstepA, voffA);
            PG8_WAIT_V(8); PG8_WAIT_L(0); PG8_BAR; PG8_MMA(0, 0, At, B0); PG8_MMA(0, 1, At, B1); PG8_BAR; PG8_SCHED;
            PG8_LDA(At, 0, 1); PG8_STAGE(PG8_SB(0, 0), b2, voffB); PG8_STAGE(PG8_SB(0, 1), b2 + hstepB, voffB); PG8_STAGE(PG8_SA(0, 0), a2, voffA);
            PG8_WAIT_V(8); PG8_WAIT_L(0); PG8_BAR; PG8_MMA(1, 0, At, B0); PG8_MMA(1, 1, At, B1); PG8_BAR; PG8_SCHED;
            PG8_LDB(B0, 1, 0); PG8_LDB(B1, 1, 1); PG8_SCHED; PG8_LDA(At, 1, 0); PG8_STAGE(PG8_SA(0, 1), a2 + hstepA, voffA);
            PG8_WAIT_V(8); PG8_WAIT_L(0); PG8_BAR; PG8_MMA(0, 0, At, B0); PG8_MMA(0, 1, At, B1); PG8_BAR; PG8_SCHED;
            PG8_LDA(At, 1, 1); PG8_STAGE(PG8_SB(1, 0), b3, voffB); PG8_STAGE(PG8_SB(1, 1), b3 + hstepB, voffB); PG8_STAGE(PG8_SA(1, 0), a3, voffA);
            PG8_WAIT_V(8); PG8_WAIT_L(0); PG8_BAR; PG8_MMA(1, 0, At, B0); PG8_MMA(1, 1, At, B1); PG8_BAR; PG8_SCHED;
        }
        if (wr == 0) PG8_BAR;
        E(acc, cur, wr, wc, fr, fq);
        if (!has_next) break;
#pragma unroll
        for (int a = 0; a < 2; ++a)
#pragma unroll
            for (int b = 0; b < 2; ++b)
#pragma unroll
                for (int m = 0; m < 4; ++m)
#pragma unroll
                    for (int n = 0; n < 2; ++n) acc[a][b][m][n] = (f32x4){0.f, 0.f, 0.f, 0.f};
        cur = nxt; cA = nA; cB = nB; ++ui;
        if (wr == 1) PG8_BAR;
    }
    PG8_WAIT_V(0);
    PG8_BAR;
#undef PG8_SA
#undef PG8_SB
#undef PG8_STAGE
#undef PG8_LDA
#undef PG8_LDB
#undef PG8_MMA
#undef PG8_WAIT_V
#undef PG8_WAIT_L
#undef PG8_BAR
#undef PG8_SCHED
}
}

template <int VS, int D> __device__ __forceinline__ void tr_block(unsigned a, s16x4 (&l)[4], s16x4 (&h)[4]) {
    asm volatile("ds_read_b64_tr_b16 %0, %1 offset:%2" : "=v"(l[0]) : "v"(a), "i"(0 * VS + D * 64) : "memory");
    asm volatile("ds_read_b64_tr_b16 %0, %1 offset:%2" : "=v"(h[0]) : "v"(a), "i"(4 * VS + D * 64) : "memory");
    asm volatile("ds_read_b64_tr_b16 %0, %1 offset:%2" : "=v"(l[1]) : "v"(a), "i"(16 * VS + D * 64) : "memory");
    asm volatile("ds_read_b64_tr_b16 %0, %1 offset:%2" : "=v"(h[1]) : "v"(a), "i"(20 * VS + D * 64) : "memory");
    asm volatile("ds_read_b64_tr_b16 %0, %1 offset:%2" : "=v"(l[2]) : "v"(a), "i"(32 * VS + D * 64) : "memory");
    asm volatile("ds_read_b64_tr_b16 %0, %1 offset:%2" : "=v"(h[2]) : "v"(a), "i"(36 * VS + D * 64) : "memory");
    asm volatile("ds_read_b64_tr_b16 %0, %1 offset:%2" : "=v"(l[3]) : "v"(a), "i"(48 * VS + D * 64) : "memory");
    asm volatile("ds_read_b64_tr_b16 %0, %1 offset:%2" : "=v"(h[3]) : "v"(a), "i"(52 * VS + D * 64) : "memory");
}
#define TR_WAIT8(l, h) asm volatile("s_waitcnt lgkmcnt(8)" : "+v"(l[0]), "+v"(l[1]), "+v"(l[2]), "+v"(l[3]), "+v"(h[0]), "+v"(h[1]), "+v"(h[2]), "+v"(h[3]) :: "memory")
#define TR_WAIT0(l, h) asm volatile("s_waitcnt lgkmcnt(0)" : "+v"(l[0]), "+v"(l[1]), "+v"(l[2]), "+v"(l[3]), "+v"(h[0]), "+v"(h[1]), "+v"(h[2]), "+v"(h[3]) :: "memory")
#define PV4(d, l, h) do { _Pragma("unroll") for (int cc = 0; cc < 4; ++cc) { \
        const bf16x8 vf = (bf16x8){l[cc][0], l[cc][1], l[cc][2], l[cc][3], h[cc][0], h[cc][1], h[cc][2], h[cc][3]}; \
        o[d] = __builtin_amdgcn_mfma_f32_32x32x16_bf16(vf, __builtin_bit_cast(bf16x8, pw[cc]), o[d], 0, 0, 0); } } while (0)

__device__ __forceinline__ float fadd_s(float a, float b) { float r; asm("v_add_f32_e32 %0, %1, %2" : "=v"(r) : "v"(a), "v"(b)); return r; }
template <int DK, int DK1, int DV, bool MASK, bool NEGM = true, bool PF2 = false, int VAH = 1, bool SHIFT = false>
__device__ __forceinline__ void attn_core(LAS unsigned char* lds,
        const bf16_t* Qp, long ldq, const bf16_t* K1p, long ldk1, const bf16_t* K2p, long ldk2, const bf16_t* Vp, long ldv,
        int q0, int kt0, int kt1, int W, f32x16 (&o)[DV / 32], float& m_out, float& l_out) {
    constexpr int KS = DK * 2 + 16, VS = DV * 2 + 64, KBUF = 64 * KS, VBUF = 64 * VS;
    constexpr int KCH1 = DK1 / 8, NKC1 = 64 * KCH1, KPT1 = (NKC1 + 511) / 512, KCH2 = (DK - DK1) / 8, NKC2 = 64 * KCH2, KPT2 = (NKC2 + 511) / 512, KPT = KPT1 + KPT2;
    constexpr int VCH = DV / 8, NVC = 64 * VCH, VPT = (NVC + 511) / 512;
    static_assert(3 * KBUF + 3 * VBUF <= 131072, "attn lds");
    int tid = threadIdx.x; asm volatile("" : "+v"(tid));
    const int lane = tid & 63, wid = __builtin_amdgcn_readfirstlane(tid >> 6), r32 = lane & 31, hi = lane >> 5;
    LAS unsigned char* kbuf = lds; LAS unsigned char* vbuf = lds + 3 * KBUF;
    const int qlo = q0 + wid * 32, qrow = qlo + r32;
    bf16x8 qf[DK / 16];
#pragma unroll
    for (int c = 0; c < DK / 16; ++c) qf[c] = *(const bf16x8*)(Qp + (long)qrow * ldq + 16 * c + 8 * hi);
#pragma unroll
    for (int d = 0; d < DV / 32; ++d) o[d] = f32x16{};
    float mrun = 0.f, lrun = 0.f;
    u32x4 kreg0[KPT], vreg0[VPT], kreg1[KPT], vreg1[VPT];
#pragma unroll
    for (int i = 0; i < KPT; ++i) { kreg0[i] = (u32x4){0u, 0u, 0u, 0u}; kreg1[i] = kreg0[i]; }
#pragma unroll
    for (int i = 0; i < VPT; ++i) { vreg0[i] = (u32x4){0u, 0u, 0u, 0u}; vreg1[i] = vreg0[i]; }
    unsigned kgo[KPT], vgo[VPT]; int klo_[KPT], vlo_[VPT];
#pragma unroll
    for (int i = 0; i < KPT1; ++i) { const int e = (tid + 512 * i) % NKC1, row = e / KCH1, ch = e % KCH1; kgo[i] = (unsigned)(row * (int)ldk1 + ch * 8) * 2u; klo_[i] = row * KS + ch * 16; }
#pragma unroll
    for (int i = 0; i < KPT2; ++i) { const int e = (tid + 512 * i) % (NKC2 ? NKC2 : 1), row = e / (KCH2 ? KCH2 : 1), ch = e % (KCH2 ? KCH2 : 1); kgo[KPT1 + i] = (unsigned)(row * (int)ldk2 + ch * 8) * 2u; klo_[KPT1 + i] = row * KS + (KCH1 + ch) * 16; }
#pragma unroll
    for (int i = 0; i < VPT; ++i) { const int e = (tid + 512 * i) % NVC, row = e / VCH, ch = e % VCH; vgo[i] = (unsigned)(row * (int)ldv + ch * 8) * 2u; vlo_[i] = row * VS + ch * 16; }
#define ATT_LOAD(t, kreg, vreg) do { \
    const char* k1t_ = (const char*)(K1p + 64L * (t) * ldk1); const char* k2t_ = (const char*)(K2p + 64L * (t) * ldk2); const char* vt_ = (const char*)(Vp + 64L * (t) * ldv); \
    _Pragma("unroll") for (int i_ = 0; i_ < KPT1; ++i_) { kreg[i_] = *(const u32x4*)(k1t_ + (size_t)kgo[i_]); } \
    _Pragma("unroll") for (int i_ = 0; i_ < KPT2; ++i_) { kreg[KPT1 + i_] = *(const u32x4*)(k2t_ + (size_t)kgo[KPT1 + i_]); } \
    _Pragma("unroll") for (int i_ = 0; i_ < VPT; ++i_) { vreg[i_] = *(const u32x4*)(vt_ + (size_t)vgo[i_]); } } while (0)
#define ATT_STORE(b) do { \
    _Pragma("unroll") for (int i_ = 0; i_ < KPT1; ++i_) { if ((NKC1 % 512 == 0) || tid + 512 * i_ < NKC1) *(LAS u32x4*)(kbuf + (b) * KBUF + klo_[i_]) = kreg[i_]; } \
    _Pragma("unroll") for (int i_ = 0; i_ < KPT2; ++i_) { if ((NKC2 % 512 == 0) || tid + 512 * i_ < NKC2) *(LAS u32x4*)(kbuf + (b) * KBUF + klo_[KPT1 + i_]) = kreg[KPT1 + i_]; } \
    _Pragma("unroll") for (int i_ = 0; i_ < VPT; ++i_) { if ((NVC % 512 == 0) || tid + 512 * i_ < NVC) *(LAS u32x4*)(vbuf + (b) * VBUF + vlo_[i_]) = vreg[i_]; } } while (0)
#define ATT_STOREKV(kb_, vb_, kreg, vreg) do { \
    _Pragma("unroll") for (int i_ = 0; i_ < KPT1; ++i_) { if ((NKC1 % 512 == 0) || tid + 512 * i_ < NKC1) *(LAS u32x4*)(kbuf + (kb_) * KBUF + klo_[i_]) = kreg[i_]; } \
    _Pragma("unroll") for (int i_ = 0; i_ < KPT2; ++i_) { if ((NKC2 % 512 == 0) || tid + 512 * i_ < NKC2) *(LAS u32x4*)(kbuf + (kb_) * KBUF + klo_[KPT1 + i_]) = kreg[KPT1 + i_]; } \
    _Pragma("unroll") for (int i_ = 0; i_ < VPT; ++i_) { if ((NVC % 512 == 0) || tid + 512 * i_ < NVC) *(LAS u32x4*)(vbuf + (vb_) * VBUF + vlo_[i_]) = vreg[i_]; } } while (0)
    ATT_LOAD(kt0, kreg0, vreg0); ATT_STOREKV(0, 0, kreg0, vreg0);
    if (PF2) ATT_LOAD((kt0 + 1 < kt1 ? kt0 + 1 : kt1 - 1), kreg1, vreg1);
    __syncthreads();
    const int pr = (r32 & 0x13) | ((r32 & 8) >> 1) | ((r32 & 4) << 1);
    const int koff = pr * KS + hi * 16;
    const int voff = (8 * hi + ((lane & 15) >> 2)) * VS + (16 * ((lane >> 4) & 1) + 4 * (lane & 3)) * 2;
    int ta = kt0, tb = kt1;
    if (MASK) { int lo = (qlo - W) >> 6; if (qlo - W < 0) lo = 0; if (lo > ta) ta = lo; const int hi_t = ((qlo + 31) >> 6) + 1; if (hi_t < tb) tb = hi_t; }
    constexpr int NQ = 2 * (DK / 16), NPV = 4 * (DV / 32), VA = (36 + NQ - 1) / NQ, VC = 32 / NPV;
    f32x16 negm = f32x16{};
    f32x16 sA0 = f32x16{}, sA1 = f32x16{};
    u32x4 pw[4];
#pragma unroll
    for (int i = 0; i < 4; ++i) pw[i] = (u32x4){0u, 0u, 0u, 0u};
    s16x4 va_l[4], va_h[4], vb_l[4], vb_h[4];
#pragma unroll
    for (int i = 0; i < 4; ++i) { va_l[i] = (s16x4){0, 0, 0, 0}; va_h[i] = va_l[i]; vb_l[i] = va_l[i]; vb_h[i] = va_l[i]; }
    bool has_pend = false, started = false;
    int kb_cur = 0, vb_cur = 0, vb_prev = 0;
#define ATT_X1(t, S0, S1) do { if (doqk_) { \
                if (NEGM) { S0 = negm; S1 = negm; } else { S0 = f32x16{}; S1 = f32x16{}; } \
                const LAS unsigned char* kb = kbuf + kb_cur * KBUF + koff; \
                bf16x8 ka0 = *(const LAS bf16x8*)(kb), ka1 = *(const LAS bf16x8*)(kb + 32 * KS); \
                __builtin_amdgcn_s_setprio(1); \
                _Pragma("unroll") for (int c = 0; c < DK / 16; ++c) { \
                    bf16x8 kn0 = ka0, kn1 = ka1; \
                    if (c + 1 < DK / 16) { kn0 = *(const LAS bf16x8*)(kb + (c + 1) * 32); kn1 = *(const LAS bf16x8*)(kb + 32 * KS + (c + 1) * 32); } \
                    S0 = __builtin_amdgcn_mfma_f32_32x32x16_bf16(ka0, qf[c], S0, 0, 0, 0); \
                    S1 = __builtin_amdgcn_mfma_f32_32x32x16_bf16(ka1, qf[c], S1, 0, 0, 0); \
                    __builtin_amdgcn_sched_barrier(0); \
                    ka0 = kn0; ka1 = kn1; } \
                __builtin_amdgcn_s_setprio(0); \
                if (!NEGM) { _Pragma("unroll") for (int r = 0; r < 16; ++r) { S0[r] -= mrun; S1[r] -= mrun; } } \
            } } while (0)
#define ATT_X2(P0, P1) do { if (dopv_) { \
                float rs0_ = P0[0], rs1_ = P1[0], rs2_ = P0[1], rs3_ = P1[1]; \
                _Pragma("unroll") for (int r = 2; r < 16; r += 2) { rs0_ = fadd_s(rs0_, P0[r]); rs1_ = fadd_s(rs1_, P1[r]); rs2_ = fadd_s(rs2_, P0[r + 1]); rs3_ = fadd_s(rs3_, P1[r + 1]); } \
                lrun += (rs0_ + rs1_) + (rs2_ + rs3_); \
                u32x4 w; \
                w.x = pk2(P0[0], P0[1]); w.y = pk2(P0[2], P0[3]); w.z = pk2(P0[4], P0[5]); w.w = pk2(P0[6], P0[7]); pw[0] = w; \
                w.x = pk2(P0[8], P0[9]); w.y = pk2(P0[10], P0[11]); w.z = pk2(P0[12], P0[13]); w.w = pk2(P0[14], P0[15]); pw[1] = w; \
                w.x = pk2(P1[0], P1[1]); w.y = pk2(P1[2], P1[3]); w.z = pk2(P1[4], P1[5]); w.w = pk2(P1[6], P1[7]); pw[2] = w; \
                w.x = pk2(P1[8], P1[9]); w.y = pk2(P1[10], P1[11]); w.z = pk2(P1[12], P1[13]); w.w = pk2(P1[14], P1[15]); pw[3] = w; \
            } } while (0)
#define ATT_X3(t, S0, S1) do { if (doqk_) { \
                const int klo = 64 * (t); \
                if (MASK && ((klo + 63 > qlo) || (klo < qlo + 31 - W))) { \
                    const int rel = qrow - klo - 8 * hi, rel2 = rel - W; \
                    _Pragma("unroll") for (int r = 0; r < 16; ++r) { const int i = r >> 2, j = r & 3; const int c0 = 16 * (i >> 1) + 4 * (i & 1) + j, c1 = c0 + 32; \
                        S0[r] = (c0 <= rel && c0 >= rel2) ? S0[r] : NEGBIG; S1[r] = (c1 <= rel && c1 >= rel2) ? S1[r] : NEGBIG; } \
                } \
                float rm = fmaxf(fmaxf(S0[0], S1[0]), S0[1]); \
                _Pragma("unroll") for (int r = 1; r < 15; r += 2) { rm = fmaxf(fmaxf(rm, S1[r]), S0[r + 1]); rm = fmaxf(fmaxf(rm, S1[r + 1]), S0[r + 2 > 15 ? 15 : r + 2]); } \
                rm = fmaxf(rm, S1[15]); \
                { auto rr_ = __builtin_amdgcn_permlane32_swap(__float_as_uint(rm), __float_as_uint(rm), false, false); rm = fmaxf(__uint_as_float(rr_[0]), __uint_as_float(rr_[1])); } \
                const float dl = started ? ((rm > 8.f) ? rm : 0.f) : rm; \
                if (__builtin_amdgcn_ballot_w64(dl != 0.f) != 0ull) { \
                    mrun += dl; \
                    _Pragma("unroll") for (int r = 0; r < 16; ++r) { S0[r] -= dl; S1[r] -= dl; } \
                    if (NEGM) { _Pragma("unroll") for (int r = 0; r < 16; ++r) negm[r] = -mrun; } \
                    if (started) { fsc_ = __builtin_amdgcn_exp2f(-dl); lrun *= fsc_; resc_ = true; } \
                } \
            } } while (0)
#define ATT_X4() do { if (dopv_) { \
                const unsigned va_ = (unsigned)(size_t)(vbuf + vb_prev * VBUF + voff); \
                __builtin_amdgcn_s_setprio(1); \
                tr_block<VS, 0>(va_, va_l, va_h); \
                tr_block<VS, 1>(va_, vb_l, vb_h); \
                if (DV == 64) { TR_WAIT8(va_l, va_h); PV4(0, va_l, va_h); TR_WAIT0(vb_l, vb_h); PV4(1, vb_l, vb_h); } \
                else { TR_WAIT8(va_l, va_h); PV4(0, va_l, va_h); \
                    tr_block<VS, 2>(va_, va_l, va_h); TR_WAIT8(vb_l, vb_h); PV4(1, vb_l, vb_h); \
                    tr_block<VS, 3>(va_, vb_l, vb_h); TR_WAIT8(va_l, va_h); PV4(DV == 64 ? 0 : 2, va_l, va_h); \
                    TR_WAIT0(vb_l, vb_h); PV4(DV == 64 ? 1 : 3, vb_l, vb_h); } \
                __builtin_amdgcn_s_setprio(0); \
            } } while (0)
#define ATT_X5(S0, S1) do { if (doqk_) { \
                _Pragma("unroll") for (int r = 0; r < 16; ++r) { S0[r] = __builtin_amdgcn_exp2f(S0[r]); S1[r] = __builtin_amdgcn_exp2f(S1[r]); } \
            } } while (0)
#define ATT_STEP(t, KL, VL, KST, VST) do { \
        const bool more_ = ((t) + 1 < kt1); \
        { const int tl_ = (t) + (PF2 ? 2 : 1); ATT_LOAD((tl_ < kt1 ? tl_ : kt1 - 1), KL, VL); }     \
        __builtin_amdgcn_sched_barrier(0);     \
        const bool doqk_ = ((t) >= ta) && ((t) < tb); \
        const bool dopv_ = has_pend; \
        float fsc_ = 1.f; bool resc_ = false; \
        ATT_X2(sA0, sA1); ATT_X4(); \
        const int sl_n_ = (kb_cur == 2) ? 0 : kb_cur + 1; \
        if (grp2) { asm volatile("s_waitcnt lgkmcnt(0)" ::: "memory"); __builtin_amdgcn_s_barrier(); asm volatile("" ::: "memory"); } \
        ATT_X1(t, sA0, sA1); ATT_X3(t, sA0, sA1); ATT_X5(sA0, sA1); \
        if (resc_) { \
            _Pragma("unroll") for (int d = 0; d < DV / 32; ++d) _Pragma("unroll") for (int r = 0; r < 16; ++r) o[d][r] *= fsc_; \
        } \
        has_pend = doqk_; started = started || doqk_; \
        __builtin_amdgcn_sched_barrier(0); \
        ATT_STOREKV(sl_n_, sl_n_, KST, VST); \
        vb_prev = kb_cur; kb_cur = sl_n_; \
        if (!grp2) { asm volatile("s_waitcnt lgkmcnt(0)" ::: "memory"); __builtin_amdgcn_s_barrier(); asm volatile("" ::: "memory"); } \
    } while (0)
    const bool grp2 = SHIFT && (wid >= 4);
    for (int t = kt0; t <= kt1; t += 2) {
        if (PF2) { ATT_STEP(t, kreg0, vreg0, kreg1, vreg1); if (t + 1 <= kt1) ATT_STEP(t + 1, kreg1, vreg1, kreg0, vreg0); }
        else { ATT_STEP(t, kreg0, vreg0, kreg0, vreg0); if (t + 1 <= kt1) ATT_STEP(t + 1, kreg0, vreg0, kreg0, vreg0); }
    }
#undef ATT_STEP
#undef ATT_X1
#undef ATT_X2
#undef ATT_X3
#undef ATT_X4
#undef ATT_X5
#undef ATT_STOREKV
#undef ATT_LOAD
#undef ATT_STORE
    lrun += __shfl_xor(lrun, 32);
    m_out = mrun; l_out = lrun;
}

#define XB_TMO      128
#define XB_XCNT(j)  (256  + 64 * (j))
#define XB_XSUB(j)  (1280 + 64 * (j))
#define XB_XGEN(j)  (2304 + 64 * (j))
#define XB_TOP      3328
#define XB_TOPGEN   3392
#define XCD_BAR_WORDS 3456
#define XB_SPIN_CAP (1u << 20)
__device__ __forceinline__ unsigned xb_ld(unsigned* p)              { return __hip_atomic_load(p, __ATOMIC_RELAXED, __HIP_MEMORY_SCOPE_AGENT); }
__device__ __forceinline__ unsigned xb_add(unsigned* p, unsigned v) { return __hip_atomic_fetch_add(p, v, __ATOMIC_RELAXED, __HIP_MEMORY_SCOPE_AGENT); }
__device__ __forceinline__ unsigned xb_xcc_id() { return (unsigned)__builtin_amdgcn_s_getreg((3 << 11) | 20) & 0xFu; }
#define XB_SPIN(cond, bar) do { unsigned _sp = 0; while (cond) { __builtin_amdgcn_s_sleep(1); \
    if ((++_sp & 255u) == 0u) { if (xb_ld(&(bar)[XB_TMO])) break; if (_sp > XB_SPIN_CAP) { atomicAdd(&(bar)[XB_TMO], 1u); break; } } } } while (0)
struct XcdBarrier { unsigned* bar; unsigned x; volatile LAS unsigned* st; };
__device__ __forceinline__ XcdBarrier xcd_barrier_post(unsigned* bar, volatile LAS unsigned* st) {
    XcdBarrier b; b.bar = bar; b.x = xb_xcc_id(); b.st = st;
    if (threadIdx.x == 0) (void)xb_add(&bar[XB_XCNT(b.x)], 1u);
    return b;
}
__device__ __forceinline__ void xcd_barrier_complete(unsigned* bar, unsigned x, unsigned& nloc, unsigned& nx) {
    const unsigned G = gridDim.x * gridDim.y * gridDim.z;
    unsigned sum, cnt, mine, sp = 0u;
    for (;;) {
        sum = 0u; cnt = 0u; mine = 0u;
#pragma unroll
        for (unsigned j = 0; j < 16; ++j) { const unsigned c = xb_ld(&bar[XB_XCNT(j)]); sum += c; cnt += (c > 0u) ? 1u : 0u; mine = (j == x) ? c : mine; }
        if (sum == G) break;
        __builtin_amdgcn_s_sleep(1);
        if ((++sp & 255u) == 0u) { if (xb_ld(&bar[XB_TMO])) break; if (sp > XB_SPIN_CAP) { atomicAdd(&bar[XB_TMO], 1u); break; } }
    }
    nloc = mine > 0u ? mine : 1u; nx = cnt > 0u ? cnt : 1u;
}
__device__ __forceinline__ void xcd_barrier(const XcdBarrier& b) {
    asm volatile("s_waitcnt vmcnt(0)" ::: "memory");
    __syncthreads();
    if (threadIdx.x == 0) {
        unsigned* bar = b.bar;
        __builtin_amdgcn_s_waitcnt(0);
        unsigned nloc = b.st[0], nx = b.st[1];
        if (nloc == 0u) { xcd_barrier_complete(bar, b.x, nloc, nx); b.st[0] = nloc; b.st[1] = nx; }
        const unsigned old = xb_add(&bar[XB_XSUB(b.x)], 1u);
        const unsigned gen = old / nloc;
        if (old + 1u == (gen + 1u) * nloc) {
            __builtin_amdgcn_fence(__ATOMIC_RELEASE, "agent");
            asm volatile("s_waitcnt vmcnt(0)" ::: "memory");
            const unsigned og = xb_add(&bar[XB_TOP], 1u);
            const unsigned tg = og / nx;
            if (og + 1u == (tg + 1u) * nx) xb_add(&bar[XB_TOPGEN], 1u);
            else XB_SPIN(xb_ld(&bar[XB_TOPGEN]) == tg, bar);
            __builtin_amdgcn_fence(__ATOMIC_ACQUIRE, "agent");
            xb_add(&bar[XB_XGEN(b.x)], 1u);
            asm volatile("s_waitcnt vmcnt(0)" ::: "memory");
        } else {
            XB_SPIN(xb_ld(&bar[XB_XGEN(b.x)]) == gen, bar);
            __builtin_amdgcn_fence(__ATOMIC_ACQUIRE, "agent");
            asm volatile("s_waitcnt vmcnt(0)" ::: "memory");
        }
    }
    __syncthreads();
}

struct Args { const void* in[31]; float* out; unsigned char* ws; int ph_lo, ph_hi; };

__device__ __forceinline__ float wave_sum(float v) {
#pragma unroll
    for (int o = 1; o < 64; o <<= 1) v += __shfl_xor(v, o);
    return v;
}

__device__ __forceinline__ void transpose_items(const float* W, int K, int N, const float* gain, bf16_t* WT, int ldt, int row_off, LAS float* scr, int gw, int NGW, int lane) {
    const int nblk = N / 32, nitems = (K / 64) * nblk;
    for (int item = gw; item < nitems; item += NGW) {
        const int kb = item / nblk, nb = item % nblk, k0 = 64 * kb, n0 = 32 * nb;
        float tmp[32];
#pragma unroll
        for (int i = 0; i < 32; ++i) { const int kk = 2 * i + (lane >> 5); tmp[i] = W[(size_t)(k0 + kk) * N + n0 + (lane & 31)]; }
#pragma unroll
        for (int i = 0; i < 32; ++i) { const int kk = 2 * i + (lane >> 5); scr[kk * 33 + (lane & 31)] = tmp[i]; }
        asm volatile("s_waitcnt lgkmcnt(0)" ::: "memory");
        const int c = lane & 7;
        f32x4 g0 = {1.f, 1.f, 1.f, 1.f}, g1 = g0;
        if (gain) { g0 = *(const f32x4*)(gain + k0 + 8 * c); g1 = *(const f32x4*)(gain + k0 + 8 * c + 4); }
#pragma unroll
        for (int j = 0; j < 4; ++j) { const int n = (lane >> 3) + 8 * j; const LAS float* sp = scr + (8 * c) * 33 + n;
            u32x4 o; o.x = pk2(sp[0 * 33] * g0.x, sp[1 * 33] * g0.y); o.y = pk2(sp[2 * 33] * g0.z, sp[3 * 33] * g0.w); o.z = pk2(sp[4 * 33] * g1.x, sp[5 * 33] * g1.y); o.w = pk2(sp[6 * 33] * g1.z, sp[7 * 33] * g1.w);
            *(u32x4*)(WT + (size_t)(row_off + n0 + n) * ldt + k0 + 8 * c) = o; }
        asm volatile("s_waitcnt lgkmcnt(0)" ::: "memory");
    }
}

__global__ void __launch_bounds__(512) mk_fwd(Args args) {
    extern __shared__ __attribute__((aligned(16))) unsigned char lds_raw[];
    LAS unsigned char* lds = (LAS unsigned char*)lds_raw;
    cg::grid_group grid = cg::this_grid();
    volatile LAS unsigned* bst = (volatile LAS unsigned*)(lds + 131072 + 256);
    unsigned* barw = (unsigned*)(GAS unsigned*)(args.ws + WS_MISC + 65536);
    if (threadIdx.x < 2) bst[threadIdx.x] = 0u;
    if (blockIdx.x == 0) { for (int i = threadIdx.x; i < XCD_BAR_WORDS; i += 512) barw[i] = 0u; }
    __syncthreads();
    XcdBarrier xbar; xbar.bar = barw; xbar.x = 0; xbar.st = bst;
    bool posted = false;
    int rep = 0;
    for (int ph = args.ph_lo; ph < args.ph_hi; ++ph) {
    int tid = threadIdx.x; asm volatile("" : "+v"(tid));
    const int lane = tid & 63, wave = __builtin_amdgcn_readfirstlane(tid >> 6);
    const int G = gridDim.x, bid = blockIdx.x;
    const int gw = bid * 8 + wave, NGW = G * 8;
    const int vcu = (G % 8 == 0) ? (bid % 8) * (G / 8) + bid / 8 : bid;
    unsigned long long wsi_ = (unsigned long long)args.ws; asm volatile("" : "+s"(wsi_));
    unsigned char* ws = (unsigned char*)(GAS unsigned char*)wsi_;
    const float* x_in = TOG(const float, args.in[0]);
    float* outp = TOG(float, args.out);
    bf16_t* Wt = (bf16_t*)(ws + WS_W);
    bf16_t* XB = (bf16_t*)(ws + WS_XB);
    float* O1S = outp;
    (void)0;
    unsigned char* BIG = ws + WS_BIG;
    bf16_t* Z = (bf16_t*)(BIG + OB_Z);
    bf16_t* OA = (bf16_t*)(BIG + OB_OA);
    bf16_t* QD = (bf16_t*)(BIG + OB_QD);
    bf16_t* KVD = (bf16_t*)(BIG + OB_KVD);
    bf16_t* Hb = (bf16_t*)(BIG + OB_H);
    bf16_t* Y = (bf16_t*)(ws + WS_Y);
    bf16_t* QX = (bf16_t*)(ws + WS_Y);
    bf16_t* OX = (bf16_t*)(ws + WS_Y + 32 * MiB);
    bf16_t* KVMEM = (bf16_t*)(ws + WS_KVMEM);
    bf16_t* MN = (bf16_t*)(ws + WS_MN);
    float* SSQX = (float*)(ws + WS_SSQX);
    float* SSQZ = (float*)(ws + WS_SSQZ);
    float* RCOS = (float*)(ws + WS_ROPE);
    float* RSIN = RCOS + (size_t)T * 16;
    float* LSE = (float*)(ws + WS_LSE);
    float* MISC = (float*)(ws + WS_MISC);

        const int layer = (ph >= 14) ? 1 : 0;
        if (ph == 0 && (PHMASK & 1)) {
            LAS float* scr = (LAS float*)(lds + wave * 16384);
            const float* g_mix = TOG(const float, args.in[3]); const float* g_cross = TOG(const float, args.in[4]); const float* g_mlp = TOG(const float, args.in[9]);
            for (int l = 0; l < 2; ++l) {
                bf16_t* wl = Wt + l * LW;
                transpose_items(TOG(const float, args.in[6]) + (size_t)l * 1024 * 512, 1024, 512, g_cross + l * 1024, wl + OW_Q, 1024, 0, scr, gw, NGW, lane);
                transpose_items(TOG(const float, args.in[7]) + (size_t)l * 1024 * 1024, 1024, 1024, nullptr, wl + OW_KV, 1024, 0, scr, gw, NGW, lane);
                transpose_items(TOG(const float, args.in[8]) + (size_t)l * 512 * 1024, 512, 1024, nullptr, wl + OW_O, 512, 0, scr, gw, NGW, lane);
                transpose_items(TOG(const float, args.in[10]) + (size_t)l * 1024 * 4096, 1024, 4096, g_mlp + l * 1024, wl + OW_1, 1024, 0, scr, gw, NGW, lane);
                transpose_items(TOG(const float, args.in[11]) + (size_t)l * 4096 * 1024, 4096, 1024, nullptr, wl + OW_2, 4096, 0, scr, gw, NGW, lane);
            }
            transpose_items(TOG(const float, args.in[12]), 1024, 2560, g_mix, Wt + OW_ABIN, 1024, 0, scr, gw, NGW, lane);
            transpose_items(TOG(const float, args.in[13]), 1024, 1024, nullptr, Wt + OW_ABOUT, 1024, 0, scr, gw, NGW, lane);
            transpose_items(TOG(const float, args.in[18]), 1024, 2208, g_mix + 1024, Wt + OW_CDIN, 1024, 0, scr, gw, NGW, lane);
            transpose_items(TOG(const float, args.in[19]), 1024, 1024, nullptr, Wt + OW_CDOUT, 1024, 0, scr, gw, NGW, lane);
            transpose_items(TOG(const float, args.in[27]), 384, 768, TOG(const float, args.in[25]), Wt + OW_UQ, 384, 0, scr, gw, NGW, lane);
            transpose_items(TOG(const float, args.in[28]), 256, 512, TOG(const float, args.in[26]), Wt + OW_UKV, 256, 0, scr, gw, NGW, lane);
            transpose_items(TOG(const float, args.in[29]), 256, 512, TOG(const float, args.in[26]), Wt + OW_UKV, 256, 512, scr, gw, NGW, lane);
            { u32x4* zp = (u32x4*)(Wt + OW_CDIN + (size_t)2208 * 1024); const int n16 = 96 * 1024 * 2 / 16;
              for (int i = bid * 512 + tid; i < n16; i += G * 512) zp[i] = (u32x4){0u, 0u, 0u, 0u}; }
            for (int m = gw; m < T; m += NGW) {
                const f32x4* xr = (const f32x4*)(x_in + (size_t)m * D) + lane; float s = 0.f;
                unsigned long long* o8 = (unsigned long long*)(XB + (size_t)m * D) + lane;
#pragma unroll
                for (int j = 0; j < 4; ++j) { const f32x4 v = xr[64 * j]; s += (v.x * v.x + v.y * v.y) + (v.z * v.z + v.w * v.w);
                    o8[64 * j] = (unsigned long long)pk2(v.x, v.y) | ((unsigned long long)pk2(v.z, v.w) << 32); }
                s = wave_sum(s);
                if (lane < 16) SSQX[(size_t)m * 16 + lane] = (lane == 0) ? s : 0.f;
            }
            for (int mm = gw; mm < 2 * 1024; mm += NGW) {
                const int l = mm >> 10, m = mm & 1023;
                const f32x4* xr = (const f32x4*)(TOG(const float, args.in[1]) + (size_t)m * D) + lane; const f32x4* gr = (const f32x4*)(TOG(const float, args.in[5]) + l * D) + lane;
                f32x4 v[4]; float s = 0.f;
#pragma unroll
                for (int j = 0; j < 4; ++j) { v[j] = xr[64 * j]; s += (v[j].x * v[j].x + v[j].y * v[j].y) + (v[j].z * v[j].z + v[j].w * v[j].w); }
                const float r = 1.0f / sqrtf(wave_sum(s) * (1.f / D) + EPS);
                unsigned long long* o8 = (unsigned long long*)(MN + ((size_t)l * 1024 + m) * D) + lane;
#pragma unroll
                for (int j = 0; j < 4; ++j) { const f32x4 gg = gr[64 * j]; o8[64 * j] = (unsigned long long)pk2(v[j].x * r * gg.x, v[j].y * r * gg.y) | ((unsigned long long)pk2(v[j].z * r * gg.z, v[j].w * r * gg.w) << 32); }
            }
            for (int i = bid * 512 + tid; i < T * 16; i += G * 512) {
                const int row = i >> 4, fi = i & 15;
                const float invf = __builtin_amdgcn_exp2f(-(float)fi * 0.83048202372184058696f);
                const double rev = (double)(TOG(const int, args.in[2]))[row] * (double)invf * 0.15915494309189533577;
                const float fr = (float)(rev - rint(rev));
                RCOS[i] = __builtin_amdgcn_cosf(fr); RSIN[i] = __builtin_amdgcn_sinf(fr);
            }
            if (bid == 0 && wave == 0) {
                const float a = (TOG(const float, args.in[20]))[lane] * (TOG(const float, args.in[21]))[lane], b2 = (TOG(const float, args.in[22]))[lane] * (TOG(const float, args.in[23]))[lane];
                const float sa = wave_sum(a), sb = wave_sum(b2);
                if (lane == 0) MISC[0] = __expf(sa) - __expf(sb) + 0.35550906759097f;
            }
        }
        if ((PHMASK & 2) && (ph == 1 || ph == 5 || ph == 8 || ph == 10 || ph == 11 || ph == 14 || ph == 17)) {
            const int njobs = (ph == 1 || ph == 10 || ph == 11) ? 2 : 1;
            for (int j = 0; j < njobs; ++j) {
                pg8::Gemm g; pg8::EpiZ E;
                E.rs = SSQX; E.rs_stride = 16; E.rs_off = 0; E.rs_n4 = 4; E.rs_inv = 1.f / 1024.f; E.qs_end = 0; E.qscale = 1.f; E.act = 0; E.rope = 0; E.rope_g = -1;
                E.rcos = RCOS; E.rsin = RSIN; E.ssq = nullptr; E.ssq_stride = 0;
                int rot = 0;
                if (ph == 1 && j == 0) { g = pg8::Gemm{XB, Wt + OW_ABIN, T, 2560, 1024, 1024}; E.O = Z; E.ldc = 2560; E.qs_end = 512; E.qscale = 0.125f * LOG2E; }
                else if (ph == 1 || (ph == 10 && j == 1)) { const int l = (ph == 1) ? 0 : 1; g = pg8::Gemm{MN + (size_t)l * 1024 * 1024, Wt + l * LW + OW_KV, 1024, 1024, 1024, 1024}; E.O = KVMEM + (size_t)l * 1024 * 1024; E.ldc = 1024; E.rs = nullptr; rot = (ph == 1) ? 0 : 128; }
                else if (ph == 5 || ph == 14) { g = pg8::Gemm{XB, Wt + layer * LW + OW_Q, T, 512, 1024, 1024}; E.O = QX; E.ldc = 512; E.qs_end = 512; E.qscale = 0.08838834764831845f * LOG2E; }
                else if (ph == 8 || ph == 17) { g = pg8::Gemm{XB, Wt + layer * LW + OW_1, T, 4096, 1024, 1024}; E.O = Hb; E.ldc = 4096; E.act = 1; }
                else if (ph == 10) { g = pg8::Gemm{XB, Wt + OW_CDIN, T, 2304, 1024, 1024}; E.O = Z; E.ldc = 2304; E.qs_end = 512; E.qscale = 0.125f * LOG2E; E.rope = 1; E.rope_g = 68; E.ssq = SSQZ; E.ssq_stride = 72; }
                else if (ph == 11 && j == 0) { g = pg8::Gemm{Z + 1536, Wt + OW_UQ, T, 768, 384, 2304}; E.O = QD; E.ldc = 768; E.rs = SSQZ; E.rs_stride = 72; E.rs_off = 48; E.rs_n4 = 3; E.rs_inv = 1.f / 384.f;
                    E.qs_end = 768; E.qscale = 0.10206207261596577f * LOG2E; E.rope = 2; }
                else { g = pg8::Gemm{Z + 1920, Wt + OW_UKV, T, 1024, 256, 2304}; E.O = KVD; E.ldc = 1024; E.rs = SSQZ; E.rs_stride = 72; E.rs_off = 60; E.rs_n4 = 2; E.rs_inv = 1.f / 256.f; rot = 128; }
                pg8::StaticOrder S; S.init(g.M, g.N, G, (bid + rot) % G);
                pg8::gemm_phase<pg8::EpiZ>(lds, g, S, E);
            }
        }
        if ((PHMASK & 4) && (ph == 4 || ph == 7 || ph == 9 || ph == 13 || ph == 16 || ph == 18)) {
            pg8::Gemm g; pg8::EpiRes E; E.base32 = nullptr; E.base16 = XB; E.xb = XB; E.ssq = SSQX;
            if (ph == 4) { g = pg8::Gemm{Y, Wt + OW_ABOUT, T, 1024, 1024, 1024}; E.base32 = x_in; }
            else if (ph == 13) { g = pg8::Gemm{Y, Wt + OW_CDOUT, T, 1024, 1024, 1024}; }
            else if (ph == 7 || ph == 16) { g = pg8::Gemm{OX, Wt + layer * LW + OW_O, T, 1024, 512, 512}; }
            else { g = pg8::Gemm{Hb, Wt + layer * LW + OW_2, T, 1024, 4096, 4096}; }
            pg8::StaticOrder S; S.init(g.M, g.N, G, bid);
            pg8::gemm_phase<pg8::EpiRes>(lds, g, S, E);
        }
        if (ph == 2 && (PHMASK & 8)) {
            const int r32 = lane & 31, hi = lane >> 5;
            for (int u = vcu; u < 3072; u += G) {
                const int gp = u >> 10, v = u & 1023, bh = v >> 5, w = v & 31, b = bh >> 3, h = bh & 7;
                const int dil = (gp == 0) ? 1 : (gp == 1) ? 4 : 16, nu = 32 / dil, res = w / nu, n = w % nu;
                const bf16_t* base = Z + ((size_t)b * SEQ + res) * 2560 + h * 64;
                const long ld = 2560L * dil;
                f32x16 o[2]; float mr, lr;
                attn_core<64, 64, 64, true, true, true, 1, false>(lds, base, ld, base + 512, ld, base + 512, ld, base + 1024, ld, 256 * n, (4 * n - 2 < 0) ? 0 : 4 * n - 2, 4 * n + 4, 128, o, mr, lr);
                const float inv = 1.0f / lr;
                const int qrow = 256 * n + wave * 32 + r32;
                const size_t tok = (size_t)b * SEQ + res + (size_t)qrow * dil;
                bf16_t* op = OA + (size_t)gp * T * 512 + tok * 512 + h * 64;
#pragma unroll
                for (int d = 0; d < 2; ++d)
#pragma unroll
                    for (int i = 0; i < 4; ++i) { u32x2 wv; wv.x = pk2(o[d][4 * i] * inv, o[d][4 * i + 1] * inv); wv.y = pk2(o[d][4 * i + 2] * inv, o[d][4 * i + 3] * inv);
                        *(u32x2*)(op + 32 * d + 8 * i + 4 * hi) = wv; }
                if (hi == 0) LSE[(size_t)gp * T * 8 + tok * 8 + h] = mr + __builtin_amdgcn_logf(lr);
            }
            const float* cw = TOG(const float, args.in[14]); const float* cb = TOG(const float, args.in[15]); const float* lg = TOG(const float, args.in[16]); const float* lb = TOG(const float, args.in[17]);
            LAS float* gl = (LAS float*)lds;
            for (int cu = bid; cu < T / 32; cu += G) {
                const int t0 = cu * 32, bstart = (t0 / SEQ) * SEQ;
                for (int e = tid; e < 62 * 64; e += 512) {
                    const int row = e >> 6, ch = e & 63, tk = t0 - 30 + row;
                    f32x4 g0 = {0.f, 0.f, 0.f, 0.f}, g1 = g0;
                    if (tk >= bstart) {
                        const u32x4 uu = *(const u32x4*)(Z + (size_t)tk * 2560 + 1536 + ch * 8), gg = *(const u32x4*)(Z + (size_t)tk * 2560 + 2048 + ch * 8);
#pragma unroll
                        for (int q = 0; q < 4; ++q) {
                            const float u0 = bf2f(uu[q] & 0xffffu), u1 = bf2f(uu[q] >> 16), a0 = bf2f(gg[q] & 0xffffu), a1 = bf2f(gg[q] >> 16);
                            const float r0 = u0 * __builtin_amdgcn_rcpf(1.f + __expf(-a0)), r1 = u1 * __builtin_amdgcn_rcpf(1.f + __expf(-a1));
                            if (q < 2) { g0[2 * q] = r0; g0[2 * q + 1] = r1; } else { g1[2 * (q - 2)] = r0; g1[2 * (q - 2) + 1] = r1; }
                        }
                    }
                    *(LAS f32x4*)(gl + row * 512 + ch * 8) = g0; *(LAS f32x4*)(gl + row * 512 + ch * 8 + 4) = g1;
                }
                __syncthreads();
                {
                    float wv[31];
#pragma unroll
                    for (int j = 0; j < 31; ++j) wv[j] = cw[j * 512 + tid];
                    const float bias = cb[tid];
                    float res[32];
#pragma unroll
                    for (int blk = 0; blk < 4; ++blk) {
                        float in[38];
#pragma unroll
                        for (int j = 0; j < 38; ++j) in[j] = gl[(blk * 8 + j) * 512 + tid];
#pragma unroll
                        for (int i = 0; i < 8; ++i) { float a = bias;
#pragma unroll
                            for (int j = 0; j < 31; ++j) a += wv[j] * in[i + j];
                            res[blk * 8 + i] = a; }
                        __builtin_amdgcn_sched_barrier(0);
                    }
#pragma unroll
                    for (int i = 0; i < 32; ++i) gl[i * 512 + tid] = res[i];
                }
                __syncthreads();
#pragma unroll
                for (int k = 0; k < 4; ++k) {
                    const int tr = wave * 4 + k;
                    const f32x4 a = *(LAS f32x4*)(gl + tr * 512 + lane * 8), c = *(LAS f32x4*)(gl + tr * 512 + lane * 8 + 4);
                    const float mu = wave_sum((a.x + a.y) + (a.z + a.w) + (c.x + c.y) + (c.z + c.w)) * (1.f / 512.f);
                    const f32x4 da = a - mu, dc = c - mu;
                    const float var = wave_sum((da.x * da.x + da.y * da.y) + (da.z * da.z + da.w * da.w) + (dc.x * dc.x + dc.y * dc.y) + (dc.z * dc.z + dc.w * dc.w)) * (1.f / 512.f);
                    const float rstd = 1.0f / sqrtf(var + EPS);
                    const f32x4 ga = *(const f32x4*)(lg + lane * 8), gc = *(const f32x4*)(lg + lane * 8 + 4), ba = *(const f32x4*)(lb + lane * 8), bc = *(const f32x4*)(lb + lane * 8 + 4);
                    f32x4 ya = da * rstd * ga + ba, yc = dc * rstd * gc + bc;
#pragma unroll
                    for (int e = 0; e < 4; ++e) { ya[e] = ya[e] * __builtin_amdgcn_rcpf(1.f + __expf(-ya[e])); yc[e] = yc[e] * __builtin_amdgcn_rcpf(1.f + __expf(-yc[e])); }
                    u32x4 wv; wv.x = pk2(ya[0], ya[1]); wv.y = pk2(ya[2], ya[3]); wv.z = pk2(yc[0], yc[1]); wv.w = pk2(yc[2], yc[3]);
                    *(u32x4*)(Y + (size_t)(t0 + tr) * 1024 + 512 + lane * 8) = wv;
                }
                __syncthreads();
            }
        }
        if (ph == 3 && (PHMASK & 16)) {
            for (size_t i = (size_t)bid * 512 + tid; i < (size_t)T * 64; i += (size_t)G * 512) {
                const size_t tok = i >> 6; const int ch = (int)(i & 63), h = ch >> 3;
                const float l0 = LSE[tok * 8 + h], l1 = LSE[(size_t)T * 8 + tok * 8 + h], l2 = LSE[(size_t)2 * T * 8 + tok * 8 + h];
                const float mx = fmaxf(l0, fmaxf(l1, l2));
                float w0 = __builtin_amdgcn_exp2f(l0 - mx), w1 = __builtin_amdgcn_exp2f(l1 - mx), w2 = __builtin_amdgcn_exp2f(l2 - mx);
                const float inv = 1.0f / (w0 + w1 + w2); w0 *= inv; w1 *= inv; w2 *= inv;
                const u32x4 a = *(const u32x4*)(OA + tok * 512 + ch * 8), b = *(const u32x4*)(OA + (size_t)T * 512 + tok * 512 + ch * 8), c = *(const u32x4*)(OA + (size_t)2 * T * 512 + tok * 512 + ch * 8);
                u32x4 r;
#pragma unroll
                for (int q = 0; q < 4; ++q) {
                    const float lo = w0 * bf2f(a[q] & 0xffffu) + w1 * bf2f(b[q] & 0xffffu) + w2 * bf2f(c[q] & 0xffffu);
                    const float hh = w0 * bf2f(a[q] >> 16) + w1 * bf2f(b[q] >> 16) + w2 * bf2f(c[q] >> 16);
                    r[q] = pk2(lo, hh);
                }
                *(u32x4*)(Y + tok * 1024 + ch * 8) = r;
            }
        }
        if ((PHMASK & 32) && (ph == 6 || ph == 15)) {
            const int r32 = lane & 31, hi = lane >> 5;
            const bf16_t* KVl = KVMEM + (size_t)layer * 1024 * 1024;
            for (int u = vcu; u < 512; u += G) {
                const int bh = u >> 5, qb = u & 31, b = bh >> 2, h = bh & 3;
                const bf16_t* qp = QX + (size_t)b * SEQ * 512 + h * 128;
                const bf16_t* kp = KVl + (size_t)b * 256 * 1024 + h * 128;
                f32x16 o[4]; float mr, lr;
                attn_core<128, 128, 128, false, false, false, 1, false>(lds, qp, 512, kp, 1024, kp, 1024, kp + 512, 1024, 256 * qb, 0, 4, 1 << 30, o, mr, lr);
                const float inv = 1.0f / lr;
                bf16_t* op = OX + ((size_t)b * SEQ + 256 * qb + wave * 32 + r32) * 512 + h * 128;
#pragma unroll
                for (int d = 0; d < 4; ++d)
#pragma unroll
                    for (int i = 0; i < 4; ++i) { u32x2 wv; wv.x = pk2(o[d][4 * i] * inv, o[d][4 * i + 1] * inv); wv.y = pk2(o[d][4 * i + 2] * inv, o[d][4 * i + 3] * inv);
                        *(u32x2*)(op + 32 * d + 8 * i + 4 * hi) = wv; }
            }
        }
        if (ph == 12 && (PHMASK & 64)) {
            const int r32 = lane & 31, hi = lane >> 5;
            const float lam = MISC[0], osc = 0.64449093240903f;
            const float* sg = TOG(const float, args.in[24]);
#ifndef NO_C
            for (int p = vcu; p < 256; p += G) {
                const int bh = p >> 4, s = p & 15, b = bh >> 2, h = bh & 3;
                for (int half = 0; half < 2; ++half) {
                    const int qb = half ? 31 - s : s;
                    const size_t row = (size_t)b * SEQ + 256 * qb + wave * 32 + r32;
                    for (int mp = 0; mp < 2; ++mp) {
                        const bf16_t* zb = Z + (size_t)b * SEQ * 2304 + h * 128;
                        f32x16 o[4]; float mr, lr;
                        attn_core<64, 64, 128, true, false, true, 1, false>(lds, zb + mp * 64, 2304, zb + 512 + mp * 64, 2304, zb, 2304, zb + 1024, 2304, 256 * qb, 0, 4 * qb + 4, 1 << 30, o, mr, lr);
                        const float inv = 1.0f / lr;
                        float* sp = O1S + row * 512 + h * 128;
                        if (mp == 0) {
#pragma unroll
                            for (int d = 0; d < 4; ++d) {
#pragma unroll
                                for (int i = 0; i < 4; ++i) *(f32x4*)(sp + 32 * d + 8 * i + 4 * hi) = (f32x4){o[d][4 * i] * inv, o[d][4 * i + 1] * inv, o[d][4 * i + 2] * inv, o[d][4 * i + 3] * inv};
                                __builtin_amdgcn_sched_barrier(0); }
                        } else {
                            float ss = 0.f;
#pragma unroll
                            for (int d = 0; d < 4; ++d) {
#pragma unroll
                                for (int i = 0; i < 4; ++i) { const f32x4 a1 = *(const f32x4*)(sp + 32 * d + 8 * i + 4 * hi);
#pragma unroll
                                    for (int e = 0; e < 4; ++e) { const float dv = a1[e] - lam * (o[d][4 * i + e] * inv); o[d][4 * i + e] = dv; ss += dv * dv; } }
                                __builtin_amdgcn_sched_barrier(0); }
                            ss += __shfl_xor(ss, 32);
                            const float rn = osc / sqrtf(ss * (1.f / 128.f) + EPS);
                            bf16_t* op = Y + row * 1024 + h * 128;
#pragma unroll
                            for (int d = 0; d < 4; ++d) {
#pragma unroll
                                for (int i = 0; i < 4; ++i) { const f32x4 gg = *(const f32x4*)(sg + 32 * d + 8 * i + 4 * hi);
                                    u32x2 wv; wv.x = pk2(o[d][4 * i] * rn * gg[0], o[d][4 * i + 1] * rn * gg[1]); wv.y = pk2(o[d][4 * i + 2] * rn * gg[2], o[d][4 * i + 3] * rn * gg[3]);
                                    *(u32x2*)(op + 32 * d + 8 * i + 4 * hi) = wv; }
                                __builtin_amdgcn_sched_barrier(0); }
                        }
                    }
                }
            }
#endif
#ifndef NO_D
            for (int p = vcu; p < 512; p += G) {
                const int bh = p >> 4, s = p & 15, b = bh >> 3, h = bh & 7;
                for (int half = 0; half < 2; ++half) {
                    const int qb = half ? 31 - s : s;
                    const size_t row = (size_t)b * SEQ + 256 * qb + wave * 32 + r32;
                    f32x16 o[2]; float mr, lr;
                    attn_core<96, 64, 64, true, true, true, 1, false>(lds, QD + (size_t)b * SEQ * 768 + h * 96, 768, KVD + (size_t)b * SEQ * 1024 + h * 64, 1024, Z + (size_t)b * SEQ * 2304 + 2176, 2304,
                                                KVD + (size_t)b * SEQ * 1024 + 512 + h * 64, 1024, 256 * qb, 0, 4 * qb + 4, 1 << 30, o, mr, lr);
                    const float inv = 1.0f / lr;
                    bf16_t* op = Y + row * 1024 + 512 + h * 64;
#pragma unroll
                    for (int d = 0; d < 2; ++d)
#pragma unroll
                        for (int i = 0; i < 4; ++i) { u32x2 wv; wv.x = pk2(o[d][4 * i] * inv, o[d][4 * i + 1] * inv); wv.y = pk2(o[d][4 * i + 2] * inv, o[d][4 * i + 3] * inv);
                            *(u32x2*)(op + 32 * d + 8 * i + 4 * hi) = wv; }
                }
            }
#endif
        }
        if (ph == 19 && (PHMASK & 128)) {
            const float* fg = TOG(const float, args.in[30]);
            for (int m = gw; m < T; m += NGW) {
                float s = (lane < 16) ? SSQX[(size_t)m * 16 + lane] : 0.f;
                s = wave_sum(s);
                const float r = 1.0f / sqrtf(s * (1.f / D) + EPS);
                const u32x2* xr = (const u32x2*)(XB + (size_t)m * D) + lane; f32x4* orow = (f32x4*)(outp + (size_t)m * D) + lane; const f32x4* gr = (const f32x4*)fg + lane;
#pragma unroll
                for (int j = 0; j < 4; ++j) { const u32x2 w = xr[64 * j]; const f32x4 gg = gr[64 * j];
                    const f32x4 v = {bf2f(w.x & 0xffffu), bf2f(w.x >> 16), bf2f(w.y & 0xffffu), bf2f(w.y >> 16)}; orow[64 * j] = v * r * gg; }
            }
        }
        if (ph + 1 < args.ph_hi) {
            if (!posted) { grid.sync(); xbar = xcd_barrier_post(barw, bst); posted = true; }
            else xcd_barrier(xbar);
        }
        if (DUPMASK != 0) { if (((DUPMASK >> ph) & 1) && !rep) { rep = 1; --ph; } else rep = 0; }
    }
}

#ifndef MK_SPLIT
#define MK_SPLIT 0
#endif
extern "C" void kernel_launch(void* const* d_in, const int* in_sizes, int n_in, void* d_out, int out_size, void* d_ws, size_t ws_size, hipStream_t stream) {
    static int grid = 0;
    if (grid == 0) {
        if (n_in != 31 || ws_size < WS_END) { fprintf(stderr, "kernel_launch: unexpected n_in %d / ws %zu\n", n_in, ws_size); grid = -1; return; }
        int dev = 0, cus = 0, per_cu = 0;
        hipGetDevice(&dev);
        hipDeviceGetAttribute(&cus, hipDeviceAttributeMultiprocessorCount, dev);
        if (hipFuncSetAttribute((const void*)mk_fwd, hipFuncAttributeMaxDynamicSharedMemorySize, LDS_BYTES) != hipSuccess) { fprintf(stderr, "kernel_launch: hipFuncSetAttribute failed\n"); }
        if (hipOccupancyMaxActiveBlocksPerMultiprocessor(&per_cu, (const void*)mk_fwd, 512, LDS_BYTES) != hipSuccess || per_cu < 1) { fprintf(stderr, "kernel_launch: occupancy query gave %d\n", per_cu); per_cu = 1; }
        (void)hipGetLastError();
        grid = cus * per_cu;
        if (grid > 256) grid = 256;
        fprintf(stderr, "kernel_launch: grid %d (cus %d per_cu %d)\n", grid, cus, per_cu);
    }
    if (grid < 0) return;
    Args a{};
    for (int i = 0; i < 31; ++i) a.in[i] = d_in[i];
    a.out = (float*)d_out; a.ws = (unsigned char*)d_ws;
#if MK_SPLIT
    for (int ph = 0; ph < 20; ++ph) { a.ph_lo = ph; a.ph_hi = ph + 1; hipLaunchKernelGGL(mk_fwd, dim3(grid), dim3(512), LDS_BYTES, stream, a); }
#else
    a.ph_lo = 0; a.ph_hi = 20;
    void* kargs[] = {&a};
    hipError_t e = hipLaunchCooperativeKernel((const void*)mk_fwd, dim3(grid), dim3(512), kargs, LDS_BYTES, stream);
    if (e != hipSuccess) fprintf(stderr, "cooperative launch failed: %s (grid %d)\n", hipGetErrorString(e), grid);
#endif
}
```

```cpp
#include <hip/hip_runtime.h>
#include <hip/hip_cooperative_groups.h>
#include <cstdio>
#include <cstdint>
namespace cg = cooperative_groups;

#define LAS __attribute__((address_space(3)))
#define GAS __attribute__((address_space(1)))
#define TOG(T, p) ((T*)(GAS T*)(p))
typedef unsigned short bf16_t;
typedef short bf16x8 __attribute__((ext_vector_type(8)));
typedef short s16x4 __attribute__((ext_vector_type(4)));
typedef float f32x4 __attribute__((ext_vector_type(4)));
typedef float f32x16 __attribute__((ext_vector_type(16)));
typedef unsigned u32x4 __attribute__((ext_vector_type(4)));
typedef unsigned u32x2 __attribute__((ext_vector_type(2)));
typedef float f32x2_t __attribute__((ext_vector_type(2)));
typedef __bf16 bf16x2_t __attribute__((ext_vector_type(2)));

__device__ __forceinline__ unsigned pk2(float lo, float hi) { f32x2_t v = {lo, hi}; bf16x2_t b = __builtin_convertvector(v, bf16x2_t); return __builtin_bit_cast(unsigned, b); }
__device__ __forceinline__ float bf2f(unsigned h) { return __uint_as_float(h << 16); }

constexpr int NB = 4, SEQ = 8192, T = NB * SEQ, D = 1024;
constexpr float EPS = 1e-6f;
constexpr float LOG2E = 1.4426950408889634f;
constexpr float NEGBIG = -1e30f;

constexpr size_t MiB = 1u << 20;
constexpr size_t WS_W = 0, WS_XB = 56 * MiB, WS_BIG = 120 * MiB, WS_Y = 376 * MiB, WS_SMALL = 440 * MiB;
constexpr size_t WS_KVMEM = WS_SMALL, WS_MN = WS_SMALL + 4 * MiB, WS_SSQX = WS_SMALL + 8 * MiB, WS_SSQZ = WS_SMALL + 10 * MiB,
                 WS_ROPE = WS_SMALL + 20 * MiB, WS_LSE = WS_SMALL + 24 * MiB, WS_MISC = WS_SMALL + 28 * MiB, WS_END = WS_SMALL + 29 * MiB;
constexpr size_t M1 = 1048576;
constexpr size_t LW = 10 * M1, OW_Q = 0, OW_KV = M1 / 2, OW_O = M1 + M1 / 2, OW_1 = 2 * M1, OW_2 = 6 * M1;
constexpr size_t OW_ABIN = 20 * M1, OW_ABOUT = OW_ABIN + 2560 * 1024, OW_CDIN = OW_ABOUT + M1, OW_CDOUT = OW_CDIN + 2304 * 1024,
                 OW_UQ = OW_CDOUT + M1, OW_UKV = OW_UQ + 768 * 384, OW_END = OW_UKV + 1024 * 256;
static_assert(OW_END * 2 <= 56 * MiB, "weights");
constexpr size_t OB_Z = 0;
constexpr size_t OB_OA = 160 * MiB;
constexpr size_t OB_QD = 144 * MiB;
constexpr size_t OB_KVD = 192 * MiB;
constexpr size_t OB_H = 0;

constexpr int LDS_BYTES = 147456;
#ifndef PHMASK
#define PHMASK 0xFF
#endif
#ifndef DUPMASK
#define DUPMASK 0
#endif

namespace pg8 {
constexpr int BM = 256, BK = 64, HALF = 128, HTB = HALF * BK * 2, STAGE_BYTES = 8 * HTB, NXCD = 8, WGM = 8;
__host__ __device__ __forceinline__ int lds_byte(int r, int c) { const int st = (r >> 4) * 2 + (c >> 5), rr = r & 15, cc = c & 31, ob = rr * 64 + cc * 2; return st * 1024 + (ob ^ (((ob >> 9) & 1) << 5)); }
__host__ __device__ __forceinline__ void stage_rc(int b, int& R, int& C) { const int st = b / 1024, sb = b % 1024, swz = sb ^ (((sb >> 9) & 1) << 5); R = (st >> 1) * 16 + swz / 64; C = (st & 1) * 32 + (swz % 64) / 2; }
__host__ __device__ __forceinline__ int perm32(int rho) { const int n = rho >> 4, i = rho & 15; return 8 * (i >> 2) + 4 * n + (i & 3); }

struct Unit { int pm, pn; };
struct Gemm { const bf16_t* A; const bf16_t* Bt; int M, N, K, lda; };

struct StaticOrder {
    int nM, nN, nwg, G, c;
    __device__ void init(int M, int N, int G_, int c_) { nM = M / BM; nN = N / BM; nwg = nM * nN; G = G_; c = c_; }
    __device__ bool next(int i, Unit& u) const {
        const long L = (long)i * G + c; if (L >= nwg) return false;
        int wgid = (int)L; { const int q = nwg / NXCD, r = nwg % NXCD, xcd = wgid % NXCD, off = wgid / NXCD; wgid = (xcd < r ? xcd * (q + 1) : r * (q + 1) + (xcd - r) * q) + off; }
        const int nig = WGM * nN, gid = wgid / nig, fm = gid * WGM, gsz = (nM - fm) < WGM ? (nM - fm) : WGM;
        u.pm = fm + ((wgid % nig) % gsz); u.pn = (wgid % nig) / gsz; return true;
    }
};


struct EpiZ {
    static constexpr bool PERM = true;
    bf16_t* O; int ldc;
    const float* rs; int rs_stride, rs_off, rs_n4; float rs_inv;
    int qs_end; float qscale;
    int act;
    int rope, rope_g;
    const float* rcos; const float* rsin;
    float* ssq; int ssq_stride;
    __device__ __forceinline__ void operator()(const f32x4 (&acc)[2][2][4][2], const Unit& u, int wr, int wc, int fr, int fq) const {
        const int row0 = u.pm * BM + wr * 64 + fr;
#pragma unroll
        for (int ai = 0; ai < 2; ++ai)
#pragma unroll
            for (int m = 0; m < 4; ++m) {
                const int row = row0 + ai * HALF + m * 16;
                float r = 1.f;
                if (rs) { f32x4 s = {0.f, 0.f, 0.f, 0.f}; const float* p = rs + (size_t)row * rs_stride + rs_off;
                    for (int k = 0; k < rs_n4; ++k) s += *(const f32x4*)(p + 4 * k);
                    r = __builtin_amdgcn_rsqf(((s.x + s.y) + (s.z + s.w)) * rs_inv + EPS); }
#pragma unroll
                for (int bj = 0; bj < 2; ++bj) {
                    const int colg = u.pn * BM + bj * HALF + wc * 32, gidx = colg >> 5, col = colg + 8 * fq;
                    f32x4 v0 = acc[ai][bj][m][0] * r, v1 = acc[ai][bj][m][1] * r;
                    if (act == 1) {
#pragma unroll
                        for (int e = 0; e < 4; ++e) { float a = fmaxf(v0[e], 0.f), b = fmaxf(v1[e], 0.f); v0[e] = a * a; v1[e] = b * b; }
                    }
                    if (ssq) {
                        float ss = (v0[0] * v0[0] + v0[1] * v0[1]) + (v0[2] * v0[2] + v0[3] * v0[3]) + (v1[0] * v1[0] + v1[1] * v1[1]) + (v1[2] * v1[2] + v1[3] * v1[3]);
                        ss += __shfl_xor(ss, 16); ss += __shfl_xor(ss, 32);
                        if (fq == 0) ssq[(size_t)row * ssq_stride + gidx] = ss;
                    }
                    if (colg < qs_end) { v0 = v0 * qscale; v1 = v1 * qscale; }
                    const bool rg = (rope == 1) ? (gidx == rope_g) : ((rope == 2) ? (gidx % 3 == 2) : false);
                    if (rg) {
                        const int ci = 8 * (fq & 1);
                        const f32x4 c0 = *(const f32x4*)(rcos + (size_t)row * 16 + ci), c1 = *(const f32x4*)(rcos + (size_t)row * 16 + ci + 4);
                        const f32x4 s0 = *(const f32x4*)(rsin + (size_t)row * 16 + ci), s1 = *(const f32x4*)(rsin + (size_t)row * 16 + ci + 4);
                        const float sg = (fq < 2) ? -1.f : 1.f;
#pragma unroll
                        for (int e = 0; e < 4; ++e) {
                            const float p0 = __shfl_xor(v0[e], 32), p1 = __shfl_xor(v1[e], 32);
                            v0[e] = v0[e] * c0[e] + sg * p0 * s0[e];
                            v1[e] = v1[e] * c1[e] + sg * p1 * s1[e];
                        }
                    }
                    u32x4 w; w.x = pk2(v0[0], v0[1]); w.y = pk2(v0[2], v0[3]); w.z = pk2(v1[0], v1[1]); w.w = pk2(v1[2], v1[3]);
                    *(u32x4*)(O + (size_t)row * ldc + col) = w;
                }
            }
    }
};
struct EpiRes {
    static constexpr bool PERM = true;
    const float* base32; const bf16_t* base16; bf16_t* xb; float* ssq;
    __device__ __forceinline__ void operator()(const f32x4 (&acc)[2][2][4][2], const Unit& u, int wr, int wc, int fr, int fq) const {
        const int row0 = u.pm * BM + wr * 64 + fr;
#pragma unroll
        for (int ai = 0; ai < 2; ++ai)
#pragma unroll
            for (int m = 0; m < 4; ++m) {
                const int row = row0 + ai * HALF + m * 16; float ss = 0.f;
#pragma unroll
                for (int bj = 0; bj < 2; ++bj) {
                    const size_t off = (size_t)row * D + u.pn * BM + bj * HALF + wc * 32 + 8 * fq;
                    f32x4 b0, b1;
                    if (base32) { b0 = *(const f32x4*)(base32 + off); b1 = *(const f32x4*)(base32 + off + 4); }
                    else { const u32x4 bw = *(const u32x4*)(base16 + off);
                        b0 = (f32x4){bf2f(bw.x & 0xffffu), bf2f(bw.x >> 16), bf2f(bw.y & 0xffffu), bf2f(bw.y >> 16)};
                        b1 = (f32x4){bf2f(bw.z & 0xffffu), bf2f(bw.z >> 16), bf2f(bw.w & 0xffffu), bf2f(bw.w >> 16)}; }
                    const f32x4 v0 = b0 + acc[ai][bj][m][0], v1 = b1 + acc[ai][bj][m][1];
                    u32x4 w; w.x = pk2(v0[0], v0[1]); w.y = pk2(v0[2], v0[3]); w.z = pk2(v1[0], v1[1]); w.w = pk2(v1[2], v1[3]);
                    *(u32x4*)(xb + off) = w;
                    ss += ((v0[0] * v0[0] + v0[1] * v0[1]) + (v0[2] * v0[2] + v0[3] * v0[3])) + ((v1[0] * v1[0] + v1[1] * v1[1]) + (v1[2] * v1[2] + v1[3] * v1[3]));
                }
                ss += __shfl_xor(ss, 16); ss += __shfl_xor(ss, 32);
                if (fq == 0) ssq[(size_t)row * 16 + u.pn * 4 + wc] = ss;
            }
    }
};

template <class Epi>
__device__ __forceinline__ void gemm_phase(LAS unsigned char* lds, const Gemm g, const StaticOrder& S, const Epi& E) {
    int tid = threadIdx.x; asm volatile("" : "+v"(tid));
    const int wid = __builtin_amdgcn_readfirstlane(tid >> 6), lane = tid & 63, wr = wid >> 2, wc = wid & 3, fr = lane & 15, fq = lane >> 4;
    const int K = g.K, nt = K / BK, lda = g.lda;
    unsigned voffA[2], voffB[2];
#pragma unroll
    for (int i = 0; i < 2; ++i) { int R, C; stage_rc(tid * 16 + i * 8192, R, C); const int Rb = Epi::PERM ? ((R & ~31) + perm32(R & 31)) : R;
        voffA[i] = (unsigned)(R * lda + C) * 2u; voffB[i] = (unsigned)(Rb * K + C) * 2u; }
    const size_t kstep = (size_t)(BK * 2);
    const size_t hstepA = (size_t)HALF * lda * 2, hstepB = (size_t)HALF * K * 2;
    const size_t tstepA = 2 * hstepA, tstepB = 2 * hstepB;
    const unsigned ldsw = (unsigned)wid * 1024u;
    const int aoff = lds_byte(wr * 64 + fr, fq * 8), boff = lds_byte(wc * 32 + fr, fq * 8);
#define PG8_SA(b, h) (((b) * 2 + (h)) * HTB)
#define PG8_SB(b, h) ((4 + (b) * 2 + (h)) * HTB)
#define PG8_STAGE(bufoff, gbase, voff) do { _Pragma("unroll") for (int _i = 0; _i < 2; ++_i) \
        __builtin_amdgcn_global_load_lds((const unsigned*)((const char*)(gbase) + (voff)[_i]), (LAS unsigned*)(lds + (bufoff) + ldsw + _i * 8192), 16, 0, 0); } while (0)
#define PG8_LDA(dst, b, h) do { _Pragma("unroll") for (int m = 0; m < 4; ++m) _Pragma("unroll") for (int k = 0; k < 2; ++k) dst[m][k] = *(const LAS bf16x8*)(lds + PG8_SA(b, h) + aoff + m * 2048 + k * 1024); } while (0)
#define PG8_LDB(dst, b, h) do { _Pragma("unroll") for (int n = 0; n < 2; ++n) _Pragma("unroll") for (int k = 0; k < 2; ++k) dst[n][k] = *(const LAS bf16x8*)(lds + PG8_SB(b, h) + boff + n * 2048 + k * 1024); } while (0)
#define PG8_MMA(ai, bj, At, Bt) do { __builtin_amdgcn_s_setprio(1); _Pragma("unroll") for (int m = 0; m < 4; ++m) _Pragma("unroll") for (int n = 0; n < 2; ++n) _Pragma("unroll") for (int k = 0; k < 2; ++k) \
        acc[ai][bj][m][n] = __builtin_amdgcn_mfma_f32_16x16x32_bf16(Bt[n][k], At[m][k], acc[ai][bj][m][n], 0, 0, 0); __builtin_amdgcn_s_setprio(0); } while (0)
#define PG8_WAIT_V(n) asm volatile("s_waitcnt vmcnt(" #n ")" ::: "memory")
#define PG8_WAIT_L(n) asm volatile("s_waitcnt lgkmcnt(" #n ")" ::: "memory")
#define PG8_BAR __builtin_amdgcn_s_barrier()
#define PG8_SCHED __builtin_amdgcn_sched_barrier(0)
    Unit cur, nxt; int ui = 0;
    if (!S.next(0, cur)) return;
    f32x4 acc[2][2][4][2];
#pragma unroll
    for (int a = 0; a < 2; ++a)
#pragma unroll
        for (int b = 0; b < 2; ++b)
#pragma unroll
            for (int m = 0; m < 4; ++m)
#pragma unroll
                for (int n = 0; n < 2; ++n) acc[a][b][m][n] = (f32x4){0.f, 0.f, 0.f, 0.f};
    bf16x8 At[4][2], B0[2][2], B1[2][2];
    const char* cA = (const char*)g.A + (size_t)cur.pm * tstepA; const char* cB = (const char*)g.Bt + (size_t)cur.pn * tstepB;
    PG8_STAGE(PG8_SB(0, 0), cB, voffB); PG8_STAGE(PG8_SB(0, 1), cB + hstepB, voffB); PG8_STAGE(PG8_SA(0, 0), cA, voffA); PG8_STAGE(PG8_SA(0, 1), cA + hstepA, voffA);
    if (wr == 1) PG8_BAR;
    PG8_WAIT_V(2); PG8_BAR;
    PG8_STAGE(PG8_SB(1, 0), cB + kstep, voffB); PG8_STAGE(PG8_SA(1, 0), cA + kstep, voffA); PG8_STAGE(PG8_SB(1, 1), cB + hstepB + kstep, voffB);
    PG8_WAIT_V(6); PG8_BAR;
    for (;;) {
        const bool has_next = S.next(ui + 1, nxt);
        const char* nA = has_next ? (const char*)g.A + (size_t)nxt.pm * tstepA : cA; const char* nB = has_next ? (const char*)g.Bt + (size_t)nxt.pn * tstepB : cB;
        for (int t = 0; t < nt; t += 2) {
            const bool last = (t == nt - 2);
            const char* a1 = cA + (size_t)(t + 1) * kstep;
            const char* a2 = last ? nA : cA + (size_t)(t + 2) * kstep; const char* b2 = last ? nB : cB + (size_t)(t + 2) * kstep;
            const char* a3 = a2 + kstep; const char* b3 = b2 + kstep;
            PG8_LDB(B0, 0, 0); PG8_LDB(B1, 0, 1); PG8_SCHED; PG8_LDA(At, 0, 0); PG8_STAGE(PG8_SA(1, 1), a1 + hstepA, voffA);
            PG8_WAIT_V(8); PG8_WAIT_L(0); PG8_BAR; PG8_MMA(0, 0, At, B0); PG8_MMA(0, 1, At, B1); PG8_BAR; PG8_SCHED;
            PG8_LDA(At, 0, 1); PG8_STAGE(PG8_SB(0, 0), b2, voffB); PG8_STAGE(PG8_SB(0, 1), b2 + hstepB, voffB); PG8_STAGE(PG8_SA(0, 0), a2, voffA);
            PG8_WAIT_V(8); PG8_WAIT_L(0); PG8_BAR; PG8_MMA(1, 0, At, B0); PG8_MMA(1, 1, At, B1); PG8_BAR; PG8_SCHED;
            PG8_LDB(B0, 1, 0); PG8_LDB(B1, 1, 1); PG8_SCHED; PG8_LDA(At, 1, 0); PG8_STAGE(PG8_SA(0, 1), a2 + hstepA, voffA);
            PG8_WAIT_V(8); PG8_WAIT_L(0); PG8_BAR; PG8_MMA(0, 0, At, B0); PG8_MMA(0, 1, At, B1); PG8_BAR; PG8_SCHED;
            PG8_LDA(At, 1, 1); PG8_STAGE(PG8_SB(1, 0), b3, voffB); PG8_STAGE(PG8_SB(1, 1), b3 + hstepB, voffB); PG8_STAGE(PG8_SA(1, 0), a3, voffA);
            PG8_WAIT_V(8); PG8_WAIT_L(0); PG8_BAR; PG8_MMA(1, 0, At, B0); PG8_MMA(1, 1, At, B1); PG8_BAR; PG8_SCHED;
        }
        if (wr == 0) PG8_BAR;
        E(acc, cur, wr, wc, fr, fq);
        if (!has_next) break;
#pragma unroll
        for (int a = 0; a < 2; ++a)
#pragma unroll
            for (int b = 0; b < 2; ++b)
#pragma unroll
                for (int m = 0; m < 4; ++m)
#pragma unroll
                    for (int n = 0; n < 2; ++n) acc[a][b][m][n] = (f32x4){0.f, 0.f, 0.f, 0.f};
        cur = nxt; cA = nA; cB = nB; ++ui;
        if (wr == 1) PG8_BAR;
    }
    PG8_WAIT_V(0);
    PG8_BAR;
#undef PG8_SA
#undef PG8_SB
#undef PG8_STAGE
#undef PG8_LDA
#undef PG8_LDB
#undef PG8_MMA
#undef PG8_WAIT_V
#undef PG8_WAIT_L
#undef PG8_BAR
#undef PG8_SCHED
}
}

template <int VS, int D> __device__ __forceinline__ void tr_block(unsigned a, s16x4 (&l)[4], s16x4 (&h)[4]) {
    asm volatile("ds_read_b64_tr_b16 %0, %1 offset:%2" : "=v"(l[0]) : "v"(a), "i"(0 * VS + D * 64) : "memory");
    asm volatile("ds_read_b64_tr_b16 %0, %1 offset:%2" : "=v"(h[0]) : "v"(a), "i"(4 * VS + D * 64) : "memory");
    asm volatile("ds_read_b64_tr_b16 %0, %1 offset:%2" : "=v"(l[1]) : "v"(a), "i"(16 * VS + D * 64) : "memory");
    asm volatile("ds_read_b64_tr_b16 %0, %1 offset:%2" : "=v"(h[1]) : "v"(a), "i"(20 * VS + D * 64) : "memory");
    asm volatile("ds_read_b64_tr_b16 %0, %1 offset:%2" : "=v"(l[2]) : "v"(a), "i"(32 * VS + D * 64) : "memory");
    asm volatile("ds_read_b64_tr_b16 %0, %1 offset:%2" : "=v"(h[2]) : "v"(a), "i"(36 * VS + D * 64) : "memory");
    asm volatile("ds_read_b64_tr_b16 %0, %1 offset:%2" : "=v"(l[3]) : "v"(a), "i"(48 * VS + D * 64) : "memory");
    asm volatile("ds_read_b64_tr_b16 %0, %1 offset:%2" : "=v"(h[3]) : "v"(a), "i"(52 * VS + D * 64) : "memory");
}
#define TR_WAIT8(l, h) asm volatile("s_waitcnt lgkmcnt(8)" : "+v"(l[0]), "+v"(l[1]), "+v"(l[2]), "+v"(l[3]), "+v"(h[0]), "+v"(h[1]), "+v"(h[2]), "+v"(h[3]) :: "memory")
#define TR_WAIT0(l, h) asm volatile("s_waitcnt lgkmcnt(0)" : "+v"(l[0]), "+v"(l[1]), "+v"(l[2]), "+v"(l[3]), "+v"(h[0]), "+v"(h[1]), "+v"(h[2]), "+v"(h[3]) :: "memory")
#define PV4(d, l, h) do { _Pragma("unroll") for (int cc = 0; cc < 4; ++cc) { \
        const bf16x8 vf = (bf16x8){l[cc][0], l[cc][1], l[cc][2], l[cc][3], h[cc][0], h[cc][1], h[cc][2], h[cc][3]}; \
        o[d] = __builtin_amdgcn_mfma_f32_32x32x16_bf16(vf, __builtin_bit_cast(bf16x8, pw[cc]), o[d], 0, 0, 0); } } while (0)

__device__ __forceinline__ float fadd_s(float a, float b) { float r; asm("v_add_f32_e32 %0, %1, %2" : "=v"(r) : "v"(a), "v"(b)); return r; }
template <int DK, int DK1, int DV, bool MASK, bool NEGM = true, bool PF2 = false, int VAH = 1, bool SHIFT = false>
__device__ __forceinline__ void attn_core(LAS unsigned char* lds,
        const bf16_t* Qp, long ldq, const bf16_t* K1p, long ldk1, const bf16_t* K2p, long ldk2, const bf16_t* Vp, long ldv,
        int q0, int kt0, int kt1, int W, f32x16 (&o)[DV / 32], float& m_out, float& l_out) {
    constexpr int KS = DK * 2 + 16, VS = DV * 2 + 64, KBUF = 64 * KS, VBUF = 64 * VS;
    constexpr int KCH1 = DK1 / 8, NKC1 = 64 * KCH1, KPT1 = (NKC1 + 511) / 512, KCH2 = (DK - DK1) / 8, NKC2 = 64 * KCH2, KPT2 = (NKC2 + 511) / 512, KPT = KPT1 + KPT2;
    constexpr int VCH = DV / 8, NVC = 64 * VCH, VPT = (NVC + 511) / 512;
    static_assert(3 * KBUF + 3 * VBUF <= 131072, "attn lds");
    int tid = threadIdx.x; asm volatile("" : "+v"(tid));
    const int lane = tid & 63, wid = __builtin_amdgcn_readfirstlane(tid >> 6), r32 = lane & 31, hi = lane >> 5;
    LAS unsigned char* kbuf = lds; LAS unsigned char* vbuf = lds + 3 * KBUF;
    const int qlo = q0 + wid * 32, qrow = qlo + r32;
    bf16x8 qf[DK / 16];
#pragma unroll
    for (int c = 0; c < DK / 16; ++c) qf[c] = *(const bf16x8*)(Qp + (long)qrow * ldq + 16 * c + 8 * hi);
#pragma unroll
    for (int d = 0; d < DV / 32; ++d) o[d] = f32x16{};
    float mrun = 0.f, lrun = 0.f;
    u32x4 kreg0[KPT], vreg0[VPT], kreg1[KPT], vreg1[VPT];
#pragma unroll
    for (int i = 0; i < KPT; ++i) { kreg0[i] = (u32x4){0u, 0u, 0u, 0u}; kreg1[i] = kreg0[i]; }
#pragma unroll
    for (int i = 0; i < VPT; ++i) { vreg0[i] = (u32x4){0u, 0u, 0u, 0u}; vreg1[i] = vreg0[i]; }
    unsigned kgo[KPT], vgo[VPT]; int klo_[KPT], vlo_[VPT];
#pragma unroll
    for (int i = 0; i < KPT1; ++i) { const int e = (tid + 512 * i) % NKC1, row = e / KCH1, ch = e % KCH1; kgo[i] = (unsigned)(row * (int)ldk1 + ch * 8) * 2u; klo_[i] = row * KS + ch * 16; }
#pragma unroll
    for (int i = 0; i < KPT2; ++i) { const int e = (tid + 512 * i) % (NKC2 ? NKC2 : 1), row = e / (KCH2 ? KCH2 : 1), ch = e % (KCH2 ? KCH2 : 1); kgo[KPT1 + i] = (unsigned)(row * (int)ldk2 + ch * 8) * 2u; klo_[KPT1 + i] = row * KS + (KCH1 + ch) * 16; }
#pragma unroll
    for (int i = 0; i < VPT; ++i) { const int e = (tid + 512 * i) % NVC, row = e / VCH, ch = e % VCH; vgo[i] = (unsigned)(row * (int)ldv + ch * 8) * 2u; vlo_[i] = row * VS + ch * 16; }
#define ATT_LOAD(t, kreg, vreg) do { \
    const char* k1t_ = (const char*)(K1p + 64L * (t) * ldk1); const char* k2t_ = (const char*)(K2p + 64L * (t) * ldk2); const char* vt_ = (const char*)(Vp + 64L * (t) * ldv); \
    _Pragma("unroll") for (int i_ = 0; i_ < KPT1; ++i_) { kreg[i_] = *(const u32x4*)(k1t_ + (size_t)kgo[i_]); } \
    _Pragma("unroll") for (int i_ = 0; i_ < KPT2; ++i_) { kreg[KPT1 + i_] = *(const u32x4*)(k2t_ + (size_t)kgo[KPT1 + i_]); } \
    _Pragma("unroll") for (int i_ = 0; i_ < VPT; ++i_) { vreg[i_] = *(const u32x4*)(vt_ + (size_t)vgo[i_]); } } while (0)
#define ATT_STORE(b) do { \
    _Pragma("unroll") for (int i_ = 0; i_ < KPT1; ++i_) { if ((NKC1 % 512 == 0) || tid + 512 * i_ < NKC1) *(LAS u32x4*)(kbuf + (b) * KBUF + klo_[i_]) = kreg[i_]; } \
    _Pragma("unroll") for (int i_ = 0; i_ < KPT2; ++i_) { if ((NKC2 % 512 == 0) || tid + 512 * i_ < NKC2) *(LAS u32x4*)(kbuf + (b) * KBUF + klo_[KPT1 + i_]) = kreg[KPT1 + i_]; } \
    _Pragma("unroll") for (int i_ = 0; i_ < VPT; ++i_) { if ((NVC % 512 == 0) || tid + 512 * i_ < NVC) *(LAS u32x4*)(vbuf + (b) * VBUF + vlo_[i_]) = vreg[i_]; } } while (0)
#define ATT_STOREKV(kb_, vb_, kreg, vreg) do { \
    _Pragma("unroll") for (int i_ = 0; i_ < KPT1; ++i_) { if ((NKC1 % 512 == 0) || tid + 512 * i_ < NKC1) *(LAS u32x4*)(kbuf + (kb_) * KBUF + klo_[i_]) = kreg[i_]; } \
    _Pragma("unroll") for (int i_ = 0; i_ < KPT2; ++i_) { if ((NKC2 % 512 == 0) || tid + 512 * i_ < NKC2) *(LAS u32x4*)(kbuf + (kb_) * KBUF + klo_[KPT1 + i_]) = kreg[KPT1 + i_]; } \
    _Pragma("unroll") for (int i_ = 0; i_ < VPT; ++i_) { if ((NVC % 512 == 0) || tid + 512 * i_ < NVC) *(LAS u32x4*)(vbuf + (vb_) * VBUF + vlo_[i_]) = vreg[i_]; } } while (0)
    ATT_LOAD(kt0, kreg0, vreg0); ATT_STOREKV(0, 0, kreg0, vreg0);
    if (PF2) ATT_LOAD((kt0 + 1 < kt1 ? kt0 + 1 : kt1 - 1), kreg1, vreg1);
    __syncthreads();
    const int pr = (r32 & 0x13) | ((r32 & 8) >> 1) | ((r32 & 4) << 1);
    const int koff = pr * KS + hi * 16;
    const int voff = (8 * hi + ((lane & 15) >> 2)) * VS + (16 * ((lane >> 4) & 1) + 4 * (lane & 3)) * 2;
    int ta = kt0, tb = kt1;
    if (MASK) { int lo = (qlo - W) >> 6; if (qlo - W < 0) lo = 0; if (lo > ta) ta = lo; const int hi_t = ((qlo + 31) >> 6) + 1; if (hi_t < tb) tb = hi_t; }
    constexpr int NQ = 2 * (DK / 16), NPV = 4 * (DV / 32), VA = (36 + NQ - 1) / NQ, VC = 32 / NPV;
    f32x16 negm = f32x16{};
    f32x16 sA0 = f32x16{}, sA1 = f32x16{};
    u32x4 pw[4];
#pragma unroll
    for (int i = 0; i < 4; ++i) pw[i] = (u32x4){0u, 0u, 0u, 0u};
    s16x4 va_l[4], va_h[4], vb_l[4], vb_h[4];
#pragma unroll
    for (int i = 0; i < 4; ++i) { va_l[i] = (s16x4){0, 0, 0, 0}; va_h[i] = va_l[i]; vb_l[i] = va_l[i]; vb_h[i] = va_l[i]; }
    bool has_pend = false, started = false;
    int kb_cur = 0, vb_cur = 0, vb_prev = 0;
#define ATT_X1(t, S0, S1) do { if (doqk_) { \
                if (NEGM) { S0 = negm; S1 = negm; } else { S0 = f32x16{}; S1 = f32x16{}; } \
                const LAS unsigned char* kb = kbuf + kb_cur * KBUF + koff; \
                bf16x8 ka0 = *(const LAS bf16x8*)(kb), ka1 = *(const LAS bf16x8*)(kb + 32 * KS); \
                __builtin_amdgcn_s_setprio(1); \
                _Pragma("unroll") for (int c = 0; c < DK / 16; ++c) { \
                    bf16x8 kn0 = ka0, kn1 = ka1; \
                    if (c + 1 < DK / 16) { kn0 = *(const LAS bf16x8*)(kb + (c + 1) * 32); kn1 = *(const LAS bf16x8*)(kb + 32 * KS + (c + 1) * 32); } \
                    S0 = __builtin_amdgcn_mfma_f32_32x32x16_bf16(ka0, qf[c], S0, 0, 0, 0); \
                    S1 = __builtin_amdgcn_mfma_f32_32x32x16_bf16(ka1, qf[c], S1, 0, 0, 0); \
                    __builtin_amdgcn_sched_barrier(0); \
                    ka0 = kn0; ka1 = kn1; } \
                __builtin_amdgcn_s_setprio(0); \
                if (!NEGM) { _Pragma("unroll") for (int r = 0; r < 16; ++r) { S0[r] -= mrun; S1[r] -= mrun; } } \
            } } while (0)
#define ATT_X2(P0, P1) do { if (dopv_) { \
                float rs0_ = P0[0], rs1_ = P1[0], rs2_ = P0[1], rs3_ = P1[1]; \
                _Pragma("unroll") for (int r = 2; r < 16; r += 2) { rs0_ = fadd_s(rs0_, P0[r]); rs1_ = fadd_s(rs1_, P1[r]); rs2_ = fadd_s(rs2_, P0[r + 1]); rs3_ = fadd_s(rs3_, P1[r + 1]); } \
                lrun += (rs0_ + rs1_) + (rs2_ + rs3_); \
                u32x4 w; \
                w.x = pk2(P0[0], P0[1]); w.y = pk2(P0[2], P0[3]); w.z = pk2(P0[4], P0[5]); w.w = pk2(P0[6], P0[7]); pw[0] = w; \
                w.x = pk2(P0[8], P0[9]); w.y = pk2(P0[10], P0[11]); w.z = pk2(P0[12], P0[13]); w.w = pk2(P0[14], P0[15]); pw[1] = w; \
                w.x = pk2(P1[0], P1[1]); w.y = pk2(P1[2], P1[3]); w.z = pk2(P1[4], P1[5]); w.w = pk2(P1[6], P1[7]); pw[2] = w; \
                w.x = pk2(P1[8], P1[9]); w.y = pk2(P1[10], P1[11]); w.z = pk2(P1[12], P1[13]); w.w = pk2(P1[14], P1[15]); pw[3] = w; \
            } } while (0)
#define ATT_X3(t, S0, S1) do { if (doqk_) { \
                const int klo = 64 * (t); \
                if (MASK && ((klo + 63 > qlo) || (klo < qlo + 31 - W))) { \
                    const int rel = qrow - klo - 8 * hi, rel2 = rel - W; \
                    _Pragma("unroll") for (int r = 0; r < 16; ++r) { const int i = r >> 2, j = r & 3; const int c0 = 16 * (i >> 1) + 4 * (i & 1) + j, c1 = c0 + 32; \
                        S0[r] = (c0 <= rel && c0 >= rel2) ? S0[r] : NEGBIG; S1[r] = (c1 <= rel && c1 >= rel2) ? S1[r] : NEGBIG; } \
                } \
                float rm = fmaxf(fmaxf(S0[0], S1[0]), S0[1]); \
                _Pragma("unroll") for (int r = 1; r < 15; r += 2) { rm = fmaxf(fmaxf(rm, S1[r]), S0[r + 1]); rm = fmaxf(fmaxf(rm, S1[r + 1]), S0[r + 2 > 15 ? 15 : r + 2]); } \
                rm = fmaxf(rm, S1[15]); \
                { auto rr_ = __builtin_amdgcn_permlane32_swap(__float_as_uint(rm), __float_as_uint(rm), false, false); rm = fmaxf(__uint_as_float(rr_[0]), __uint_as_float(rr_[1])); } \
                const float dl = started ? ((rm > 8.f) ? rm : 0.f) : rm; \
                if (__builtin_amdgcn_ballot_w64(dl != 0.f) != 0ull) { \
                    mrun += dl; \
                    _Pragma("unroll") for (int r = 0; r < 16; ++r) { S0[r] -= dl; S1[r] -= dl; } \
                    if (NEGM) { _Pragma("unroll") for (int r = 0; r < 16; ++r) negm[r] = -mrun; } \
                    if (started) { fsc_ = __builtin_amdgcn_exp2f(-dl); lrun *= fsc_; resc_ = true; } \
                } \
            } } while (0)
#define ATT_X4() do { if (dopv_) { \
                const unsigned va_ = (unsigned)(size_t)(vbuf + vb_prev * VBUF + voff); \
                __builtin_amdgcn_s_setprio(1); \
                tr_block<VS, 0>(va_, va_l, va_h); \
                tr_block<VS, 1>(va_, vb_l, vb_h); \
                if (DV == 64) { TR_WAIT8(va_l, va_h); PV4(0, va_l, va_h); TR_WAIT0(vb_l, vb_h); PV4(1, vb_l, vb_h); } \
                else { TR_WAIT8(va_l, va_h); PV4(0, va_l, va_h); \
                    tr_block<VS, 2>(va_, va_l, va_h); TR_WAIT8(vb_l, vb_h); PV4(1, vb_l, vb_h); \
                    tr_block<VS, 3>(va_, vb_l, vb_h); TR_WAIT8(va_l, va_h); PV4(DV == 64 ? 0 : 2, va_l, va_h); \
                    TR_WAIT0(vb_l, vb_h); PV4(DV == 64 ? 1 : 3, vb_l, vb_h); } \
                __builtin_amdgcn_s_setprio(0); \
            } } while (0)
#define ATT_X5(S0, S1) do { if (doqk_) { \
                _Pragma("unroll") for (int r = 0; r < 16; ++r) { S0[r] = __builtin_amdgcn_exp2f(S0[r]); S1[r] = __builtin_amdgcn_exp2f(S1[r]); } \
            } } while (0)
#define ATT_STEP(t, KL, VL, KST, VST) do { \
        const bool more_ = ((t) + 1 < kt1); \
        { const int tl_ = (t) + (PF2 ? 2 : 1); ATT_LOAD((tl_ < kt1 ? tl_ : kt1 - 1), KL, VL); }     \
        __builtin_amdgcn_sched_barrier(0);     \
        const bool doqk_ = ((t) >= ta) && ((t) < tb); \
        const bool dopv_ = has_pend; \
        float fsc_ = 1.f; bool resc_ = false; \
        ATT_X2(sA0, sA1); ATT_X4(); \
        const int sl_n_ = (kb_cur == 2) ? 0 : kb_cur + 1; \
        if (grp2) { asm volatile("s_waitcnt lgkmcnt(0)" ::: "memory"); __builtin_amdgcn_s_barrier(); asm volatile("" ::: "memory"); } \
        ATT_X1(t, sA0, sA1); ATT_X3(t, sA0, sA1); ATT_X5(sA0, sA1); \
        if (resc_) { \
            _Pragma("unroll") for (int d = 0; d < DV / 32; ++d) _Pragma("unroll") for (int r = 0; r < 16; ++r) o[d][r] *= fsc_; \
        } \
        has_pend = doqk_; started = started || doqk_; \
        __builtin_amdgcn_sched_barrier(0); \
        ATT_STOREKV(sl_n_, sl_n_, KST, VST); \
        vb_prev = kb_cur; kb_cur = sl_n_; \
        if (!grp2) { asm volatile("s_waitcnt lgkmcnt(0)" ::: "memory"); __builtin_amdgcn_s_barrier(); asm volatile("" ::: "memory"); } \
    } while (0)
    const bool grp2 = SHIFT && (wid >= 4);
    for (int t = kt0; t <= kt1; t += 2) {
        if (PF2) { ATT_STEP(t, kreg0, vreg0, kreg1, vreg1); if (t + 1 <= kt1) ATT_STEP(t + 1, kreg1, vreg1, kreg0, vreg0); }
        else { ATT_STEP(t, kreg0, vreg0, kreg0, vreg0); if (t + 1 <= kt1) ATT_STEP(t + 1, kreg0, vreg0, kreg0, vreg0); }
    }
#undef ATT_STEP
#undef ATT_X1
#undef ATT_X2
#undef ATT_X3
#undef ATT_X4
#undef ATT_X5
#undef ATT_STOREKV
#undef ATT_LOAD
#undef ATT_STORE
    lrun += __shfl_xor(lrun, 32);
    m_out = mrun; l_out = lrun;
}

#define XB_TMO      128
#define XB_XCNT(j)  (256  + 64 * (j))
#define XB_XSUB(j)  (1280 + 64 * (j))
#define XB_XGEN(j)  (2304 + 64 * (j))
#define XB_TOP      3328
#define XB_TOPGEN   3392
#define XCD_BAR_WORDS 3456
#define XB_SPIN_CAP (1u << 20)
__device__ __forceinline__ unsigned xb_ld(unsigned* p)              { return __hip_atomic_load(p, __ATOMIC_RELAXED, __HIP_MEMORY_SCOPE_AGENT); }
__device__ __forceinline__ unsigned xb_add(unsigned* p, unsigned v) { return __hip_atomic_fetch_add(p, v, __ATOMIC_RELAXED, __HIP_MEMORY_SCOPE_AGENT); }
__device__ __forceinline__ unsigned xb_xcc_id() { return (unsigned)__builtin_amdgcn_s_getreg((3 << 11) | 20) & 0xFu; }
#define XB_SPIN(cond, bar) do { unsigned _sp = 0; while (cond) { __builtin_amdgcn_s_sleep(1); \
    if ((++_sp & 255u) == 0u) { if (xb_ld(&(bar)[XB_TMO])) break; if (_sp > XB_SPIN_CAP) { atomicAdd(&(bar)[XB_TMO], 1u); break; } } } } while (0)
struct XcdBarrier { unsigned* bar; unsigned x; volatile LAS unsigned* st; };
__device__ __forceinline__ XcdBarrier xcd_barrier_post(unsigned* bar, volatile LAS unsigned* st) {
    XcdBarrier b; b.bar = bar; b.x = xb_xcc_id(); b.st = st;
    if (threadIdx.x == 0) (void)xb_add(&bar[XB_XCNT(b.x)], 1u);
    return b;
}
__device__ __forceinline__ void xcd_barrier_complete(unsigned* bar, unsigned x, unsigned& nloc, unsigned& nx) {
    const unsigned G = gridDim.x * gridDim.y * gridDim.z;
    unsigned sum, cnt, mine, sp = 0u;
    for (;;) {
        sum = 0u; cnt = 0u; mine = 0u;
#pragma unroll
        for (unsigned j = 0; j < 16; ++j) { const unsigned c = xb_ld(&bar[XB_XCNT(j)]); sum += c; cnt += (c > 0u) ? 1u : 0u; mine = (j == x) ? c : mine; }
        if (sum == G) break;
        __builtin_amdgcn_s_sleep(1);
        if ((++sp & 255u) == 0u) { if (xb_ld(&bar[XB_TMO])) break; if (sp > XB_SPIN_CAP) { atomicAdd(&bar[XB_TMO], 1u); break; } }
    }
    nloc = mine > 0u ? mine : 1u; nx = cnt > 0u ? cnt : 1u;
}
__device__ __forceinline__ void xcd_barrier(const XcdBarrier& b) {
    asm volatile("s_waitcnt vmcnt(0)" ::: "memory");
    __syncthreads();
    if (threadIdx.x == 0) {
        unsigned* bar = b.bar;
        __builtin_amdgcn_s_waitcnt(0);
        unsigned nloc = b.st[0], nx = b.st[1];
        if (nloc == 0u) { xcd_barrier_complete(bar, b.x, nloc, nx); b.st[0] = nloc; b.st[1] = nx; }
        const unsigned old = xb_add(&bar[XB_XSUB(b.x)], 1u);
        const unsigned gen = old / nloc;
        if (old + 1u == (gen + 1u) * nloc) {
            __builtin_amdgcn_fence(__ATOMIC_RELEASE, "agent");
            asm volatile("s_waitcnt vmcnt(0)" ::: "memory");
            const unsigned og = xb_add(&bar[XB_TOP], 1u);
            const unsigned tg = og / nx;
            if (og + 1u == (tg + 1u) * nx) xb_add(&bar[XB_TOPGEN], 1u);
            else XB_SPIN(xb_ld(&bar[XB_TOPGEN]) == tg, bar);
            __builtin_amdgcn_fence(__ATOMIC_ACQUIRE, "agent");
            xb_add(&bar[XB_XGEN(b.x)], 1u);
            asm volatile("s_waitcnt vmcnt(0)" ::: "memory");
        } else {
            XB_SPIN(xb_ld(&bar[XB_XGEN(b.x)]) == gen, bar);
            __builtin_amdgcn_fence(__ATOMIC_ACQUIRE, "agent");
            asm volatile("s_waitcnt vmcnt(0)" ::: "memory");
        }
    }
    __syncthreads();
}

struct Args { const void* in[31]; float* out; unsigned char* ws; int ph_lo, ph_hi; };

__device__ __forceinline__ float wave_sum(float v) {
#pragma unroll
    for (int o = 1; o < 64; o <<= 1) v += __shfl_xor(v, o);
    return v;
}

__device__ __forceinline__ void transpose_items(const float* W, int K, int N, const float* gain, bf16_t* WT, int ldt, int row_off, LAS float* scr, int gw, int NGW, int lane) {
    const int nblk = N / 32, nitems = (K / 64) * nblk;
    for (int item = gw; item < nitems; item += NGW) {
        const int kb = item / nblk, nb = item % nblk, k0 = 64 * kb, n0 = 32 * nb;
        float tmp[32];
#pragma unroll
        for (int i = 0; i < 32; ++i) { const int kk = 2 * i + (lane >> 5); tmp[i] = W[(size_t)(k0 + kk) * N + n0 + (lane & 31)]; }
#pragma unroll
        for (int i = 0; i < 32; ++i) { const int kk = 2 * i + (lane >> 5); scr[kk * 33 + (lane & 31)] = tmp[i]; }
        asm volatile("s_waitcnt lgkmcnt(0)" ::: "memory");
        const int c = lane & 7;
        f32x4 g0 = {1.f, 1.f, 1.f, 1.f}, g1 = g0;
        if (gain) { g0 = *(const f32x4*)(gain + k0 + 8 * c); g1 = *(const f32x4*)(gain + k0 + 8 * c + 4); }
#pragma unroll
        for (int j = 0; j < 4; ++j) { const int n = (lane >> 3) + 8 * j; const LAS float* sp = scr + (8 * c) * 33 + n;
            u32x4 o; o.x = pk2(sp[0 * 33] * g0.x, sp[1 * 33] * g0.y); o.y = pk2(sp[2 * 33] * g0.z, sp[3 * 33] * g0.w); o.z = pk2(sp[4 * 33] * g1.x, sp[5 * 33] * g1.y); o.w = pk2(sp[6 * 33] * g1.z, sp[7 * 33] * g1.w);
            *(u32x4*)(WT + (size_t)(row_off + n0 + n) * ldt + k0 + 8 * c) = o; }
        asm volatile("s_waitcnt lgkmcnt(0)" ::: "memory");
    }
}

__global__ void __launch_bounds__(512) mk_fwd(Args args) {
    extern __shared__ __attribute__((aligned(16))) unsigned char lds_raw[];
    LAS unsigned char* lds = (LAS unsigned char*)lds_raw;
    cg::grid_group grid = cg::this_grid();
    volatile LAS unsigned* bst = (volatile LAS unsigned*)(lds + 131072 + 256);
    unsigned* barw = (unsigned*)(GAS unsigned*)(args.ws + WS_MISC + 65536);
    if (threadIdx.x < 2) bst[threadIdx.x] = 0u;
    if (blockIdx.x == 0) { for (int i = threadIdx.x; i < XCD_BAR_WORDS; i += 512) barw[i] = 0u; }
    __syncthreads();
    XcdBarrier xbar; xbar.bar = barw; xbar.x = 0; xbar.st = bst;
    bool posted = false;
    int rep = 0;
    for (int ph = args.ph_lo; ph < args.ph_hi; ++ph) {
    int tid = threadIdx.x; asm volatile("" : "+v"(tid));
    const int lane = tid & 63, wave = __builtin_amdgcn_readfirstlane(tid >> 6);
    const int G = gridDim.x, bid = blockIdx.x;
    const int gw = bid * 8 + wave, NGW = G * 8;
    const int vcu = (G % 8 == 0) ? (bid % 8) * (G / 8) + bid / 8 : bid;
    unsigned long long wsi_ = (unsigned long long)args.ws; asm volatile("" : "+s"(wsi_));
    unsigned char* ws = (unsigned char*)(GAS unsigned char*)wsi_;
    const float* x_in = TOG(const float, args.in[0]);
    float* outp = TOG(float, args.out);
    bf16_t* Wt = (bf16_t*)(ws + WS_W);
    bf16_t* XB = (bf16_t*)(ws + WS_XB);
    float* O1S = outp;
    (void)0;
    unsigned char* BIG = ws + WS_BIG;
    bf16_t* Z = (bf16_t*)(BIG + OB_Z);
    bf16_t* OA = (bf16_t*)(BIG + OB_OA);
    bf16_t* QD = (bf16_t*)(BIG + OB_QD);
    bf16_t* KVD = (bf16_t*)(BIG + OB_KVD);
    bf16_t* Hb = (bf16_t*)(BIG + OB_H);
    bf16_t* Y = (bf16_t*)(ws + WS_Y);
    bf16_t* QX = (bf16_t*)(ws + WS_Y);
    bf16_t* OX = (bf16_t*)(ws + WS_Y + 32 * MiB);
    bf16_t* KVMEM = (bf16_t*)(ws + WS_KVMEM);
    bf16_t* MN = (bf16_t*)(ws + WS_MN);
    float* SSQX = (float*)(ws + WS_SSQX);
    float* SSQZ = (float*)(ws + WS_SSQZ);
    float* RCOS = (float*)(ws + WS_ROPE);
    float* RSIN = RCOS + (size_t)T * 16;
    float* LSE = (float*)(ws + WS_LSE);
    float* MISC = (float*)(ws + WS_MISC);

        const int layer = (ph >= 14) ? 1 : 0;
        if (ph == 0 && (PHMASK & 1)) {
            LAS float* scr = (LAS float*)(lds + wave * 16384);
            const float* g_mix = TOG(const float, args.in[3]); const float* g_cross = TOG(const float, args.in[4]); const float* g_mlp = TOG(const float, args.in[9]);
            for (int l = 0; l < 2; ++l) {
                bf16_t* wl = Wt + l * LW;
                transpose_items(TOG(const float, args.in[6]) + (size_t)l * 1024 * 512, 1024, 512, g_cross + l * 1024, wl + OW_Q, 1024, 0, scr, gw, NGW, lane);
                transpose_items(TOG(const float, args.in[7]) + (size_t)l * 1024 * 1024, 1024, 1024, nullptr, wl + OW_KV, 1024, 0, scr, gw, NGW, lane);
                transpose_items(TOG(const float, args.in[8]) + (size_t)l * 512 * 1024, 512, 1024, nullptr, wl + OW_O, 512, 0, scr, gw, NGW, lane);
                transpose_items(TOG(const float, args.in[10]) + (size_t)l * 1024 * 4096, 1024, 4096, g_mlp + l * 1024, wl + OW_1, 1024, 0, scr, gw, NGW, lane);
                transpose_items(TOG(const float, args.in[11]) + (size_t)l * 4096 * 1024, 4096, 1024, nullptr, wl + OW_2, 4096, 0, scr, gw, NGW, lane);
            }
            transpose_items(TOG(const float, args.in[12]), 1024, 2560, g_mix, Wt + OW_ABIN, 1024, 0, scr, gw, NGW, lane);
            transpose_items(TOG(const float, args.in[13]), 1024, 1024, nullptr, Wt + OW_ABOUT, 1024, 0, scr, gw, NGW, lane);
            transpose_items(TOG(const float, args.in[18]), 1024, 2208, g_mix + 1024, Wt + OW_CDIN, 1024, 0, scr, gw, NGW, lane);
            transpose_items(TOG(const float, args.in[19]), 1024, 1024, nullptr, Wt + OW_CDOUT, 1024, 0, scr, gw, NGW, lane);
            transpose_items(TOG(const float, args.in[27]), 384, 768, TOG(const float, args.in[25]), Wt + OW_UQ, 384, 0, scr, gw, NGW, lane);
            transpose_items(TOG(const float, args.in[28]), 256, 512, TOG(const float, args.in[26]), Wt + OW_UKV, 256, 0, scr, gw, NGW, lane);
            transpose_items(TOG(const float, args.in[29]), 256, 512, TOG(const float, args.in[26]), Wt + OW_UKV, 256, 512, scr, gw, NGW, lane);
            { u32x4* zp = (u32x4*)(Wt + OW_CDIN + (size_t)2208 * 1024); const int n16 = 96 * 1024 * 2 / 16;
              for (int i = bid * 512 + tid; i < n16; i += G * 512) zp[i] = (u32x4){0u, 0u, 0u, 0u}; }
            for (int m = gw; m < T; m += NGW) {
                const f32x4* xr = (const f32x4*)(x_in + (size_t)m * D) + lane; float s = 0.f;
                unsigned long long* o8 = (unsigned long long*)(XB + (size_t)m * D) + lane;
#pragma unroll
                for (int j = 0; j < 4; ++j) { const f32x4 v = xr[64 * j]; s += (v.x * v.x + v.y * v.y) + (v.z * v.z + v.w * v.w);
                    o8[64 * j] = (unsigned long long)pk2(v.x, v.y) | ((unsigned long long)pk2(v.z, v.w) << 32); }
                s = wave_sum(s);
                if (lane < 16) SSQX[(size_t)m * 16 + lane] = (lane == 0) ? s : 0.f;
            }
            for (int mm = gw; mm < 2 * 1024; mm += NGW) {
                const int l = mm >> 10, m = mm & 1023;
                const f32x4* xr = (const f32x4*)(TOG(const float, args.in[1]) + (size_t)m * D) + lane; const f32x4* gr = (const f32x4*)(TOG(const float, args.in[5]) + l * D) + lane;
                f32x4 v[4]; float s = 0.f;
#pragma unroll
                for (int j = 0; j < 4; ++j) { v[j] = xr[64 * j]; s += (v[j].x * v[j].x + v[j].y * v[j].y) + (v[j].z * v[j].z + v[j].w * v[j].w); }
                const float r = 1.0f / sqrtf(wave_sum(s) * (1.f / D) + EPS);
                unsigned long long* o8 = (unsigned long long*)(MN + ((size_t)l * 1024 + m) * D) + lane;
#pragma unroll
                for (int j = 0; j < 4; ++j) { const f32x4 gg = gr[64 * j]; o8[64 * j] = (unsigned long long)pk2(v[j].x * r * gg.x, v[j].y * r * gg.y) | ((unsigned long long)pk2(v[j].z * r * gg.z, v[j].w * r * gg.w) << 32); }
            }
            for (int i = bid * 512 + tid; i < T * 16; i += G * 512) {
                const int row = i >> 4, fi = i & 15;
                const float invf = __builtin_amdgcn_exp2f(-(float)fi * 0.83048202372184058696f);
                const double rev = (double)(TOG(const int, args.in[2]))[row] * (double)invf * 0.15915494309189533577;
                const float fr = (float)(rev - rint(rev));
                RCOS[i] = __builtin_amdgcn_cosf(fr); RSIN[i] = __builtin_amdgcn_sinf(fr);
            }
            if (bid == 0 && wave == 0) {
                const float a = (TOG(const float, args.in[20]))[lane] * (TOG(const float, args.in[21]))[lane], b2 = (TOG(const float, args.in[22]))[lane] * (TOG(const float, args.in[23]))[lane];
                const float sa = wave_sum(a), sb = wave_sum(b2);
                if (lane == 0) MISC[0] = __expf(sa) - __expf(sb) + 0.35550906759097f;
            }
        }
        if ((PHMASK & 2) && (ph == 1 || ph == 5 || ph == 8 || ph == 10 || ph == 11 || ph == 14 || ph == 17)) {
            const int njobs = (ph == 1 || ph == 10 || ph == 11) ? 2 : 1;
            for (int j = 0; j < njobs; ++j) {
                pg8::Gemm g; pg8::EpiZ E;
                E.rs = SSQX; E.rs_stride = 16; E.rs_off = 0; E.rs_n4 = 4; E.rs_inv = 1.f / 1024.f; E.qs_end = 0; E.qscale = 1.f; E.act = 0; E.rope = 0; E.rope_g = -1;
                E.rcos = RCOS; E.rsin = RSIN; E.ssq = nullptr; E.ssq_stride = 0;
                int rot = 0;
                if (ph == 1 && j == 0) { g = pg8::Gemm{XB, Wt + OW_ABIN, T, 2560, 1024, 1024}; E.O = Z; E.ldc = 2560; E.qs_end = 512; E.qscale = 0.125f * LOG2E; }
                else if (ph == 1 || (ph == 10 && j == 1)) { const int l = (ph == 1) ? 0 : 1; g = pg8::Gemm{MN + (size_t)l * 1024 * 1024, Wt + l * LW + OW_KV, 1024, 1024, 1024, 1024}; E.O = KVMEM + (size_t)l * 1024 * 1024; E.ldc = 1024; E.rs = nullptr; rot = (ph == 1) ? 0 : 128; }
                else if (ph == 5 || ph == 14) { g = pg8::Gemm{XB, Wt + layer * LW + OW_Q, T, 512, 1024, 1024}; E.O = QX; E.ldc = 512; E.qs_end = 512; E.qscale = 0.08838834764831845f * LOG2E; }
                else if (ph == 8 || ph == 17) { g = pg8::Gemm{XB, Wt + layer * LW + OW_1, T, 4096, 1024, 1024}; E.O = Hb; E.ldc = 4096; E.act = 1; }
                else if (ph == 10) { g = pg8::Gemm{XB, Wt + OW_CDIN, T, 2304, 1024, 1024}; E.O = Z; E.ldc = 2304; E.qs_end = 512; E.qscale = 0.125f * LOG2E; E.rope = 1; E.rope_g = 68; E.ssq = SSQZ; E.ssq_stride = 72; }
                else if (ph == 11 && j == 0) { g = pg8::Gemm{Z + 1536, Wt + OW_UQ, T, 768, 384, 2304}; E.O = QD; E.ldc = 768; E.rs = SSQZ; E.rs_stride = 72; E.rs_off = 48; E.rs_n4 = 3; E.rs_inv = 1.f / 384.f;
                    E.qs_end = 768; E.qscale = 0.10206207261596577f * LOG2E; E.rope = 2; }
                else { g = pg8::Gemm{Z + 1920, Wt + OW_UKV, T, 1024, 256, 2304}; E.O = KVD; E.ldc = 1024; E.rs = SSQZ; E.rs_stride = 72; E.rs_off = 60; E.rs_n4 = 2; E.rs_inv = 1.f / 256.f; rot = 128; }
                pg8::StaticOrder S; S.init(g.M, g.N, G, (bid + rot) % G);
                pg8::gemm_phase<pg8::EpiZ>(lds, g, S, E);
            }
        }
        if ((PHMASK & 4) && (ph == 4 || ph == 7 || ph == 9 || ph == 13 || ph == 16 || ph == 18)) {
            pg8::Gemm g; pg8::EpiRes E; E.base32 = nullptr; E.base16 = XB; E.xb = XB; E.ssq = SSQX;
            if (ph == 4) { g = pg8::Gemm{Y, Wt + OW_ABOUT, T, 1024, 1024, 1024}; E.base32 = x_in; }
            else if (ph == 13) { g = pg8::Gemm{Y, Wt + OW_CDOUT, T, 1024, 1024, 1024}; }
            else if (ph == 7 || ph == 16) { g = pg8::Gemm{OX, Wt + layer * LW + OW_O, T, 1024, 512, 512}; }
            else { g = pg8::Gemm{Hb, Wt + layer * LW + OW_2, T, 1024, 4096, 4096}; }
            pg8::StaticOrder S; S.init(g.M, g.N, G, bid);
            pg8::gemm_phase<pg8::EpiRes>(lds, g, S, E);
        }
        if (ph == 2 && (PHMASK & 8)) {
            const int r32 = lane & 31, hi = lane >> 5;
            for (int u = vcu; u < 3072; u += G) {
                const int gp = u >> 10, v = u & 1023, bh = v >> 5, w = v & 31, b = bh >> 3, h = bh & 7;
                const int dil = (gp == 0) ? 1 : (gp == 1) ? 4 : 16, nu = 32 / dil, res = w / nu, n = w % nu;
                const bf16_t* base = Z + ((size_t)b * SEQ + res) * 2560 + h * 64;
                const long ld = 2560L * dil;
                f32x16 o[2]; float mr, lr;
                attn_core<64, 64, 64, true, true, true, 1, false>(lds, base, ld, base + 512, ld, base + 512, ld, base + 1024, ld, 256 * n, (4 * n - 2 < 0) ? 0 : 4 * n - 2, 4 * n + 4, 128, o, mr, lr);
                const float inv = 1.0f / lr;
                const int qrow = 256 * n + wave * 32 + r32;
                const size_t tok = (size_t)b * SEQ + res + (size_t)qrow * dil;
                bf16_t* op = OA + (size_t)gp * T * 512 + tok * 512 + h * 64;
#pragma unroll
                for (int d = 0; d < 2; ++d)
#pragma unroll
                    for (int i = 0; i < 4; ++i) { u32x2 wv; wv.x = pk2(o[d][4 * i] * inv, o[d][4 * i + 1] * inv); wv.y = pk2(o[d][4 * i + 2] * inv, o[d][4 * i + 3] * inv);
                        *(u32x2*)(op + 32 * d + 8 * i + 4 * hi) = wv; }
                if (hi == 0) LSE[(size_t)gp * T * 8 + tok * 8 + h] = mr + __builtin_amdgcn_logf(lr);
            }
            const float* cw = TOG(const float, args.in[14]); const float* cb = TOG(const float, args.in[15]); const float* lg = TOG(const float, args.in[16]); const float* lb = TOG(const float, args.in[17]);
            LAS float* gl = (LAS float*)lds;
            for (int cu = bid; cu < T / 32; cu += G) {
                const int t0 = cu * 32, bstart = (t0 / SEQ) * SEQ;
                for (int e = tid; e < 62 * 64; e += 512) {
                    const int row = e >> 6, ch = e & 63, tk = t0 - 30 + row;
                    f32x4 g0 = {0.f, 0.f, 0.f, 0.f}, g1 = g0;
                    if (tk >= bstart) {
                        const u32x4 uu = *(const u32x4*)(Z + (size_t)tk * 2560 + 1536 + ch * 8), gg = *(const u32x4*)(Z + (size_t)tk * 2560 + 2048 + ch * 8);
#pragma unroll
                        for (int q = 0; q < 4; ++q) {
                            const float u0 = bf2f(uu[q] & 0xffffu), u1 = bf2f(uu[q] >> 16), a0 = bf2f(gg[q] & 0xffffu), a1 = bf2f(gg[q] >> 16);
                            const float r0 = u0 * __builtin_amdgcn_rcpf(1.f + __expf(-a0)), r1 = u1 * __builtin_amdgcn_rcpf(1.f + __expf(-a1));
                            if (q < 2) { g0[2 * q] = r0; g0[2 * q + 1] = r1; } else { g1[2 * (q - 2)] = r0; g1[2 * (q - 2) + 1] = r1; }
                        }
                    }
                    *(LAS f32x4*)(gl + row * 512 + ch * 8) = g0; *(LAS f32x4*)(gl + row * 512 + ch * 8 + 4) = g1;
                }
                __syncthreads();
                {
                    float wv[31];
#pragma unroll
                    for (int j = 0; j < 31; ++j) wv[j] = cw[j * 512 + tid];
                    const float bias = cb[tid];
                    float res[32];
#pragma unroll
                    for (int blk = 0; blk < 4; ++blk) {
                        float in[38];
#pragma unroll
                        for (int j = 0; j < 38; ++j) in[j] = gl[(blk * 8 + j) * 512 + tid];
#pragma unroll
                        for (int i = 0; i < 8; ++i) { float a = bias;
#pragma unroll
                            for (int j = 0; j < 31; ++j) a += wv[j] * in[i + j];
                            res[blk * 8 + i] = a; }
                        __builtin_amdgcn_sched_barrier(0);
                    }
#pragma unroll
                    for (int i = 0; i < 32; ++i) gl[i * 512 + tid] = res[i];
                }
                __syncthreads();
#pragma unroll
                for (int k = 0; k < 4; ++k) {
                    const int tr = wave * 4 + k;
                    const f32x4 a = *(LAS f32x4*)(gl + tr * 512 + lane * 8), c = *(LAS f32x4*)(gl + tr * 512 + lane * 8 + 4);
                    const float mu = wave_sum((a.x + a.y) + (a.z + a.w) + (c.x + c.y) + (c.z + c.w)) * (1.f / 512.f);
                    const f32x4 da = a - mu, dc = c - mu;
                    const float var = wave_sum((da.x * da.x + da.y * da.y) + (da.z * da.z + da.w * da.w) + (dc.x * dc.x + dc.y * dc.y) + (dc.z * dc.z + dc.w * dc.w)) * (1.f / 512.f);
                    const float rstd = 1.0f / sqrtf(var + EPS);
                    const f32x4 ga = *(const f32x4*)(lg + lane * 8), gc = *(const f32x4*)(lg + lane * 8 + 4), ba = *(const f32x4*)(lb + lane * 8), bc = *(const f32x4*)(lb + lane * 8 + 4);
                    f32x4 ya = da * rstd * ga + ba, yc = dc * rstd * gc + bc;
#pragma unroll
                    for (int e = 0; e < 4; ++e) { ya[e] = ya[e] * __builtin_amdgcn_rcpf(1.f + __expf(-ya[e])); yc[e] = yc[e] * __builtin_amdgcn_rcpf(1.f + __expf(-yc[e])); }
                    u32x4 wv; wv.x = pk2(ya[0], ya[1]); wv.y = pk2(ya[2], ya[3]); wv.z = pk2(yc[0], yc[1]); wv.w = pk2(yc[2], yc[3]);
                    *(u32x4*)(Y + (size_t)(t0 + tr) * 1024 + 512 + lane * 8) = wv;
                }
                __syncthreads();
            }
        }
        if (ph == 3 && (PHMASK & 16)) {
            for (size_t i = (size_t)bid * 512 + tid; i < (size_t)T * 64; i += (size_t)G * 512) {
                const size_t tok = i >> 6; const int ch = (int)(i & 63), h = ch >> 3;
                const float l0 = LSE[tok * 8 + h], l1 = LSE[(size_t)T * 8 + tok * 8 + h], l2 = LSE[(size_t)2 * T * 8 + tok * 8 + h];
                const float mx = fmaxf(l0, fmaxf(l1, l2));
                float w0 = __builtin_amdgcn_exp2f(l0 - mx), w1 = __builtin_amdgcn_exp2f(l1 - mx), w2 = __builtin_amdgcn_exp2f(l2 - mx);
                const float inv = 1.0f / (w0 + w1 + w2); w0 *= inv; w1 *= inv; w2 *= inv;
                const u32x4 a = *(const u32x4*)(OA + tok * 512 + ch * 8), b = *(const u32x4*)(OA + (size_t)T * 512 + tok * 512 + ch * 8), c = *(const u32x4*)(OA + (size_t)2 * T * 512 + tok * 512 + ch * 8);
                u32x4 r;
#pragma unroll
                for (int q = 0; q < 4; ++q) {
                    const float lo = w0 * bf2f(a[q] & 0xffffu) + w1 * bf2f(b[q] & 0xffffu) + w2 * bf2f(c[q] & 0xffffu);
                    const float hh = w0 * bf2f(a[q] >> 16) + w1 * bf2f(b[q] >> 16) + w2 * bf2f(c[q] >> 16);
                    r[q] = pk2(lo, hh);
                }
                *(u32x4*)(Y + tok * 1024 + ch * 8) = r;
            }
        }
        if ((PHMASK & 32) && (ph == 6 || ph == 15)) {
            const int r32 = lane & 31, hi = lane >> 5;
            const bf16_t* KVl = KVMEM + (size_t)layer * 1024 * 1024;
            for (int u = vcu; u < 512; u += G) {
                const int bh = u >> 5, qb = u & 31, b = bh >> 2, h = bh & 3;
                const bf16_t* qp = QX + (size_t)b * SEQ * 512 + h * 128;
                const bf16_t* kp = KVl + (size_t)b * 256 * 1024 + h * 128;
                f32x16 o[4]; float mr, lr;
                attn_core<128, 128, 128, false, false, false, 1, false>(lds, qp, 512, kp, 1024, kp, 1024, kp + 512, 1024, 256 * qb, 0, 4, 1 << 30, o, mr, lr);
                const float inv = 1.0f / lr;
                bf16_t* op = OX + ((size_t)b * SEQ + 256 * qb + wave * 32 + r32) * 512 + h * 128;
#pragma unroll
                for (int d = 0; d < 4; ++d)
#pragma unroll
                    for (int i = 0; i < 4; ++i) { u32x2 wv; wv.x = pk2(o[d][4 * i] * inv, o[d][4 * i + 1] * inv); wv.y = pk2(o[d][4 * i + 2] * inv, o[d][4 * i + 3] * inv);
                        *(u32x2*)(op + 32 * d + 8 * i + 4 * hi) = wv; }
            }
        }
        if (ph == 12 && (PHMASK & 64)) {
            const int r32 = lane & 31, hi = lane >> 5;
            const float lam = MISC[0], osc = 0.64449093240903f;
            const float* sg = TOG(const float, args.in[24]);
#ifndef NO_C
            for (int p = vcu; p < 256; p += G) {
                const int bh = p >> 4, s = p & 15, b = bh >> 2, h = bh & 3;
                for (int half = 0; half < 2; ++half) {
                    const int qb = half ? 31 - s : s;
                    const size_t row = (size_t)b * SEQ + 256 * qb + wave * 32 + r32;
                    for (int mp = 0; mp < 2; ++mp) {
                        const bf16_t* zb = Z + (size_t)b * SEQ * 2304 + h * 128;
                        f32x16 o[4]; float mr, lr;
                        attn_core<64, 64, 128, true, false, true, 1, false>(lds, zb + mp * 64, 2304, zb + 512 + mp * 64, 2304, zb, 2304, zb + 1024, 2304, 256 * qb, 0, 4 * qb + 4, 1 << 30, o, mr, lr);
                        const float inv = 1.0f / lr;
                        float* sp = O1S + row * 512 + h * 128;
                        if (mp == 0) {
#pragma unroll
                            for (int d = 0; d < 4; ++d) {
#pragma unroll
                                for (int i = 0; i < 4; ++i) *(f32x4*)(sp + 32 * d + 8 * i + 4 * hi) = (f32x4){o[d][4 * i] * inv, o[d][4 * i + 1] * inv, o[d][4 * i + 2] * inv, o[d][4 * i + 3] * inv};
                                __builtin_amdgcn_sched_barrier(0); }
                        } else {
                            float ss = 0.f;
#pragma unroll
                            for (int d = 0; d < 4; ++d) {
#pragma unroll
                                for (int i = 0; i < 4; ++i) { const f32x4 a1 = *(const f32x4*)(sp + 32 * d + 8 * i + 4 * hi);
#pragma unroll
                                    for (int e = 0; e < 4; ++e) { const float dv = a1[e] - lam * (o[d][4 * i + e] * inv); o[d][4 * i + e] = dv; ss += dv * dv; } }
                                __builtin_amdgcn_sched_barrier(0); }
                            ss += __shfl_xor(ss, 32);
                            const float rn = osc / sqrtf(ss * (1.f / 128.f) + EPS);
                            bf16_t* op = Y + row * 1024 + h * 128;
#pragma unroll
                            for (int d = 0; d < 4; ++d) {
#pragma unroll
                                for (int i = 0; i < 4; ++i) { const f32x4 gg = *(const f32x4*)(sg + 32 * d + 8 * i + 4 * hi);
                                    u32x2 wv; wv.x = pk2(o[d][4 * i] * rn * gg[0], o[d][4 * i + 1] * rn * gg[1]); wv.y = pk2(o[d][4 * i + 2] * rn * gg[2], o[d][4 * i + 3] * rn * gg[3]);
                                    *(u32x2*)(op + 32 * d + 8 * i + 4 * hi) = wv; }
                                __builtin_amdgcn_sched_barrier(0); }
                        }
                    }
                }
            }
#endif
#ifndef NO_D
            for (int p = vcu; p < 512; p += G) {
                const int bh = p >> 4, s = p & 15, b = bh >> 3, h = bh & 7;
                for (int half = 0; half < 2; ++half) {
                    const int qb = half ? 31 - s : s;
                    const size_t row = (size_t)b * SEQ + 256 * qb + wave * 32 + r32;
                    f32x16 o[2]; float mr, lr;
                    attn_core<96, 64, 64, true, true, true, 1, false>(lds, QD + (size_t)b * SEQ * 768 + h * 96, 768, KVD + (size_t)b * SEQ * 1024 + h * 64, 1024, Z + (size_t)b * SEQ * 2304 + 2176, 2304,
                                                KVD + (size_t)b * SEQ * 1024 + 512 + h * 64, 1024, 256 * qb, 0, 4 * qb + 4, 1 << 30, o, mr, lr);
                    const float inv = 1.0f / lr;
                    bf16_t* op = Y + row * 1024 + 512 + h * 64;
#pragma unroll
                    for (int d = 0; d < 2; ++d)
#pragma unroll
                        for (int i = 0; i < 4; ++i) { u32x2 wv; wv.x = pk2(o[d][4 * i] * inv, o[d][4 * i + 1] * inv); wv.y = pk2(o[d][4 * i + 2] * inv, o[d][4 * i + 3] * inv);
                            *(u32x2*)(op + 32 * d + 8 * i + 4 * hi) = wv; }
                }
            }
#endif
        }
        if (ph == 19 && (PHMASK & 128)) {
            const float* fg = TOG(const float, args.in[30]);
            for (int m = gw; m < T; m += NGW) {
                float s = (lane < 16) ? SSQX[(size_t)m * 16 + lane] : 0.f;
                s = wave_sum(s);
                const float r = 1.0f / sqrtf(s * (1.f / D) + EPS);
                const u32x2* xr = (const u32x2*)(XB + (size_t)m * D) + lane; f32x4* orow = (f32x4*)(outp + (size_t)m * D) + lane; const f32x4* gr = (const f32x4*)fg + lane;
#pragma unroll
                for (int j = 0; j < 4; ++j) { const u32x2 w = xr[64 * j]; const f32x4 gg = gr[64 * j];
                    const f32x4 v = {bf2f(w.x & 0xffffu), bf2f(w.x >> 16), bf2f(w.y & 0xffffu), bf2f(w.y >> 16)}; orow[64 * j] = v * r * gg; }
            }
        }
        if (ph + 1 < args.ph_hi) {
            if (!posted) { grid.sync(); xbar = xcd_barrier_post(barw, bst); posted = true; }
            else xcd_barrier(xbar);
        }
        if (DUPMASK != 0) { if (((DUPMASK >> ph) & 1) && !rep) { rep = 1; --ph; } else rep = 0; }
    }
}

#ifndef MK_SPLIT
#define MK_SPLIT 0
#endif
extern "C" void kernel_launch(void* const* d_in, const int* in_sizes, int n_in, void* d_out, int out_size, void* d_ws, size_t ws_size, hipStream_t stream) {
    static int grid = 0;
    if (grid == 0) {
        if (n_in != 31 || ws_size < WS_END) { fprintf(stderr, "kernel_launch: unexpected n_in %d / ws %zu\n", n_in, ws_size); grid = -1; return; }
        int dev = 0, cus = 0, per_cu = 0;
        hipGetDevice(&dev);
        hipDeviceGetAttribute(&cus, hipDeviceAttributeMultiprocessorCount, dev);
        if (hipFuncSetAttribute((const void*)mk_fwd, hipFuncAttributeMaxDynamicSharedMemorySize, LDS_BYTES) != hipSuccess) { fprintf(stderr, "kernel_launch: hipFuncSetAttribute failed\n"); }
        if (hipOccupancyMaxActiveBlocksPerMultiprocessor(&per_cu, (const void*)mk_fwd, 512, LDS_BYTES) != hipSuccess || per_cu < 1) { fprintf(stderr, "kernel_launch: occupancy query gave %d\n", per_cu); per_cu = 1; }
        (void)hipGetLastError();
        grid = cus * per_cu;
        if (grid > 256) grid = 256;
        fprintf(stderr, "kernel_launch: grid %d (cus %d per_cu %d)\n", grid, cus, per_cu);
    }
    if (grid < 0) return;
    Args a{};
    for (int i = 0; i < 31; ++i) a.in[i] = d_in[i];
    a.out = (float*)d_out; a.ws = (unsigned char*)d_ws;
#if MK_SPLIT
    for (int ph = 0; ph < 20; ++ph) { a.ph_lo = ph; a.ph_hi = ph + 1; hipLaunchKernelGGL(mk_fwd, dim3(grid), dim3(512), LDS_BYTES, stream, a); }
#else
    a.ph_lo = 0; a.ph_hi = 20;
    void* kargs[] = {&a};
    hipError_t e = hipLaunchCooperativeKernel((const void*)mk_fwd, dim3(grid), dim3(512), kargs, LDS_BYTES, stream);
    if (e != hipSuccess) fprintf(stderr, "cooperative launch failed: %s (grid %d)\n", hipGetErrorString(e), grid);
#endif
}
```

```cpp
#include <hip/hip_runtime.h>
#include <hip/hip_cooperative_groups.h>
#include <cstdio>
#include <cstdint>
namespace cg = cooperative_groups;

#define LAS __attribute__((address_space(3)))
#define GAS __attribute__((address_space(1)))
#define TOG(T, p) ((T*)(GAS T*)(p))
typedef unsigned short bf16_t;
typedef short bf16x8 __attribute__((ext_vector_type(8)));
typedef short s16x4 __attribute__((ext_vector_type(4)));
typedef float f32x4 __attribute__((ext_vector_type(4)));
typedef float f32x16 __attribute__((ext_vector_type(16)));
typedef unsigned u32x4 __attribute__((ext_vector_type(4)));
typedef unsigned u32x2 __attribute__((ext_vector_type(2)));
typedef float f32x2_t __attribute__((ext_vector_type(2)));
typedef __bf16 bf16x2_t __attribute__((ext_vector_type(2)));

__device__ __forceinline__ unsigned pk2(float lo, float hi) { f32x2_t v = {lo, hi}; bf16x2_t b = __builtin_convertvector(v, bf16x2_t); return __builtin_bit_cast(unsigned, b); }
__device__ __forceinline__ float bf2f(unsigned h) { return __uint_as_float(h << 16); }

constexpr int NB = 4, SEQ = 8192, T = NB * SEQ, D = 1024;
constexpr float EPS = 1e-6f;
constexpr float LOG2E = 1.4426950408889634f;
constexpr float NEGBIG = -1e30f;

constexpr size_t MiB = 1u << 20;
constexpr size_t WS_W = 0, WS_XB = 56 * MiB, WS_BIG = 120 * MiB, WS_Y = 376 * MiB, WS_SMALL = 440 * MiB;
constexpr size_t WS_KVMEM = WS_SMALL, WS_MN = WS_SMALL + 4 * MiB, WS_SSQX = WS_SMALL + 8 * MiB, WS_SSQZ = WS_SMALL + 10 * MiB,
                 WS_ROPE = WS_SMALL + 20 * MiB, WS_LSE = WS_SMALL + 24 * MiB, WS_MISC = WS_SMALL + 28 * MiB, WS_END = WS_SMALL + 29 * MiB;
constexpr size_t M1 = 1048576;
constexpr size_t LW = 10 * M1, OW_Q = 0, OW_KV = M1 / 2, OW_O = M1 + M1 / 2, OW_1 = 2 * M1, OW_2 = 6 * M1;
constexpr size_t OW_ABIN = 20 * M1, OW_ABOUT = OW_ABIN + 2560 * 1024, OW_CDIN = OW_ABOUT + M1, OW_CDOUT = OW_CDIN + 2304 * 1024,
                 OW_UQ = OW_CDOUT + M1, OW_UKV = OW_UQ + 768 * 384, OW_END = OW_UKV + 1024 * 256;
static_assert(OW_END * 2 <= 56 * MiB, "weights");
constexpr size_t OB_Z = 0;
constexpr size_t OB_OA = 160 * MiB;
constexpr size_t OB_QD = 144 * MiB;
constexpr size_t OB_KVD = 192 * MiB;
constexpr size_t OB_H = 0;

constexpr int LDS_BYTES = 147456;
#ifndef PHMASK
#define PHMASK 0xFF
#endif
#ifndef DUPMASK
#define DUPMASK 0
#endif

namespace pg8 {
constexpr int BM = 256, BK = 64, HALF = 128, HTB = HALF * BK * 2, STAGE_BYTES = 8 * HTB, NXCD = 8, WGM = 8;
__host__ __device__ __forceinline__ int lds_byte(int r, int c) { const int st = (r >> 4) * 2 + (c >> 5), rr = r & 15, cc = c & 31, ob = rr * 64 + cc * 2; return st * 1024 + (ob ^ (((ob >> 9) & 1) << 5)); }
__host__ __device__ __forceinline__ void stage_rc(int b, int& R, int& C) { const int st = b / 1024, sb = b % 1024, swz = sb ^ (((sb >> 9) & 1) << 5); R = (st >> 1) * 16 + swz / 64; C = (st & 1) * 32 + (swz % 64) / 2; }
__host__ __device__ __forceinline__ int perm32(int rho) { const int n = rho >> 4, i = rho & 15; return 8 * (i >> 2) + 4 * n + (i & 3); }

struct Unit { int pm, pn; };
struct Gemm { const bf16_t* A; const bf16_t* Bt; int M, N, K, lda; };

struct StaticOrder {
    int nM, nN, nwg, G, c;
    __device__ void init(int M, int N, int G_, int c_) { nM = M / BM; nN = N / BM; nwg = nM * nN; G = G_; c = c_; }
    __device__ bool next(int i, Unit& u) const {
        const long L = (long)i * G + c; if (L >= nwg) return false;
        int wgid = (int)L; { const int q = nwg / NXCD, r = nwg % NXCD, xcd = wgid % NXCD, off = wgid / NXCD; wgid = (xcd < r ? xcd * (q + 1) : r * (q + 1) + (xcd - r) * q) + off; }
        const int nig = WGM * nN, gid = wgid / nig, fm = gid * WGM, gsz = (nM - fm) < WGM ? (nM - fm) : WGM;
        u.pm = fm + ((wgid % nig) % gsz); u.pn = (wgid % nig) / gsz; return true;
    }
};


struct EpiZ {
    static constexpr bool PERM = true;
    bf16_t* O; int ldc;
    const float* rs; int rs_stride, rs_off, rs_n4; float rs_inv;
    LAS float* rtab;
    int qs_end; float qscale;
    int act;
    int rope, rope_g;
    const float* rcos; const float* rsin;
    float* ssq; int ssq_stride;
    __device__ __forceinline__ void operator()(const f32x4 (&acc)[2][2][4][2], const Unit& u, int wr, int wc, int fr, int fq) const {
        const int row0 = u.pm * BM + wr * 64 + fr;
        if (rs) {
            int t_ = threadIdx.x; asm volatile("" : "+v"(t_));
            const int rr_ = t_ >> 1, hh_ = t_ & 1;
            f32x4 s = {0.f, 0.f, 0.f, 0.f}; const float* p = rs + (size_t)(u.pm * BM + rr_) * rs_stride + rs_off;
            for (int k = hh_; k < rs_n4; k += 2) s += *(const f32x4*)(p + 4 * k);
            float tot = (s.x + s.y) + (s.z + s.w); tot += __shfl_xor(tot, 1);
            if (hh_ == 0) rtab[rr_] = __builtin_amdgcn_rsqf(tot * rs_inv + EPS);
            asm volatile("s_waitcnt lgkmcnt(0)" ::: "memory"); __builtin_amdgcn_s_barrier(); asm volatile("" ::: "memory");
        }
#pragma unroll
        for (int ai = 0; ai < 2; ++ai)
#pragma unroll
            for (int m = 0; m < 4; ++m) {
                const int row = row0 + ai * HALF + m * 16;
                const float r = rs ? rtab[wr * 64 + fr + ai * HALF + m * 16] : 1.f;
#pragma unroll
                for (int bj = 0; bj < 2; ++bj) {
                    const int colg = u.pn * BM + bj * HALF + wc * 32, gidx = colg >> 5, col = colg + 8 * fq;
                    f32x4 v0 = acc[ai][bj][m][0] * r, v1 = acc[ai][bj][m][1] * r;
                    if (act == 1) {
#pragma unroll
                        for (int e = 0; e < 4; ++e) { float a = fmaxf(v0[e], 0.f), b = fmaxf(v1[e], 0.f); v0[e] = a * a; v1[e] = b * b; }
                    }
                    if (ssq) {
                        float ss = (v0[0] * v0[0] + v0[1] * v0[1]) + (v0[2] * v0[2] + v0[3] * v0[3]) + (v1[0] * v1[0] + v1[1] * v1[1]) + (v1[2] * v1[2] + v1[3] * v1[3]);
                        ss += __shfl_xor(ss, 16); ss += __shfl_xor(ss, 32);
                        if (fq == 0) ssq[(size_t)row * ssq_stride + gidx] = ss;
                    }
                    if (colg < qs_end) { v0 = v0 * qscale; v1 = v1 * qscale; }
                    const bool rg = (rope == 1) ? (gidx == rope_g) : ((rope == 2) ? (gidx % 3 == 2) : false);
                    if (rg) {
                        const int ci = 8 * (fq & 1);
                        const f32x4 c0 = *(const f32x4*)(rcos + (size_t)row * 16 + ci), c1 = *(const f32x4*)(rcos + (size_t)row * 16 + ci + 4);
                        const f32x4 s0 = *(const f32x4*)(rsin + (size_t)row * 16 + ci), s1 = *(const f32x4*)(rsin + (size_t)row * 16 + ci + 4);
                        const float sg = (fq < 2) ? -1.f : 1.f;
#pragma unroll
                        for (int e = 0; e < 4; ++e) {
                            const float p0 = __shfl_xor(v0[e], 32), p1 = __shfl_xor(v1[e], 32);
                            v0[e] = v0[e] * c0[e] + sg * p0 * s0[e];
                            v1[e] = v1[e] * c1[e] + sg * p1 * s1[e];
                        }
                    }
                    u32x4 w; w.x = pk2(v0[0], v0[1]); w.y = pk2(v0[2], v0[3]); w.z = pk2(v1[0], v1[1]); w.w = pk2(v1[2], v1[3]);
                    *(u32x4*)(O + (size_t)row * ldc + col) = w;
                }
                __builtin_amdgcn_sched_barrier(0);
            }
    }
};
struct EpiRes {
    static constexpr bool PERM = true;
    const float* base32; const bf16_t* base16; bf16_t* xb; float* ssq;
    __device__ __forceinline__ void operator()(const f32x4 (&acc)[2][2][4][2], const Unit& u, int wr, int wc, int fr, int fq) const {
        const int row0 = u.pm * BM + wr * 64 + fr;
#pragma unroll
        for (int ai = 0; ai < 2; ++ai)
#pragma unroll
            for (int m = 0; m < 4; ++m) {
                const int row = row0 + ai * HALF + m * 16; float ss = 0.f;
#pragma unroll
                for (int bj = 0; bj < 2; ++bj) {
                    const size_t off = (size_t)row * D + u.pn * BM + bj * HALF + wc * 32 + 8 * fq;
                    f32x4 b0, b1;
                    if (base32) { b0 = *(const f32x4*)(base32 + off); b1 = *(const f32x4*)(base32 + off + 4); }
                    else { const u32x4 bw = *(const u32x4*)(base16 + off);
                        b0 = (f32x4){bf2f(bw.x & 0xffffu), bf2f(bw.x >> 16), bf2f(bw.y & 0xffffu), bf2f(bw.y >> 16)};
                        b1 = (f32x4){bf2f(bw.z & 0xffffu), bf2f(bw.z >> 16), bf2f(bw.w & 0xffffu), bf2f(bw.w >> 16)}; }
                    const f32x4 v0 = b0 + acc[ai][bj][m][0], v1 = b1 + acc[ai][bj][m][1];
                    u32x4 w; w.x = pk2(v0[0], v0[1]); w.y = pk2(v0[2], v0[3]); w.z = pk2(v1[0], v1[1]); w.w = pk2(v1[2], v1[3]);
                    *(u32x4*)(xb + off) = w;
                    ss += ((v0[0] * v0[0] + v0[1] * v0[1]) + (v0[2] * v0[2] + v0[3] * v0[3])) + ((v1[0] * v1[0] + v1[1] * v1[1]) + (v1[2] * v1[2] + v1[3] * v1[3]));
                }
                ss += __shfl_xor(ss, 16); ss += __shfl_xor(ss, 32);
                if (fq == 0) ssq[(size_t)row * 16 + u.pn * 4 + wc] = ss;
            }
    }
};

template <class Epi>
__device__ __forceinline__ void gemm_phase(LAS unsigned char* lds, const Gemm g, const StaticOrder& S, const Epi& E) {
    int tid = threadIdx.x; asm volatile("" : "+v"(tid));
    const int wid = __builtin_amdgcn_readfirstlane(tid >> 6), lane = tid & 63, wr = wid >> 2, wc = wid & 3, fr = lane & 15, fq = lane >> 4;
    const int K = g.K, nt = K / BK, lda = g.lda;
    unsigned voffA[2], voffB[2];
#pragma unroll
    for (int i = 0; i < 2; ++i) { int R, C; stage_rc(tid * 16 + i * 8192, R, C); const int Rb = Epi::PERM ? ((R & ~31) + perm32(R & 31)) : R;
        voffA[i] = (unsigned)(R * lda + C) * 2u; voffB[i] = (unsigned)(Rb * K + C) * 2u; }
    const size_t kstep = (size_t)(BK * 2);
    const size_t hstepA = (size_t)HALF * lda * 2, hstepB = (size_t)HALF * K * 2;
    const size_t tstepA = 2 * hstepA, tstepB = 2 * hstepB;
    const unsigned ldsw = (unsigned)wid * 1024u;
    const int aoff = lds_byte(wr * 64 + fr, fq * 8), boff = lds_byte(wc * 32 + fr, fq * 8);
#define PG8_SA(b, h) (((b) * 2 + (h)) * HTB)
#define PG8_SB(b, h) ((4 + (b) * 2 + (h)) * HTB)
#define PG8_STAGE(bufoff, gbase, voff) do { _Pragma("unroll") for (int _i = 0; _i < 2; ++_i) \
        __builtin_amdgcn_global_load_lds((const unsigned*)((const char*)(gbase) + (voff)[_i]), (LAS unsigned*)(lds + (bufoff) + ldsw + _i * 8192), 16, 0, 0); } while (0)
#define PG8_LDA(dst, b, h) do { _Pragma("unroll") for (int m = 0; m < 4; ++m) _Pragma("unroll") for (int k = 0; k < 2; ++k) dst[m][k] = *(const LAS bf16x8*)(lds + PG8_SA(b, h) + aoff + m * 2048 + k * 1024); } while (0)
#define PG8_LDB(dst, b, h) do { _Pragma("unroll") for (int n = 0; n < 2; ++n) _Pragma("unroll") for (int k = 0; k < 2; ++k) dst[n][k] = *(const LAS bf16x8*)(lds + PG8_SB(b, h) + boff + n * 2048 + k * 1024); } while (0)
#define PG8_MMA(ai, bj, At, Bt) do { __builtin_amdgcn_s_setprio(1); _Pragma("unroll") for (int m = 0; m < 4; ++m) _Pragma("unroll") for (int n = 0; n < 2; ++n) _Pragma("unroll") for (int k = 0; k < 2; ++k) \
        acc[ai][bj][m][n] = __builtin_amdgcn_mfma_f32_16x16x32_bf16(Bt[n][k], At[m][k], acc[ai][bj][m][n], 0, 0, 0); __builtin_amdgcn_s_setprio(0); } while (0)
#define PG8_WAIT_V(n) asm volatile("s_waitcnt vmcnt(" #n ")" ::: "memory")
#define PG8_WAIT_L(n) asm volatile("s_waitcnt lgkmcnt(" #n ")" ::: "memory")
#define PG8_BAR __builtin_amdgcn_s_barrier()
#define PG8_SCHED __builtin_amdgcn_sched_barrier(0)
    Unit cur, nxt; int ui = 0;
    if (!S.next(0, cur)) return;
    f32x4 acc[2][2][4][2];
#pragma unroll
    for (int a = 0; a < 2; ++a)
#pragma unroll
        for (int b = 0; b < 2; ++b)
#pragma unroll
            for (int m = 0; m < 4; ++m)
#pragma unroll
                for (int n = 0; n < 2; ++n) acc[a][b][m][n] = (f32x4){0.f, 0.f, 0.f, 0.f};
    bf16x8 At[4][2], B0[2][2], B1[2][2];
    const char* cA = (const char*)g.A + (size_t)cur.pm * tstepA; const char* cB = (const char*)g.Bt + (size_t)cur.pn * tstepB;
    PG8_STAGE(PG8_SB(0, 0), cB, voffB); PG8_STAGE(PG8_SB(0, 1), cB + hstepB, voffB); PG8_STAGE(PG8_SA(0, 0), cA, voffA); PG8_STAGE(PG8_SA(0, 1), cA + hstepA, voffA);
    if (wr == 1) PG8_BAR;
    PG8_WAIT_V(2); PG8_BAR;
    PG8_STAGE(PG8_SB(1, 0), cB + kstep, voffB); PG8_STAGE(PG8_SA(1, 0), cA + kstep, voffA); PG8_STAGE(PG8_SB(1, 1), cB + hstepB + kstep, voffB);
    PG8_WAIT_V(6); PG8_BAR;
    for (;;) {
        const bool has_next = S.next(ui + 1, nxt);
        const char* nA = has_next ? (const char*)g.A + (size_t)nxt.pm * tstepA : cA; const char* nB = has_next ? (const char*)g.Bt + (size_t)nxt.pn * tstepB : cB;
        for (int t = 0; t < nt; t += 2) {
            const bool last = (t == nt - 2);
            const char* a1 = cA + (size_t)(t + 1) * kstep;
            const char* a2 = last ? nA : cA + (size_t)(t + 2) * kstep; const char* b2 = last ? nB : cB + (size_t)(t + 2) * kstep;
            const char* a3 = a2 + kstep; const char* b3 = b2 + kstep;
            PG8_LDB(B0, 0, 0); PG8_LDB(B1, 0, 1); PG8_SCHED; PG8_LDA(At, 0, 0); PG8_STAGE(PG8_SA(1, 1), a1 + hstepA, voffA);
            PG8_WAIT_V(8); PG8_WAIT_L(0); PG8_BAR; PG8_MMA(0, 0, At, B0); PG8_MMA(0, 1, At, B1); PG8_BAR; PG8_SCHED;
            PG8_LDA(At, 0, 1); PG8_STAGE(PG8_SB(0, 0), b2, voffB); PG8_STAGE(PG8_SB(0, 1), b2 + hstepB, voffB); PG8_STAGE(PG8_SA(0, 0), a2, voffA);
            PG8_WAIT_V(8); PG8_WAIT_L(0); PG8_BAR; PG8_MMA(1, 0, At, B0); PG8_MMA(1, 1, At, B1); PG8_BAR; PG8_SCHED;
            PG8_LDB(B0, 1, 0); PG8_LDB(B1, 1, 1); PG8_SCHED; PG8_LDA(At, 1, 0); PG8_STAGE(PG8_SA(0, 1), a2 + hstepA, voffA);
            PG8_WAIT_V(8); PG8_WAIT_L(0); PG8_BAR; PG8_MMA(0, 0, At, B0); PG8_MMA(0, 1, At, B1); PG8_BAR; PG8_SCHED;
            PG8_LDA(At, 1, 1); PG8_STAGE(PG8_SB(1, 0), b3, voffB); PG8_STAGE(PG8_SB(1, 1), b3 + hstepB, voffB); PG8_STAGE(PG8_SA(1, 0), a3, voffA);
            PG8_WAIT_V(8); PG8_WAIT_L(0); PG8_BAR; PG8_MMA(1, 0, At, B0); PG8_MMA(1, 1, At, B1); PG8_BAR; PG8_SCHED;
        }
        if (wr == 0) PG8_BAR;
        E(acc, cur, wr, wc, fr, fq);
        if (!has_next) break;
#pragma unroll
        for (int a = 0; a < 2; ++a)
#pragma unroll
            for (int b = 0; b < 2; ++b)
#pragma unroll
                for (int m = 0; m < 4; ++m)
#pragma unroll
                    for (int n = 0; n < 2; ++n) acc[a][b][m][n] = (f32x4){0.f, 0.f, 0.f, 0.f};
        cur = nxt; cA = nA; cB = nB; ++ui;
        if (wr == 1) PG8_BAR;
    }
    PG8_WAIT_V(0);
    PG8_BAR;
#undef PG8_SA
#undef PG8_SB
#undef PG8_STAGE
#undef PG8_LDA
#undef PG8_LDB
#undef PG8_MMA
#undef PG8_WAIT_V
#undef PG8_WAIT_L
#undef PG8_BAR
#undef PG8_SCHED
}
}

template <int VS, int D> __device__ __forceinline__ void tr_block(unsigned a, s16x4 (&l)[4], s16x4 (&h)[4]) {
    asm volatile("ds_read_b64_tr_b16 %0, %1 offset:%2" : "=v"(l[0]) : "v"(a), "i"(0 * VS + D * 64) : "memory");
    asm volatile("ds_read_b64_tr_b16 %0, %1 offset:%2" : "=v"(h[0]) : "v"(a), "i"(4 * VS + D * 64) : "memory");
    asm volatile("ds_read_b64_tr_b16 %0, %1 offset:%2" : "=v"(l[1]) : "v"(a), "i"(16 * VS + D * 64) : "memory");
    asm volatile("ds_read_b64_tr_b16 %0, %1 offset:%2" : "=v"(h[1]) : "v"(a), "i"(20 * VS + D * 64) : "memory");
    asm volatile("ds_read_b64_tr_b16 %0, %1 offset:%2" : "=v"(l[2]) : "v"(a), "i"(32 * VS + D * 64) : "memory");
    asm volatile("ds_read_b64_tr_b16 %0, %1 offset:%2" : "=v"(h[2]) : "v"(a), "i"(36 * VS + D * 64) : "memory");
    asm volatile("ds_read_b64_tr_b16 %0, %1 offset:%2" : "=v"(l[3]) : "v"(a), "i"(48 * VS + D * 64) : "memory");
    asm volatile("ds_read_b64_tr_b16 %0, %1 offset:%2" : "=v"(h[3]) : "v"(a), "i"(52 * VS + D * 64) : "memory");
}
#define TR_WAIT8(l, h) asm volatile("s_waitcnt lgkmcnt(8)" : "+v"(l[0]), "+v"(l[1]), "+v"(l[2]), "+v"(l[3]), "+v"(h[0]), "+v"(h[1]), "+v"(h[2]), "+v"(h[3]) :: "memory")
#define TR_WAIT0(l, h) asm volatile("s_waitcnt lgkmcnt(0)" : "+v"(l[0]), "+v"(l[1]), "+v"(l[2]), "+v"(l[3]), "+v"(h[0]), "+v"(h[1]), "+v"(h[2]), "+v"(h[3]) :: "memory")
#define PV4(d, l, h) do { _Pragma("unroll") for (int cc = 0; cc < 4; ++cc) { \
        const bf16x8 vf = (bf16x8){l[cc][0], l[cc][1], l[cc][2], l[cc][3], h[cc][0], h[cc][1], h[cc][2], h[cc][3]}; \
        o[d] = __builtin_amdgcn_mfma_f32_32x32x16_bf16(vf, __builtin_bit_cast(bf16x8, pw[cc]), o[d], 0, 0, 0); } } while (0)

__device__ __forceinline__ float fadd_s(float a, float b) { float r; asm("v_add_f32_e32 %0, %1, %2" : "=v"(r) : "v"(a), "v"(b)); return r; }
template <int DK, int DK1, int DV, bool MASK, bool NEGM = true, bool PF2 = false, int VAH = 1, bool SHIFT = false>
__device__ __forceinline__ void attn_core(LAS unsigned char* lds,
        const bf16_t* Qp, long ldq, const bf16_t* K1p, long ldk1, const bf16_t* K2p, long ldk2, const bf16_t* Vp, long ldv,
        int q0, int kt0, int kt1, int W, f32x16 (&o)[DV / 32], float& m_out, float& l_out) {
    constexpr int KS = DK * 2 + 16, VS = DV * 2 + 64, KBUF = 64 * KS, VBUF = 64 * VS;
    constexpr int KCH1 = DK1 / 8, NKC1 = 64 * KCH1, KPT1 = (NKC1 + 511) / 512, KCH2 = (DK - DK1) / 8, NKC2 = 64 * KCH2, KPT2 = (NKC2 + 511) / 512, KPT = KPT1 + KPT2;
    constexpr int VCH = DV / 8, NVC = 64 * VCH, VPT = (NVC + 511) / 512;
    static_assert(3 * KBUF + 3 * VBUF <= 131072, "attn lds");
    int tid = threadIdx.x; asm volatile("" : "+v"(tid));
    const int lane = tid & 63, wid = __builtin_amdgcn_readfirstlane(tid >> 6), r32 = lane & 31, hi = lane >> 5;
    LAS unsigned char* kbuf = lds; LAS unsigned char* vbuf = lds + 3 * KBUF;
    const int qlo = q0 + wid * 32, qrow = qlo + r32;
    bf16x8 qf[DK / 16];
#pragma unroll
    for (int c = 0; c < DK / 16; ++c) qf[c] = *(const bf16x8*)(Qp + (long)qrow * ldq + 16 * c + 8 * hi);
#pragma unroll
    for (int d = 0; d < DV / 32; ++d) o[d] = f32x16{};
    float mrun = 0.f, lrun = 0.f;
    u32x4 kreg0[KPT], vreg0[VPT], kreg1[KPT], vreg1[VPT];
#pragma unroll
    for (int i = 0; i < KPT; ++i) { kreg0[i] = (u32x4){0u, 0u, 0u, 0u}; kreg1[i] = kreg0[i]; }
#pragma unroll
    for (int i = 0; i < VPT; ++i) { vreg0[i] = (u32x4){0u, 0u, 0u, 0u}; vreg1[i] = vreg0[i]; }
    unsigned kgo[KPT], vgo[VPT]; int klo_[KPT], vlo_[VPT];
#pragma unroll
    for (int i = 0; i < KPT1; ++i) { const int e = (tid + 512 * i) % NKC1, row = e / KCH1, ch = e % KCH1; kgo[i] = (unsigned)(row * (int)ldk1 + ch * 8) * 2u; klo_[i] = row * KS + ch * 16; }
#pragma unroll
    for (int i = 0; i < KPT2; ++i) { const int e = (tid + 512 * i) % (NKC2 ? NKC2 : 1), row = e / (KCH2 ? KCH2 : 1), ch = e % (KCH2 ? KCH2 : 1); kgo[KPT1 + i] = (unsigned)(row * (int)ldk2 + ch * 8) * 2u; klo_[KPT1 + i] = row * KS + (KCH1 + ch) * 16; }
#pragma unroll
    for (int i = 0; i < VPT; ++i) { const int e = (tid + 512 * i) % NVC, row = e / VCH, ch = e % VCH; vgo[i] = (unsigned)(row * (int)ldv + ch * 8) * 2u; vlo_[i] = row * VS + ch * 16; }
#define ATT_LOAD(t, kreg, vreg) do { \
    const char* k1t_ = (const char*)(K1p + 64L * (t) * ldk1); const char* k2t_ = (const char*)(K2p + 64L * (t) * ldk2); const char* vt_ = (const char*)(Vp + 64L * (t) * ldv); \
    _Pragma("unroll") for (int i_ = 0; i_ < KPT1; ++i_) { kreg[i_] = *(const u32x4*)(k1t_ + (size_t)kgo[i_]); } \
    _Pragma("unroll") for (int i_ = 0; i_ < KPT2; ++i_) { kreg[KPT1 + i_] = *(const u32x4*)(k2t_ + (size_t)kgo[KPT1 + i_]); } \
    _Pragma("unroll") for (int i_ = 0; i_ < VPT; ++i_) { vreg[i_] = *(const u32x4*)(vt_ + (size_t)vgo[i_]); } } while (0)
#define ATT_STORE(b) do { \
    _Pragma("unroll") for (int i_ = 0; i_ < KPT1; ++i_) { if ((NKC1 % 512 == 0) || tid + 512 * i_ < NKC1) *(LAS u32x4*)(kbuf + (b) * KBUF + klo_[i_]) = kreg[i_]; } \
    _Pragma("unroll") for (int i_ = 0; i_ < KPT2; ++i_) { if ((NKC2 % 512 == 0) || tid + 512 * i_ < NKC2) *(LAS u32x4*)(kbuf + (b) * KBUF + klo_[KPT1 + i_]) = kreg[KPT1 + i_]; } \
    _Pragma("unroll") for (int i_ = 0; i_ < VPT; ++i_) { if ((NVC % 512 == 0) || tid + 512 * i_ < NVC) *(LAS u32x4*)(vbuf + (b) * VBUF + vlo_[i_]) = vreg[i_]; } } while (0)
#define ATT_STOREKV(kb_, vb_, kreg, vreg) do { \
    _Pragma("unroll") for (int i_ = 0; i_ < KPT1; ++i_) { if ((NKC1 % 512 == 0) || tid + 512 * i_ < NKC1) *(LAS u32x4*)(kbuf + (kb_) * KBUF + klo_[i_]) = kreg[i_]; } \
    _Pragma("unroll") for (int i_ = 0; i_ < KPT2; ++i_) { if ((NKC2 % 512 == 0) || tid + 512 * i_ < NKC2) *(LAS u32x4*)(kbuf + (kb_) * KBUF + klo_[KPT1 + i_]) = kreg[KPT1 + i_]; } \
    _Pragma("unroll") for (int i_ = 0; i_ < VPT; ++i_) { if ((NVC % 512 == 0) || tid + 512 * i_ < NVC) *(LAS u32x4*)(vbuf + (vb_) * VBUF + vlo_[i_]) = vreg[i_]; } } while (0)
    ATT_LOAD(kt0, kreg0, vreg0); ATT_STOREKV(0, 0, kreg0, vreg0);
    if (PF2) ATT_LOAD((kt0 + 1 < kt1 ? kt0 + 1 : kt1 - 1), kreg1, vreg1);
    __syncthreads();
    const int pr = (r32 & 0x13) | ((r32 & 8) >> 1) | ((r32 & 4) << 1);
    const int koff = pr * KS + hi * 16;
    const int voff = (8 * hi + ((lane & 15) >> 2)) * VS + (16 * ((lane >> 4) & 1) + 4 * (lane & 3)) * 2;
    int ta = kt0, tb = kt1;
    if (MASK) { int lo = (qlo - W) >> 6; if (qlo - W < 0) lo = 0; if (lo > ta) ta = lo; const int hi_t = ((qlo + 31) >> 6) + 1; if (hi_t < tb) tb = hi_t; }
    constexpr int NQ = 2 * (DK / 16), NPV = 4 * (DV / 32), VA = (36 + NQ - 1) / NQ, VC = 32 / NPV;
    f32x16 negm = f32x16{};
    f32x16 sA0 = f32x16{}, sA1 = f32x16{};
    u32x4 pw[4];
#pragma unroll
    for (int i = 0; i < 4; ++i) pw[i] = (u32x4){0u, 0u, 0u, 0u};
    s16x4 va_l[4], va_h[4], vb_l[4], vb_h[4];
#pragma unroll
    for (int i = 0; i < 4; ++i) { va_l[i] = (s16x4){0, 0, 0, 0}; va_h[i] = va_l[i]; vb_l[i] = va_l[i]; vb_h[i] = va_l[i]; }
    bool has_pend = false, started = false;
    int kb_cur = 0, vb_cur = 0, vb_prev = 0;
#define ATT_X1(t, S0, S1) do { if (doqk_) { \
                if (NEGM) { S0 = negm; S1 = negm; } else { S0 = f32x16{}; S1 = f32x16{}; } \
                const LAS unsigned char* kb = kbuf + kb_cur * KBUF + koff; \
                bf16x8 ka0 = *(const LAS bf16x8*)(kb), ka1 = *(const LAS bf16x8*)(kb + 32 * KS); \
                __builtin_amdgcn_s_setprio(1); \
                _Pragma("unroll") for (int c = 0; c < DK / 16; ++c) { \
                    bf16x8 kn0 = ka0, kn1 = ka1; \
                    if (c + 1 < DK / 16) { kn0 = *(const LAS bf16x8*)(kb + (c + 1) * 32); kn1 = *(const LAS bf16x8*)(kb + 32 * KS + (c + 1) * 32); } \
                    S0 = __builtin_amdgcn_mfma_f32_32x32x16_bf16(ka0, qf[c], S0, 0, 0, 0); \
                    S1 = __builtin_amdgcn_mfma_f32_32x32x16_bf16(ka1, qf[c], S1, 0, 0, 0); \
                    __builtin_amdgcn_sched_barrier(0); \
                    ka0 = kn0; ka1 = kn1; } \
                __builtin_amdgcn_s_setprio(0); \
                if (!NEGM) { _Pragma("unroll") for (int r = 0; r < 16; ++r) { S0[r] -= mrun; S1[r] -= mrun; } } \
            } } while (0)
#define ATT_X2(P0, P1) do { if (dopv_) { \
                float rs0_ = P0[0], rs1_ = P1[0], rs2_ = P0[1], rs3_ = P1[1]; \
                _Pragma("unroll") for (int r = 2; r < 16; r += 2) { rs0_ = fadd_s(rs0_, P0[r]); rs1_ = fadd_s(rs1_, P1[r]); rs2_ = fadd_s(rs2_, P0[r + 1]); rs3_ = fadd_s(rs3_, P1[r + 1]); } \
                lrun += (rs0_ + rs1_) + (rs2_ + rs3_); \
                u32x4 w; \
                w.x = pk2(P0[0], P0[1]); w.y = pk2(P0[2], P0[3]); w.z = pk2(P0[4], P0[5]); w.w = pk2(P0[6], P0[7]); pw[0] = w; \
                w.x = pk2(P0[8], P0[9]); w.y = pk2(P0[10], P0[11]); w.z = pk2(P0[12], P0[13]); w.w = pk2(P0[14], P0[15]); pw[1] = w; \
                w.x = pk2(P1[0], P1[1]); w.y = pk2(P1[2], P1[3]); w.z = pk2(P1[4], P1[5]); w.w = pk2(P1[6], P1[7]); pw[2] = w; \
                w.x = pk2(P1[8], P1[9]); w.y = pk2(P1[10], P1[11]); w.z = pk2(P1[12], P1[13]); w.w = pk2(P1[14], P1[15]); pw[3] = w; \
            } } while (0)
#define ATT_X3(t, S0, S1) do { if (doqk_) { \
                const int klo = 64 * (t); \
                if (MASK && ((klo + 63 > qlo) || (klo < qlo + 31 - W))) { \
                    const int rel = qrow - klo - 8 * hi, rel2 = rel - W; \
                    _Pragma("unroll") for (int r = 0; r < 16; ++r) { const int i = r >> 2, j = r & 3; const int c0 = 16 * (i >> 1) + 4 * (i & 1) + j, c1 = c0 + 32; \
                        S0[r] = (c0 <= rel && c0 >= rel2) ? S0[r] : NEGBIG; S1[r] = (c1 <= rel && c1 >= rel2) ? S1[r] : NEGBIG; } \
                } \
                float rm = fmaxf(fmaxf(S0[0], S1[0]), S0[1]); \
                _Pragma("unroll") for (int r = 1; r < 15; r += 2) { rm = fmaxf(fmaxf(rm, S1[r]), S0[r + 1]); rm = fmaxf(fmaxf(rm, S1[r + 1]), S0[r + 2 > 15 ? 15 : r + 2]); } \
                rm = fmaxf(rm, S1[15]); \
                { auto rr_ = __builtin_amdgcn_permlane32_swap(__float_as_uint(rm), __float_as_uint(rm), false, false); rm = fmaxf(__uint_as_float(rr_[0]), __uint_as_float(rr_[1])); } \
                const float dl = started ? ((rm > 8.f) ? rm : 0.f) : rm; \
                if (__builtin_amdgcn_ballot_w64(dl != 0.f) != 0ull) { \
                    mrun += dl; \
                    _Pragma("unroll") for (int r = 0; r < 16; ++r) { S0[r] -= dl; S1[r] -= dl; } \
                    if (NEGM) { _Pragma("unroll") for (int r = 0; r < 16; ++r) negm[r] = -mrun; } \
                    if (started) { fsc_ = __builtin_amdgcn_exp2f(-dl); lrun *= fsc_; resc_ = true; } \
                } \
            } } while (0)
#define ATT_X4() do { if (dopv_) { \
                const unsigned va_ = (unsigned)(size_t)(vbuf + vb_prev * VBUF + voff); \
                __builtin_amdgcn_s_setprio(1); \
                tr_block<VS, 0>(va_, va_l, va_h); \
                tr_block<VS, 1>(va_, vb_l, vb_h); \
                if (DV == 64) { TR_WAIT8(va_l, va_h); PV4(0, va_l, va_h); TR_WAIT0(vb_l, vb_h); PV4(1, vb_l, vb_h); } \
                else { TR_WAIT8(va_l, va_h); PV4(0, va_l, va_h); \
                    tr_block<VS, 2>(va_, va_l, va_h); TR_WAIT8(vb_l, vb_h); PV4(1, vb_l, vb_h); \
                    tr_block<VS, 3>(va_, vb_l, vb_h); TR_WAIT8(va_l, va_h); PV4(DV == 64 ? 0 : 2, va_l, va_h); \
                    TR_WAIT0(vb_l, vb_h); PV4(DV == 64 ? 1 : 3, vb_l, vb_h); } \
                __builtin_amdgcn_s_setprio(0); \
            } } while (0)
#define ATT_X5(S0, S1) do { if (doqk_) { \
                _Pragma("unroll") for (int r = 0; r < 16; ++r) { S0[r] = __builtin_amdgcn_exp2f(S0[r]); S1[r] = __builtin_amdgcn_exp2f(S1[r]); } \
            } } while (0)
#define ATT_STEP(t, KL, VL, KST, VST) do { \
        const bool more_ = ((t) + 1 < kt1); \
        { const int tl_ = (t) + (PF2 ? 2 : 1); ATT_LOAD((tl_ < kt1 ? tl_ : kt1 - 1), KL, VL); }     \
        __builtin_amdgcn_sched_barrier(0);     \
        const bool doqk_ = ((t) >= ta) && ((t) < tb); \
        const bool dopv_ = has_pend; \
        float fsc_ = 1.f; bool resc_ = false; \
        ATT_X2(sA0, sA1); ATT_X4(); \
        const int sl_n_ = (kb_cur == 2) ? 0 : kb_cur + 1; \
        if (grp2) { asm volatile("s_waitcnt lgkmcnt(0)" ::: "memory"); __builtin_amdgcn_s_barrier(); asm volatile("" ::: "memory"); } \
        ATT_X1(t, sA0, sA1); ATT_X3(t, sA0, sA1); ATT_X5(sA0, sA1); \
        if (resc_) { \
            _Pragma("unroll") for (int d = 0; d < DV / 32; ++d) _Pragma("unroll") for (int r = 0; r < 16; ++r) o[d][r] *= fsc_; \
        } \
        has_pend = doqk_; started = started || doqk_; \
        __builtin_amdgcn_sched_barrier(0); \
        ATT_STOREKV(sl_n_, sl_n_, KST, VST); \
        vb_prev = kb_cur; kb_cur = sl_n_; \
        if (!grp2) { asm volatile("s_waitcnt lgkmcnt(0)" ::: "memory"); __builtin_amdgcn_s_barrier(); asm volatile("" ::: "memory"); } \
    } while (0)
    const bool grp2 = SHIFT && (wid >= 4);
    for (int t = kt0; t <= kt1; t += 2) {
        if (PF2) { ATT_STEP(t, kreg0, vreg0, kreg1, vreg1); if (t + 1 <= kt1) ATT_STEP(t + 1, kreg1, vreg1, kreg0, vreg0); }
        else { ATT_STEP(t, kreg0, vreg0, kreg0, vreg0); if (t + 1 <= kt1) ATT_STEP(t + 1, kreg0, vreg0, kreg0, vreg0); }
    }
#undef ATT_STEP
#undef ATT_X1
#undef ATT_X2
#undef ATT_X3
#undef ATT_X4
#undef ATT_X5
#undef ATT_STOREKV
#undef ATT_LOAD
#undef ATT_STORE
    lrun += __shfl_xor(lrun, 32);
    m_out = mrun; l_out = lrun;
}

#define XB_TMO      128
#define XB_XCNT(j)  (256  + 64 * (j))
#define XB_XSUB(j)  (1280 + 64 * (j))
#define XB_XGEN(j)  (2304 + 64 * (j))
#define XB_TOP      3328
#define XB_TOPGEN   3392
#define XCD_BAR_WORDS 3456
#define XB_SPIN_CAP (1u << 20)
__device__ __forceinline__ unsigned xb_ld(unsigned* p)              { return __hip_atomic_load(p, __ATOMIC_RELAXED, __HIP_MEMORY_SCOPE_AGENT); }
__device__ __forceinline__ unsigned xb_add(unsigned* p, unsigned v) { return __hip_atomic_fetch_add(p, v, __ATOMIC_RELAXED, __HIP_MEMORY_SCOPE_AGENT); }
__device__ __forceinline__ unsigned xb_xcc_id() { return (unsigned)__builtin_amdgcn_s_getreg((3 << 11) | 20) & 0xFu; }
#define XB_SPIN(cond, bar) do { unsigned _sp = 0; while (cond) { __builtin_amdgcn_s_sleep(1); \
    if ((++_sp & 255u) == 0u) { if (xb_ld(&(bar)[XB_TMO])) break; if (_sp > XB_SPIN_CAP) { atomicAdd(&(bar)[XB_TMO], 1u); break; } } } } while (0)
struct XcdBarrier { unsigned* bar; unsigned x; volatile LAS unsigned* st; };
__device__ __forceinline__ XcdBarrier xcd_barrier_post(unsigned* bar, volatile LAS unsigned* st) {
    XcdBarrier b; b.bar = bar; b.x = xb_xcc_id(); b.st = st;
    if (threadIdx.x == 0) (void)xb_add(&bar[XB_XCNT(b.x)], 1u);
    return b;
}
__device__ __forceinline__ void xcd_barrier_complete(unsigned* bar, unsigned x, unsigned& nloc, unsigned& nx) {
    const unsigned G = gridDim.x * gridDim.y * gridDim.z;
    unsigned sum, cnt, mine, sp = 0u;
    for (;;) {
        sum = 0u; cnt = 0u; mine = 0u;
#pragma unroll
        for (unsigned j = 0; j < 16; ++j) { const unsigned c = xb_ld(&bar[XB_XCNT(j)]); sum += c; cnt += (c > 0u) ? 1u : 0u; mine = (j == x) ? c : mine; }
        if (sum == G) break;
        __builtin_amdgcn_s_sleep(1);
        if ((++sp & 255u) == 0u) { if (xb_ld(&bar[XB_TMO])) break; if (sp > XB_SPIN_CAP) { atomicAdd(&bar[XB_TMO], 1u); break; } }
    }
    nloc = mine > 0u ? mine : 1u; nx = cnt > 0u ? cnt : 1u;
}
__device__ __forceinline__ void xcd_barrier(const XcdBarrier& b) {
    asm volatile("s_waitcnt vmcnt(0)" ::: "memory");
    __syncthreads();
    if (threadIdx.x == 0) {
        unsigned* bar = b.bar;
        __builtin_amdgcn_s_waitcnt(0);
        unsigned nloc = b.st[0], nx = b.st[1];
        if (nloc == 0u) { xcd_barrier_complete(bar, b.x, nloc, nx); b.st[0] = nloc; b.st[1] = nx; }
        const unsigned old = xb_add(&bar[XB_XSUB(b.x)], 1u);
        const unsigned gen = old / nloc;
        if (old + 1u == (gen + 1u) * nloc) {
            __builtin_amdgcn_fence(__ATOMIC_RELEASE, "agent");
            asm volatile("s_waitcnt vmcnt(0)" ::: "memory");
            const unsigned og = xb_add(&bar[XB_TOP], 1u);
            const unsigned tg = og / nx;
            if (og + 1u == (tg + 1u) * nx) xb_add(&bar[XB_TOPGEN], 1u);
            else XB_SPIN(xb_ld(&bar[XB_TOPGEN]) == tg, bar);
            __builtin_amdgcn_fence(__ATOMIC_ACQUIRE, "agent");
            xb_add(&bar[XB_XGEN(b.x)], 1u);
            asm volatile("s_waitcnt vmcnt(0)" ::: "memory");
        } else {
            XB_SPIN(xb_ld(&bar[XB_XGEN(b.x)]) == gen, bar);
            __builtin_amdgcn_fence(__ATOMIC_ACQUIRE, "agent");
            asm volatile("s_waitcnt vmcnt(0)" ::: "memory");
        }
    }
    __syncthreads();
}

struct Args { const void* in[31]; float* out; unsigned char* ws; int ph_lo, ph_hi; };

__device__ __forceinline__ float wave_sum(float v) {
#pragma unroll
    for (int o = 1; o < 64; o <<= 1) v += __shfl_xor(v, o);
    return v;
}

__device__ __forceinline__ void transpose_items(const float* W, int K, int N, const float* gain, bf16_t* WT, int ldt, int row_off, LAS float* scr, int gw, int NGW, int lane) {
    const int nblk = N / 32, nitems = (K / 64) * nblk;
    for (int item = gw; item < nitems; item += NGW) {
        const int kb = item / nblk, nb = item % nblk, k0 = 64 * kb, n0 = 32 * nb;
        float tmp[32];
#pragma unroll
        for (int i = 0; i < 32; ++i) { const int kk = 2 * i + (lane >> 5); tmp[i] = W[(size_t)(k0 + kk) * N + n0 + (lane & 31)]; }
#pragma unroll
        for (int i = 0; i < 32; ++i) { const int kk = 2 * i + (lane >> 5); scr[kk * 33 + (lane & 31)] = tmp[i]; }
        asm volatile("s_waitcnt lgkmcnt(0)" ::: "memory");
        const int c = lane & 7;
        f32x4 g0 = {1.f, 1.f, 1.f, 1.f}, g1 = g0;
        if (gain) { g0 = *(const f32x4*)(gain + k0 + 8 * c); g1 = *(const f32x4*)(gain + k0 + 8 * c + 4); }
#pragma unroll
        for (int j = 0; j < 4; ++j) { const int n = (lane >> 3) + 8 * j; const LAS float* sp = scr + (8 * c) * 33 + n;
            u32x4 o; o.x = pk2(sp[0 * 33] * g0.x, sp[1 * 33] * g0.y); o.y = pk2(sp[2 * 33] * g0.z, sp[3 * 33] * g0.w); o.z = pk2(sp[4 * 33] * g1.x, sp[5 * 33] * g1.y); o.w = pk2(sp[6 * 33] * g1.z, sp[7 * 33] * g1.w);
            *(u32x4*)(WT + (size_t)(row_off + n0 + n) * ldt + k0 + 8 * c) = o; }
        asm volatile("s_waitcnt lgkmcnt(0)" ::: "memory");
    }
}

__global__ void __launch_bounds__(512) mk_fwd(Args args) {
    extern __shared__ __attribute__((aligned(16))) unsigned char lds_raw[];
    LAS unsigned char* lds = (LAS unsigned char*)lds_raw;
    cg::grid_group grid = cg::this_grid();
    volatile LAS unsigned* bst = (volatile LAS unsigned*)(lds + 131072 + 256);
    unsigned* barw = (unsigned*)(GAS unsigned*)(args.ws + WS_MISC + 65536);
    if (threadIdx.x < 2) bst[threadIdx.x] = 0u;
    if (blockIdx.x == 0) { for (int i = threadIdx.x; i < XCD_BAR_WORDS; i += 512) barw[i] = 0u; }
    __syncthreads();
    XcdBarrier xbar; xbar.bar = barw; xbar.x = 0; xbar.st = bst;
    bool posted = false;
    int rep = 0;
    for (int ph = args.ph_lo; ph < args.ph_hi; ++ph) {
    int tid = threadIdx.x; asm volatile("" : "+v"(tid));
    const int lane = tid & 63, wave = __builtin_amdgcn_readfirstlane(tid >> 6);
    const int G = gridDim.x, bid = blockIdx.x;
    const int gw = bid * 8 + wave, NGW = G * 8;
    const int vcu = (G % 8 == 0) ? (bid % 8) * (G / 8) + bid / 8 : bid;
    unsigned long long wsi_ = (unsigned long long)args.ws; asm volatile("" : "+s"(wsi_));
    unsigned char* ws = (unsigned char*)(GAS unsigned char*)wsi_;
    const float* x_in = TOG(const float, args.in[0]);
    float* outp = TOG(float, args.out);
    bf16_t* Wt = (bf16_t*)(ws + WS_W);
    bf16_t* XB = (bf16_t*)(ws + WS_XB);
    float* O1S = outp;
    (void)0;
    unsigned char* BIG = ws + WS_BIG;
    bf16_t* Z = (bf16_t*)(BIG + OB_Z);
    bf16_t* OA = (bf16_t*)(BIG + OB_OA);
    bf16_t* QD = (bf16_t*)(BIG + OB_QD);
    bf16_t* KVD = (bf16_t*)(BIG + OB_KVD);
    bf16_t* Hb = (bf16_t*)(BIG + OB_H);
    bf16_t* Y = (bf16_t*)(ws + WS_Y);
    bf16_t* QX = (bf16_t*)(ws + WS_Y);
    bf16_t* OX = (bf16_t*)(ws + WS_Y + 32 * MiB);
    bf16_t* KVMEM = (bf16_t*)(ws + WS_KVMEM);
    bf16_t* MN = (bf16_t*)(ws + WS_MN);
    float* SSQX = (float*)(ws + WS_SSQX);
    float* SSQZ = (float*)(ws + WS_SSQZ);
    float* RCOS = (float*)(ws + WS_ROPE);
    float* RSIN = RCOS + (size_t)T * 16;
    float* LSE = (float*)(ws + WS_LSE);
    float* MISC = (float*)(ws + WS_MISC);

        const int layer = (ph >= 14) ? 1 : 0;
        if (ph == 0 && (PHMASK & 1)) {
            LAS float* scr = (LAS float*)(lds + wave * 16384);
            const float* g_mix = TOG(const float, args.in[3]); const float* g_cross = TOG(const float, args.in[4]); const float* g_mlp = TOG(const float, args.in[9]);
            for (int l = 0; l < 2; ++l) {
                bf16_t* wl = Wt + l * LW;
                transpose_items(TOG(const float, args.in[6]) + (size_t)l * 1024 * 512, 1024, 512, g_cross + l * 1024, wl + OW_Q, 1024, 0, scr, gw, NGW, lane);
                transpose_items(TOG(const float, args.in[7]) + (size_t)l * 1024 * 1024, 1024, 1024, nullptr, wl + OW_KV, 1024, 0, scr, gw, NGW, lane);
                transpose_items(TOG(const float, args.in[8]) + (size_t)l * 512 * 1024, 512, 1024, nullptr, wl + OW_O, 512, 0, scr, gw, NGW, lane);
                transpose_items(TOG(const float, args.in[10]) + (size_t)l * 1024 * 4096, 1024, 4096, g_mlp + l * 1024, wl + OW_1, 1024, 0, scr, gw, NGW, lane);
                transpose_items(TOG(const float, args.in[11]) + (size_t)l * 4096 * 1024, 4096, 1024, nullptr, wl + OW_2, 4096, 0, scr, gw, NGW, lane);
            }
            transpose_items(TOG(const float, args.in[12]), 1024, 2560, g_mix, Wt + OW_ABIN, 1024, 0, scr, gw, NGW, lane);
            transpose_items(TOG(const float, args.in[13]), 1024, 1024, nullptr, Wt + OW_ABOUT, 1024, 0, scr, gw, NGW, lane);
            transpose_items(TOG(const float, args.in[18]), 1024, 2208, g_mix + 1024, Wt + OW_CDIN, 1024, 0, scr, gw, NGW, lane);
            transpose_items(TOG(const float, args.in[19]), 1024, 1024, nullptr, Wt + OW_CDOUT, 1024, 0, scr, gw, NGW, lane);
            transpose_items(TOG(const float, args.in[27]), 384, 768, TOG(const float, args.in[25]), Wt + OW_UQ, 384, 0, scr, gw, NGW, lane);
            transpose_items(TOG(const float, args.in[28]), 256, 512, TOG(const float, args.in[26]), Wt + OW_UKV, 256, 0, scr, gw, NGW, lane);
            transpose_items(TOG(const float, args.in[29]), 256, 512, TOG(const float, args.in[26]), Wt + OW_UKV, 256, 512, scr, gw, NGW, lane);
            { u32x4* zp = (u32x4*)(Wt + OW_CDIN + (size_t)2208 * 1024); const int n16 = 96 * 1024 * 2 / 16;
              for (int i = bid * 512 + tid; i < n16; i += G * 512) zp[i] = (u32x4){0u, 0u, 0u, 0u}; }
            for (int m = gw; m < T; m += NGW) {
                const f32x4* xr = (const f32x4*)(x_in + (size_t)m * D) + lane; float s = 0.f;
                unsigned long long* o8 = (unsigned long long*)(XB + (size_t)m * D) + lane;
#pragma unroll
                for (int j = 0; j < 4; ++j) { const f32x4 v = xr[64 * j]; s += (v.x * v.x + v.y * v.y) + (v.z * v.z + v.w * v.w);
                    o8[64 * j] = (unsigned long long)pk2(v.x, v.y) | ((unsigned long long)pk2(v.z, v.w) << 32); }
                s = wave_sum(s);
                if (lane < 16) SSQX[(size_t)m * 16 + lane] = (lane == 0) ? s : 0.f;
            }
            for (int mm = gw; mm < 2 * 1024; mm += NGW) {
                const int l = mm >> 10, m = mm & 1023;
                const f32x4* xr = (const f32x4*)(TOG(const float, args.in[1]) + (size_t)m * D) + lane; const f32x4* gr = (const f32x4*)(TOG(const float, args.in[5]) + l * D) + lane;
                f32x4 v[4]; float s = 0.f;
#pragma unroll
                for (int j = 0; j < 4; ++j) { v[j] = xr[64 * j]; s += (v[j].x * v[j].x + v[j].y * v[j].y) + (v[j].z * v[j].z + v[j].w * v[j].w); }
                const float r = 1.0f / sqrtf(wave_sum(s) * (1.f / D) + EPS);
                unsigned long long* o8 = (unsigned long long*)(MN + ((size_t)l * 1024 + m) * D) + lane;
#pragma unroll
                for (int j = 0; j < 4; ++j) { const f32x4 gg = gr[64 * j]; o8[64 * j] = (unsigned long long)pk2(v[j].x * r * gg.x, v[j].y * r * gg.y) | ((unsigned long long)pk2(v[j].z * r * gg.z, v[j].w * r * gg.w) << 32); }
            }
            for (int i = bid * 512 + tid; i < T * 16; i += G * 512) {
                const int row = i >> 4, fi = i & 15;
                const float invf = __builtin_amdgcn_exp2f(-(float)fi * 0.83048202372184058696f);
                const double rev = (double)(TOG(const int, args.in[2]))[row] * (double)invf * 0.15915494309189533577;
                const float fr = (float)(rev - rint(rev));
                RCOS[i] = __builtin_amdgcn_cosf(fr); RSIN[i] = __builtin_amdgcn_sinf(fr);
            }
            if (bid == 0 && wave == 0) {
                const float a = (TOG(const float, args.in[20]))[lane] * (TOG(const float, args.in[21]))[lane], b2 = (TOG(const float, args.in[22]))[lane] * (TOG(const float, args.in[23]))[lane];
                const float sa = wave_sum(a), sb = wave_sum(b2);
                if (lane == 0) MISC[0] = __expf(sa) - __expf(sb) + 0.35550906759097f;
            }
        }
        if ((PHMASK & 2) && (ph == 1 || ph == 5 || ph == 8 || ph == 10 || ph == 11 || ph == 14 || ph == 17)) {
            const int njobs = (ph == 1 || ph == 10 || ph == 11) ? 2 : 1;
            for (int j = 0; j < njobs; ++j) {
                pg8::Gemm g; pg8::EpiZ E;
                E.rs = SSQX; E.rs_stride = 16; E.rs_off = 0; E.rs_n4 = 4; E.rs_inv = 1.f / 1024.f; E.qs_end = 0; E.qscale = 1.f; E.act = 0; E.rope = 0; E.rope_g = -1;
                E.rcos = RCOS; E.rsin = RSIN; E.ssq = nullptr; E.ssq_stride = 0; E.rtab = (LAS float*)(lds + 131072 + 1024);
                int rot = 0;
                if (ph == 1 && j == 0) { g = pg8::Gemm{XB, Wt + OW_ABIN, T, 2560, 1024, 1024}; E.O = Z; E.ldc = 2560; E.qs_end = 512; E.qscale = 0.125f * LOG2E; }
                else if (ph == 1 || (ph == 10 && j == 1)) { const int l = (ph == 1) ? 0 : 1; g = pg8::Gemm{MN + (size_t)l * 1024 * 1024, Wt + l * LW + OW_KV, 1024, 1024, 1024, 1024}; E.O = KVMEM + (size_t)l * 1024 * 1024; E.ldc = 1024; E.rs = nullptr; rot = (ph == 1) ? 0 : 128; }
                else if (ph == 5 || ph == 14) { g = pg8::Gemm{XB, Wt + layer * LW + OW_Q, T, 512, 1024, 1024}; E.O = QX; E.ldc = 512; E.qs_end = 512; E.qscale = 0.08838834764831845f * LOG2E; }
                else if (ph == 8 || ph == 17) { g = pg8::Gemm{XB, Wt + layer * LW + OW_1, T, 4096, 1024, 1024}; E.O = Hb; E.ldc = 4096; E.act = 1; }
                else if (ph == 10) { g = pg8::Gemm{XB, Wt + OW_CDIN, T, 2304, 1024, 1024}; E.O = Z; E.ldc = 2304; E.qs_end = 512; E.qscale = 0.125f * LOG2E; E.rope = 1; E.rope_g = 68; E.ssq = SSQZ; E.ssq_stride = 72; }
                else if (ph == 11 && j == 0) { g = pg8::Gemm{Z + 1536, Wt + OW_UQ, T, 768, 384, 2304}; E.O = QD; E.ldc = 768; E.rs = SSQZ; E.rs_stride = 72; E.rs_off = 48; E.rs_n4 = 3; E.rs_inv = 1.f / 384.f;
                    E.qs_end = 768; E.qscale = 0.10206207261596577f * LOG2E; E.rope = 2; }
                else { g = pg8::Gemm{Z + 1920, Wt + OW_UKV, T, 1024, 256, 2304}; E.O = KVD; E.ldc = 1024; E.rs = SSQZ; E.rs_stride = 72; E.rs_off = 60; E.rs_n4 = 2; E.rs_inv = 1.f / 256.f; rot = 128; }
                pg8::StaticOrder S; S.init(g.M, g.N, G, (bid + rot) % G);
                pg8::gemm_phase<pg8::EpiZ>(lds, g, S, E);
            }
        }
        if ((PHMASK & 4) && (ph == 4 || ph == 7 || ph == 9 || ph == 13 || ph == 16 || ph == 18)) {
            pg8::Gemm g; pg8::EpiRes E; E.base32 = nullptr; E.base16 = XB; E.xb = XB; E.ssq = SSQX;
            if (ph == 4) { g = pg8::Gemm{Y, Wt + OW_ABOUT, T, 1024, 1024, 1024}; E.base32 = x_in; }
            else if (ph == 13) { g = pg8::Gemm{Y, Wt + OW_CDOUT, T, 1024, 1024, 1024}; }
            else if (ph == 7 || ph == 16) { g = pg8::Gemm{OX, Wt + layer * LW + OW_O, T, 1024, 512, 512}; }
            else { g = pg8::Gemm{Hb, Wt + layer * LW + OW_2, T, 1024, 4096, 4096}; }
            pg8::StaticOrder S; S.init(g.M, g.N, G, bid);
            pg8::gemm_phase<pg8::EpiRes>(lds, g, S, E);
        }
        if (ph == 2 && (PHMASK & 8)) {
            const int r32 = lane & 31, hi = lane >> 5;
            for (int u = vcu; u < 3072; u += G) {
                const int gp = u >> 10, v = u & 1023, bh = v >> 5, w = v & 31, b = bh >> 3, h = bh & 7;
                const int dil = (gp == 0) ? 1 : (gp == 1) ? 4 : 16, nu = 32 / dil, res = w / nu, n = w % nu;
                const bf16_t* base = Z + ((size_t)b * SEQ + res) * 2560 + h * 64;
                const long ld = 2560L * dil;
                f32x16 o[2]; float mr, lr;
                attn_core<64, 64, 64, true, true, true, 1, false>(lds, base, ld, base + 512, ld, base + 512, ld, base + 1024, ld, 256 * n, (4 * n - 2 < 0) ? 0 : 4 * n - 2, 4 * n + 4, 128, o, mr, lr);
                const float inv = 1.0f / lr;
                const int qrow = 256 * n + wave * 32 + r32;
                const size_t tok = (size_t)b * SEQ + res + (size_t)qrow * dil;
                bf16_t* op = OA + (size_t)gp * T * 512 + tok * 512 + h * 64;
#pragma unroll
                for (int d = 0; d < 2; ++d)
#pragma unroll
                    for (int i = 0; i < 4; ++i) { u32x2 wv; wv.x = pk2(o[d][4 * i] * inv, o[d][4 * i + 1] * inv); wv.y = pk2(o[d][4 * i + 2] * inv, o[d][4 * i + 3] * inv);
                        *(u32x2*)(op + 32 * d + 8 * i + 4 * hi) = wv; }
                if (hi == 0) LSE[(size_t)gp * T * 8 + tok * 8 + h] = mr + __builtin_amdgcn_logf(lr);
            }
            const float* cw = TOG(const float, args.in[14]); const float* cb = TOG(const float, args.in[15]); const float* lg = TOG(const float, args.in[16]); const float* lb = TOG(const float, args.in[17]);
            LAS float* gl = (LAS float*)lds;
            for (int cu = bid; cu < T / 32; cu += G) {
                const int t0 = cu * 32, bstart = (t0 / SEQ) * SEQ;
                for (int e = tid; e < 62 * 64; e += 512) {
                    const int row = e >> 6, ch = e & 63, tk = t0 - 30 + row;
                    f32x4 g0 = {0.f, 0.f, 0.f, 0.f}, g1 = g0;
                    if (tk >= bstart) {
                        const u32x4 uu = *(const u32x4*)(Z + (size_t)tk * 2560 + 1536 + ch * 8), gg = *(const u32x4*)(Z + (size_t)tk * 2560 + 2048 + ch * 8);
#pragma unroll
                        for (int q = 0; q < 4; ++q) {
                            const float u0 = bf2f(uu[q] & 0xffffu), u1 = bf2f(uu[q] >> 16), a0 = bf2f(gg[q] & 0xffffu), a1 = bf2f(gg[q] >> 16);
                            const float r0 = u0 * __builtin_amdgcn_rcpf(1.f + __expf(-a0)), r1 = u1 * __builtin_amdgcn_rcpf(1.f + __expf(-a1));
                            if (q < 2) { g0[2 * q] = r0; g0[2 * q + 1] = r1; } else { g1[2 * (q - 2)] = r0; g1[2 * (q - 2) + 1] = r1; }
                        }
                    }
                    *(LAS f32x4*)(gl + row * 512 + ch * 8) = g0; *(LAS f32x4*)(gl + row * 512 + ch * 8 + 4) = g1;
                }
                __syncthreads();
                {
                    float wv[31];
#pragma unroll
                    for (int j = 0; j < 31; ++j) wv[j] = cw[j * 512 + tid];
                    const float bias = cb[tid];
                    float res[32];
#pragma unroll
                    for (int blk = 0; blk < 4; ++blk) {
                        float in[38];
#pragma unroll
                        for (int j = 0; j < 38; ++j) in[j] = gl[(blk * 8 + j) * 512 + tid];
#pragma unroll
                        for (int i = 0; i < 8; ++i) { float a = bias;
#pragma unroll
                            for (int j = 0; j < 31; ++j) a += wv[j] * in[i + j];
                            res[blk * 8 + i] = a; }
                        __builtin_amdgcn_sched_barrier(0);
                    }
#pragma unroll
                    for (int i = 0; i < 32; ++i) gl[i * 512 + tid] = res[i];
                }
                __syncthreads();
#pragma unroll
                for (int k = 0; k < 4; ++k) {
                    const int tr = wave * 4 + k;
                    const f32x4 a = *(LAS f32x4*)(gl + tr * 512 + lane * 8), c = *(LAS f32x4*)(gl + tr * 512 + lane * 8 + 4);
                    const float mu = wave_sum((a.x + a.y) + (a.z + a.w) + (c.x + c.y) + (c.z + c.w)) * (1.f / 512.f);
                    const f32x4 da = a - mu, dc = c - mu;
                    const float var = wave_sum((da.x * da.x + da.y * da.y) + (da.z * da.z + da.w * da.w) + (dc.x * dc.x + dc.y * dc.y) + (dc.z * dc.z + dc.w * dc.w)) * (1.f / 512.f);
                    const float rstd = 1.0f / sqrtf(var + EPS);
                    const f32x4 ga = *(const f32x4*)(lg + lane * 8), gc = *(const f32x4*)(lg + lane * 8 + 4), ba = *(const f32x4*)(lb + lane * 8), bc = *(const f32x4*)(lb + lane * 8 + 4);
                    f32x4 ya = da * rstd * ga + ba, yc = dc * rstd * gc + bc;
#pragma unroll
                    for (int e = 0; e < 4; ++e) { ya[e] = ya[e] * __builtin_amdgcn_rcpf(1.f + __expf(-ya[e])); yc[e] = yc[e] * __builtin_amdgcn_rcpf(1.f + __expf(-yc[e])); }
                    u32x4 wv; wv.x = pk2(ya[0], ya[1]); wv.y = pk2(ya[2], ya[3]); wv.z = pk2(yc[0], yc[1]); wv.w = pk2(yc[2], yc[3]);
                    *(u32x4*)(Y + (size_t)(t0 + tr) * 1024 + 512 + lane * 8) = wv;
                }
                __syncthreads();
            }
        }
        if (ph == 3 && (PHMASK & 16)) {
            for (size_t i = (size_t)bid * 512 + tid; i < (size_t)T * 64; i += (size_t)G * 512) {
                const size_t tok = i >> 6; const int ch = (int)(i & 63), h = ch >> 3;
                const float l0 = LSE[tok * 8 + h], l1 = LSE[(size_t)T * 8 + tok * 8 + h], l2 = LSE[(size_t)2 * T * 8 + tok * 8 + h];
                const float mx = fmaxf(l0, fmaxf(l1, l2));
                float w0 = __builtin_amdgcn_exp2f(l0 - mx), w1 = __builtin_amdgcn_exp2f(l1 - mx), w2 = __builtin_amdgcn_exp2f(l2 - mx);
                const float inv = 1.0f / (w0 + w1 + w2); w0 *= inv; w1 *= inv; w2 *= inv;
                const u32x4 a = *(const u32x4*)(OA + tok * 512 + ch * 8), b = *(const u32x4*)(OA + (size_t)T * 512 + tok * 512 + ch * 8), c = *(const u32x4*)(OA + (size_t)2 * T * 512 + tok * 512 + ch * 8);
                u32x4 r;
#pragma unroll
                for (int q = 0; q < 4; ++q) {
                    const float lo = w0 * bf2f(a[q] & 0xffffu) + w1 * bf2f(b[q] & 0xffffu) + w2 * bf2f(c[q] & 0xffffu);
                    const float hh = w0 * bf2f(a[q] >> 16) + w1 * bf2f(b[q] >> 16) + w2 * bf2f(c[q] >> 16);
                    r[q] = pk2(lo, hh);
                }
                *(u32x4*)(Y + tok * 1024 + ch * 8) = r;
            }
        }
        if ((PHMASK & 32) && (ph == 6 || ph == 15)) {
            const int r32 = lane & 31, hi = lane >> 5;
            const bf16_t* KVl = KVMEM + (size_t)layer * 1024 * 1024;
            for (int u = vcu; u < 512; u += G) {
                const int bh = u >> 5, qb = u & 31, b = bh >> 2, h = bh & 3;
                const bf16_t* qp = QX + (size_t)b * SEQ * 512 + h * 128;
                const bf16_t* kp = KVl + (size_t)b * 256 * 1024 + h * 128;
                f32x16 o[4]; float mr, lr;
                attn_core<128, 128, 128, false, false, false, 1, false>(lds, qp, 512, kp, 1024, kp, 1024, kp + 512, 1024, 256 * qb, 0, 4, 1 << 30, o, mr, lr);
                const float inv = 1.0f / lr;
                bf16_t* op = OX + ((size_t)b * SEQ + 256 * qb + wave * 32 + r32) * 512 + h * 128;
#pragma unroll
                for (int d = 0; d < 4; ++d)
#pragma unroll
                    for (int i = 0; i < 4; ++i) { u32x2 wv; wv.x = pk2(o[d][4 * i] * inv, o[d][4 * i + 1] * inv); wv.y = pk2(o[d][4 * i + 2] * inv, o[d][4 * i + 3] * inv);
                        *(u32x2*)(op + 32 * d + 8 * i + 4 * hi) = wv; }
            }
        }
        if (ph == 12 && (PHMASK & 64)) {
            const int r32 = lane & 31, hi = lane >> 5;
            const float lam = MISC[0], osc = 0.64449093240903f;
            const float* sg = TOG(const float, args.in[24]);
#ifndef NO_C
            for (int p = vcu; p < 256; p += G) {
                const int bh = p >> 4, s = p & 15, b = bh >> 2, h = bh & 3;
                for (int half = 0; half < 2; ++half) {
                    const int qb = half ? 31 - s : s;
                    const size_t row = (size_t)b * SEQ + 256 * qb + wave * 32 + r32;
                    for (int mp = 0; mp < 2; ++mp) {
                        const bf16_t* zb = Z + (size_t)b * SEQ * 2304 + h * 128;
                        f32x16 o[4]; float mr, lr;
                        attn_core<64, 64, 128, true, false, true, 1, false>(lds, zb + mp * 64, 2304, zb + 512 + mp * 64, 2304, zb, 2304, zb + 1024, 2304, 256 * qb, 0, 4 * qb + 4, 1 << 30, o, mr, lr);
                        const float inv = 1.0f / lr;
                        float* sp = O1S + row * 512 + h * 128;
                        if (mp == 0) {
#pragma unroll
                            for (int d = 0; d < 4; ++d) {
#pragma unroll
                                for (int i = 0; i < 4; ++i) *(f32x4*)(sp + 32 * d + 8 * i + 4 * hi) = (f32x4){o[d][4 * i] * inv, o[d][4 * i + 1] * inv, o[d][4 * i + 2] * inv, o[d][4 * i + 3] * inv};
                                __builtin_amdgcn_sched_barrier(0); }
                        } else {
                            float ss = 0.f;
#pragma unroll
                            for (int d = 0; d < 4; ++d) {
#pragma unroll
                                for (int i = 0; i < 4; ++i) { const f32x4 a1 = *(const f32x4*)(sp + 32 * d + 8 * i + 4 * hi);
#pragma unroll
                                    for (int e = 0; e < 4; ++e) { const float dv = a1[e] - lam * (o[d][4 * i + e] * inv); o[d][4 * i + e] = dv; ss += dv * dv; } }
                                __builtin_amdgcn_sched_barrier(0); }
                            ss += __shfl_xor(ss, 32);
                            const float rn = osc / sqrtf(ss * (1.f / 128.f) + EPS);
                            bf16_t* op = Y + row * 1024 + h * 128;
#pragma unroll
                            for (int d = 0; d < 4; ++d) {
#pragma unroll
                                for (int i = 0; i < 4; ++i) { const f32x4 gg = *(const f32x4*)(sg + 32 * d + 8 * i + 4 * hi);
                                    u32x2 wv; wv.x = pk2(o[d][4 * i] * rn * gg[0], o[d][4 * i + 1] * rn * gg[1]); wv.y = pk2(o[d][4 * i + 2] * rn * gg[2], o[d][4 * i + 3] * rn * gg[3]);
                                    *(u32x2*)(op + 32 * d + 8 * i + 4 * hi) = wv; }
                                __builtin_amdgcn_sched_barrier(0); }
                        }
                    }
                }
            }
#endif
#ifndef NO_D
            for (int p = vcu; p < 512; p += G) {
                const int bh = p >> 4, s = p & 15, b = bh >> 3, h = bh & 7;
                for (int half = 0; half < 2; ++half) {
                    const int qb = half ? 31 - s : s;
                    const size_t row = (size_t)b * SEQ + 256 * qb + wave * 32 + r32;
                    f32x16 o[2]; float mr, lr;
                    attn_core<96, 64, 64, true, true, true, 1, false>(lds, QD + (size_t)b * SEQ * 768 + h * 96, 768, KVD + (size_t)b * SEQ * 1024 + h * 64, 1024, Z + (size_t)b * SEQ * 2304 + 2176, 2304,
                                                KVD + (size_t)b * SEQ * 1024 + 512 + h * 64, 1024, 256 * qb, 0, 4 * qb + 4, 1 << 30, o, mr, lr);
                    const float inv = 1.0f / lr;
                    bf16_t* op = Y + row * 1024 + 512 + h * 64;
#pragma unroll
                    for (int d = 0; d < 2; ++d)
#pragma unroll
                        for (int i = 0; i < 4; ++i) { u32x2 wv; wv.x = pk2(o[d][4 * i] * inv, o[d][4 * i + 1] * inv); wv.y = pk2(o[d][4 * i + 2] * inv, o[d][4 * i + 3] * inv);
                            *(u32x2*)(op + 32 * d + 8 * i + 4 * hi) = wv; }
                }
            }
#endif
        }
        if (ph == 19 && (PHMASK & 128)) {
            const float* fg = TOG(const float, args.in[30]);
            for (int m = gw; m < T; m += NGW) {
                float s = (lane < 16) ? SSQX[(size_t)m * 16 + lane] : 0.f;
                s = wave_sum(s);
                const float r = 1.0f / sqrtf(s * (1.f / D) + EPS);
                const u32x2* xr = (const u32x2*)(XB + (size_t)m * D) + lane; f32x4* orow = (f32x4*)(outp + (size_t)m * D) + lane; const f32x4* gr = (const f32x4*)fg + lane;
#pragma unroll
                for (int j = 0; j < 4; ++j) { const u32x2 w = xr[64 * j]; const f32x4 gg = gr[64 * j];
                    const f32x4 v = {bf2f(w.x & 0xffffu), bf2f(w.x >> 16), bf2f(w.y & 0xffffu), bf2f(w.y >> 16)}; orow[64 * j] = v * r * gg; }
            }
        }
        if (ph + 1 < args.ph_hi) {
            if (!posted) { grid.sync(); xbar = xcd_barrier_post(barw, bst); posted = true; }
            else xcd_barrier(xbar);
        }
        if (DUPMASK != 0) { if (((DUPMASK >> ph) & 1) && !rep) { rep = 1; --ph; } else rep = 0; }
    }
}

#ifndef MK_SPLIT
#define MK_SPLIT 0
#endif
extern "C" void kernel_launch(void* const* d_in, const int* in_sizes, int n_in, void* d_out, int out_size, void* d_ws, size_t ws_size, hipStream_t stream) {
    static int grid = 0;
    if (grid == 0) {
        if (n_in != 31 || ws_size < WS_END) { fprintf(stderr, "kernel_launch: unexpected n_in %d / ws %zu\n", n_in, ws_size); grid = -1; return; }
        int dev = 0, cus = 0, per_cu = 0;
        hipGetDevice(&dev);
        hipDeviceGetAttribute(&cus, hipDeviceAttributeMultiprocessorCount, dev);
        if (hipFuncSetAttribute((const void*)mk_fwd, hipFuncAttributeMaxDynamicSharedMemorySize, LDS_BYTES) != hipSuccess) { fprintf(stderr, "kernel_launch: hipFuncSetAttribute failed\n"); }
        if (hipOccupancyMaxActiveBlocksPerMultiprocessor(&per_cu, (const void*)mk_fwd, 512, LDS_BYTES) != hipSuccess || per_cu < 1) { fprintf(stderr, "kernel_launch: occupancy query gave %d\n", per_cu); per_cu = 1; }
        (void)hipGetLastError();
        grid = cus * per_cu;
        if (grid > 256) grid = 256;
        fprintf(stderr, "kernel_launch: grid %d (cus %d per_cu %d)\n", grid, cus, per_cu);
    }
    if (grid < 0) return;
    Args a{};
    for (int i = 0; i < 31; ++i) a.in[i] = d_in[i];
    a.out = (float*)d_out; a.ws = (unsigned char*)d_ws;
#if MK_SPLIT
    for (int ph = 0; ph < 20; ++ph) { a.ph_lo = ph; a.ph_hi = ph + 1; hipLaunchKernelGGL(mk_fwd, dim3(grid), dim3(512), LDS_BYTES, stream, a); }
#else
    a.ph_lo = 0; a.ph_hi = 20;
    void* kargs[] = {&a};
    hipError_t e = hipLaunchCooperativeKernel((const void*)mk_fwd, dim3(grid), dim3(512), kargs, LDS_BYTES, stream);
    if (e != hipSuccess) fprintf(stderr, "cooperative launch failed: %s (grid %d)\n", hipGetErrorString(e), grid);
#endif
}
```

```cpp
#include <hip/hip_runtime.h>
#include <hip/hip_cooperative_groups.h>
#include <cstdio>
#include <cstdint>
namespace cg = cooperative_groups;

#define LAS __attribute__((address_space(3)))
#define GAS __attribute__((address_space(1)))
#define TOG(T, p) ((T*)(GAS T*)(p))
typedef unsigned short bf16_t;
typedef short bf16x8 __attribute__((ext_vector_type(8)));
typedef short s16x4 __attribute__((ext_vector_type(4)));
typedef float f32x4 __attribute__((ext_vector_type(4)));
typedef float f32x16 __attribute__((ext_vector_type(16)));
typedef unsigned u32x4 __attribute__((ext_vector_type(4)));
typedef unsigned u32x2 __attribute__((ext_vector_type(2)));
typedef float f32x2_t __attribute__((ext_vector_type(2)));
typedef __bf16 bf16x2_t __attribute__((ext_vector_type(2)));

__device__ __forceinline__ unsigned pk2(float lo, float hi) { f32x2_t v = {lo, hi}; bf16x2_t b = __builtin_convertvector(v, bf16x2_t); return __builtin_bit_cast(unsigned, b); }
__device__ __forceinline__ float bf2f(unsigned h) { return __uint_as_float(h << 16); }

__device__ __forceinline__ float xsum16_32(float v) {
    { auto r = __builtin_amdgcn_permlane16_swap(__float_as_uint(v), __float_as_uint(v), false, false); v = __uint_as_float(r[0]) + __uint_as_float(r[1]); }
    { auto r = __builtin_amdgcn_permlane32_swap(__float_as_uint(v), __float_as_uint(v), false, false); v = __uint_as_float(r[0]) + __uint_as_float(r[1]); }
    return v;
}

constexpr int NB = 4, SEQ = 8192, T = NB * SEQ, D = 1024;
constexpr float EPS = 1e-6f;
constexpr float LOG2E = 1.4426950408889634f;
constexpr float NEGBIG = -1e30f;

constexpr size_t MiB = 1u << 20;
constexpr size_t WS_W = 0, WS_XB = 56 * MiB, WS_BIG = 120 * MiB, WS_Y = 376 * MiB, WS_SMALL = 440 * MiB;
constexpr size_t WS_KVMEM = WS_SMALL, WS_MN = WS_SMALL + 4 * MiB, WS_SSQX = WS_SMALL + 8 * MiB, WS_SSQZ = WS_SMALL + 10 * MiB,
                 WS_ROPE = WS_SMALL + 20 * MiB, WS_LSE = WS_SMALL + 24 * MiB, WS_MISC = WS_SMALL + 28 * MiB, WS_END = WS_SMALL + 29 * MiB;
constexpr size_t M1 = 1048576;
constexpr size_t LW = 10 * M1, OW_Q = 0, OW_KV = M1 / 2, OW_O = M1 + M1 / 2, OW_1 = 2 * M1, OW_2 = 6 * M1;
constexpr size_t OW_ABIN = 20 * M1, OW_ABOUT = OW_ABIN + 2560 * 1024, OW_CDIN = OW_ABOUT + M1, OW_CDOUT = OW_CDIN + 2304 * 1024,
                 OW_UQ = OW_CDOUT + M1, OW_UKV = OW_UQ + 768 * 384, OW_END = OW_UKV + 1024 * 256;
static_assert(OW_END * 2 <= 56 * MiB, "weights");
constexpr size_t OB_Z = 0;
constexpr size_t OB_OA = 160 * MiB;
constexpr size_t OB_QD = 144 * MiB;
constexpr size_t OB_KVD = 192 * MiB;
constexpr size_t OB_H = 0;

constexpr int LDS_BYTES = 147456;
#ifndef PHMASK
#define PHMASK 0xFF
#endif
#ifndef DUPMASK
#define DUPMASK 0
#endif

namespace pg8 {
constexpr int BM = 256, BK = 64, HALF = 128, HTB = HALF * BK * 2, STAGE_BYTES = 8 * HTB, NXCD = 8, WGM = 8;
__host__ __device__ __forceinline__ int lds_byte(int r, int c) { const int st = (r >> 4) * 2 + (c >> 5), rr = r & 15, cc = c & 31, ob = rr * 64 + cc * 2; return st * 1024 + (ob ^ (((ob >> 9) & 1) << 5)); }
__host__ __device__ __forceinline__ void stage_rc(int b, int& R, int& C) { const int st = b / 1024, sb = b % 1024, swz = sb ^ (((sb >> 9) & 1) << 5); R = (st >> 1) * 16 + swz / 64; C = (st & 1) * 32 + (swz % 64) / 2; }
__host__ __device__ __forceinline__ int perm32(int rho) { const int n = rho >> 4, i = rho & 15; return 8 * (i >> 2) + 4 * n + (i & 3); }

struct Unit { int pm, pn; };
struct Gemm { const bf16_t* A; const bf16_t* Bt; int M, N, K, lda; };

struct StaticOrder {
    int nM, nN, nwg, G, c;
    __device__ void init(int M, int N, int G_, int c_) { nM = M / BM; nN = N / BM; nwg = nM * nN; G = G_; c = c_; }
    __device__ bool next(int i, Unit& u) const {
        const long L = (long)i * G + c; if (L >= nwg) return false;
        int wgid = (int)L; { const int q = nwg / NXCD, r = nwg % NXCD, xcd = wgid % NXCD, off = wgid / NXCD; wgid = (xcd < r ? xcd * (q + 1) : r * (q + 1) + (xcd - r) * q) + off; }
        const int nig = WGM * nN, gid = wgid / nig, fm = gid * WGM, gsz = (nM - fm) < WGM ? (nM - fm) : WGM;
        u.pm = fm + ((wgid % nig) % gsz); u.pn = (wgid % nig) / gsz; return true;
    }
};


struct EpiZ {
    static constexpr bool PERM = true;
    bf16_t* O; int ldc;
    const float* rs; int rs_stride, rs_off, rs_n4; float rs_inv;
    LAS float* rtab;
    int qs_end; float qscale;
    int act;
    int rope, rope_g;
    const float* rcos; const float* rsin;
    float* ssq; int ssq_stride;
    __device__ __forceinline__ void operator()(const f32x4 (&acc)[2][2][4][2], const Unit& u, int wr, int wc, int fr, int fq) const {
        const int row0 = u.pm * BM + wr * 64 + fr;
        if (rs) {
            int t_ = threadIdx.x; asm volatile("" : "+v"(t_));
            const int rr_ = t_ >> 1, hh_ = t_ & 1;
            f32x4 s = {0.f, 0.f, 0.f, 0.f}; const float* p = rs + (size_t)(u.pm * BM + rr_) * rs_stride + rs_off;
            for (int k = hh_; k < rs_n4; k += 2) s += *(const f32x4*)(p + 4 * k);
            float tot = (s.x + s.y) + (s.z + s.w); tot += __shfl_xor(tot, 1);
            if (hh_ == 0) rtab[rr_] = __builtin_amdgcn_rsqf(tot * rs_inv + EPS);
            asm volatile("s_waitcnt lgkmcnt(0)" ::: "memory"); __builtin_amdgcn_s_barrier(); asm volatile("" ::: "memory");
        }
#pragma unroll
        for (int ai = 0; ai < 2; ++ai)
#pragma unroll
            for (int m = 0; m < 4; ++m) {
                const int row = row0 + ai * HALF + m * 16;
                const float r = rs ? rtab[wr * 64 + fr + ai * HALF + m * 16] : 1.f;
#pragma unroll
                for (int bj = 0; bj < 2; ++bj) {
                    const int colg = u.pn * BM + bj * HALF + wc * 32, gidx = colg >> 5, col = colg + 8 * fq;
                    f32x4 v0 = acc[ai][bj][m][0] * r, v1 = acc[ai][bj][m][1] * r;
                    if (act == 1) {
#pragma unroll
                        for (int e = 0; e < 4; ++e) { float a = fmaxf(v0[e], 0.f), b = fmaxf(v1[e], 0.f); v0[e] = a * a; v1[e] = b * b; }
                    }
                    if (ssq) {
                        float ss = (v0[0] * v0[0] + v0[1] * v0[1]) + (v0[2] * v0[2] + v0[3] * v0[3]) + (v1[0] * v1[0] + v1[1] * v1[1]) + (v1[2] * v1[2] + v1[3] * v1[3]);
                        ss = xsum16_32(ss);
                        if (fq == 0) ssq[(size_t)row * ssq_stride + gidx] = ss;
                    }
                    if (colg < qs_end) { v0 = v0 * qscale; v1 = v1 * qscale; }
                    const bool rg = (rope == 1) ? (gidx == rope_g) : ((rope == 2) ? (gidx % 3 == 2) : false);
                    if (rg) {
                        const int ci = 8 * (fq & 1);
                        const f32x4 c0 = *(const f32x4*)(rcos + (size_t)row * 16 + ci), c1 = *(const f32x4*)(rcos + (size_t)row * 16 + ci + 4);
                        const f32x4 s0 = *(const f32x4*)(rsin + (size_t)row * 16 + ci), s1 = *(const f32x4*)(rsin + (size_t)row * 16 + ci + 4);
                        const float sg = (fq < 2) ? -1.f : 1.f;
#pragma unroll
                        for (int e = 0; e < 4; ++e) {
                            const float p0 = __shfl_xor(v0[e], 32), p1 = __shfl_xor(v1[e], 32);
                            v0[e] = v0[e] * c0[e] + sg * p0 * s0[e];
                            v1[e] = v1[e] * c1[e] + sg * p1 * s1[e];
                        }
                    }
                    u32x4 w; w.x = pk2(v0[0], v0[1]); w.y = pk2(v0[2], v0[3]); w.z = pk2(v1[0], v1[1]); w.w = pk2(v1[2], v1[3]);
                    *(u32x4*)(O + (size_t)row * ldc + col) = w;
                }
                __builtin_amdgcn_sched_barrier(0);
            }
    }
};
struct EpiRes {
    static constexpr bool PERM = true;
    const float* base32; const bf16_t* base16; bf16_t* xb; float* ssq;
    __device__ __forceinline__ void operator()(const f32x4 (&acc)[2][2][4][2], const Unit& u, int wr, int wc, int fr, int fq) const {
        const int row0 = u.pm * BM + wr * 64 + fr;
#pragma unroll
        for (int ai = 0; ai < 2; ++ai)
#pragma unroll
            for (int m = 0; m < 4; ++m) {
                const int row = row0 + ai * HALF + m * 16; float ss = 0.f;
#pragma unroll
                for (int bj = 0; bj < 2; ++bj) {
                    const size_t off = (size_t)row * D + u.pn * BM + bj * HALF + wc * 32 + 8 * fq;
                    f32x4 b0, b1;
                    if (base32) { b0 = *(const f32x4*)(base32 + off); b1 = *(const f32x4*)(base32 + off + 4); }
                    else { const u32x4 bw = *(const u32x4*)(base16 + off);
                        b0 = (f32x4){bf2f(bw.x & 0xffffu), bf2f(bw.x >> 16), bf2f(bw.y & 0xffffu), bf2f(bw.y >> 16)};
                        b1 = (f32x4){bf2f(bw.z & 0xffffu), bf2f(bw.z >> 16), bf2f(bw.w & 0xffffu), bf2f(bw.w >> 16)}; }
                    const f32x4 v0 = b0 + acc[ai][bj][m][0], v1 = b1 + acc[ai][bj][m][1];
                    u32x4 w; w.x = pk2(v0[0], v0[1]); w.y = pk2(v0[2], v0[3]); w.z = pk2(v1[0], v1[1]); w.w = pk2(v1[2], v1[3]);
                    *(u32x4*)(xb + off) = w;
                    ss += ((v0[0] * v0[0] + v0[1] * v0[1]) + (v0[2] * v0[2] + v0[3] * v0[3])) + ((v1[0] * v1[0] + v1[1] * v1[1]) + (v1[2] * v1[2] + v1[3] * v1[3]));
                }
                ss = xsum16_32(ss);
                if (fq == 0) ssq[(size_t)row * 16 + u.pn * 4 + wc] = ss;
            }
    }
};

template <class Epi>
__device__ __forceinline__ void gemm_phase(LAS unsigned char* lds, const Gemm g, const StaticOrder& S, const Epi& E) {
    int tid = threadIdx.x; asm volatile("" : "+v"(tid));
    const int wid = __builtin_amdgcn_readfirstlane(tid >> 6), lane = tid & 63, wr = wid >> 2, wc = wid & 3, fr = lane & 15, fq = lane >> 4;
    const int K = g.K, nt = K / BK, lda = g.lda;
    unsigned voffA[2], voffB[2];
#pragma unroll
    for (int i = 0; i < 2; ++i) { int R, C; stage_rc(tid * 16 + i * 8192, R, C); const int Rb = Epi::PERM ? ((R & ~31) + perm32(R & 31)) : R;
        voffA[i] = (unsigned)(R * lda + C) * 2u; voffB[i] = (unsigned)(Rb * K + C) * 2u; }
    const size_t kstep = (size_t)(BK * 2);
    const size_t hstepA = (size_t)HALF * lda * 2, hstepB = (size_t)HALF * K * 2;
    const size_t tstepA = 2 * hstepA, tstepB = 2 * hstepB;
    const unsigned ldsw = (unsigned)wid * 1024u;
    const int aoff = lds_byte(wr * 64 + fr, fq * 8), boff = lds_byte(wc * 32 + fr, fq * 8);
#define PG8_SA(b, h) (((b) * 2 + (h)) * HTB)
#define PG8_SB(b, h) ((4 + (b) * 2 + (h)) * HTB)
#define PG8_STAGE(bufoff, gbase, voff) do { _Pragma("unroll") for (int _i = 0; _i < 2; ++_i) \
        __builtin_amdgcn_global_load_lds((const unsigned*)((const char*)(gbase) + (voff)[_i]), (LAS unsigned*)(lds + (bufoff) + ldsw + _i * 8192), 16, 0, 0); } while (0)
#define PG8_LDA(dst, b, h) do { _Pragma("unroll") for (int m = 0; m < 4; ++m) _Pragma("unroll") for (int k = 0; k < 2; ++k) dst[m][k] = *(const LAS bf16x8*)(lds + PG8_SA(b, h) + aoff + m * 2048 + k * 1024); } while (0)
#define PG8_LDB(dst, b, h) do { _Pragma("unroll") for (int n = 0; n < 2; ++n) _Pragma("unroll") for (int k = 0; k < 2; ++k) dst[n][k] = *(const LAS bf16x8*)(lds + PG8_SB(b, h) + boff + n * 2048 + k * 1024); } while (0)
#define PG8_MMA(ai, bj, At, Bt) do { __builtin_amdgcn_s_setprio(1); _Pragma("unroll") for (int m = 0; m < 4; ++m) _Pragma("unroll") for (int n = 0; n < 2; ++n) _Pragma("unroll") for (int k = 0; k < 2; ++k) \
        acc[ai][bj][m][n] = __builtin_amdgcn_mfma_f32_16x16x32_bf16(Bt[n][k], At[m][k], acc[ai][bj][m][n], 0, 0, 0); __builtin_amdgcn_s_setprio(0); } while (0)
#define PG8_WAIT_V(n) asm volatile("s_waitcnt vmcnt(" #n ")" ::: "memory")
#define PG8_WAIT_L(n) asm volatile("s_waitcnt lgkmcnt(" #n ")" ::: "memory")
#define PG8_BAR __builtin_amdgcn_s_barrier()
#define PG8_SCHED __builtin_amdgcn_sched_barrier(0)
    Unit cur, nxt; int ui = 0;
    if (!S.next(0, cur)) return;
    f32x4 acc[2][2][4][2];
#pragma unroll
    for (int a = 0; a < 2; ++a)
#pragma unroll
        for (int b = 0; b < 2; ++b)
#pragma unroll
            for (int m = 0; m < 4; ++m)
#pragma unroll
                for (int n = 0; n < 2; ++n) acc[a][b][m][n] = (f32x4){0.f, 0.f, 0.f, 0.f};
    bf16x8 At[4][2], B0[2][2], B1[2][2];
    const char* cA = (const char*)g.A + (size_t)cur.pm * tstepA; const char* cB = (const char*)g.Bt + (size_t)cur.pn * tstepB;
    PG8_STAGE(PG8_SB(0, 0), cB, voffB); PG8_STAGE(PG8_SB(0, 1), cB + hstepB, voffB); PG8_STAGE(PG8_SA(0, 0), cA, voffA); PG8_STAGE(PG8_SA(0, 1), cA + hstepA, voffA);
    if (wr == 1) PG8_BAR;
    PG8_WAIT_V(2); PG8_BAR;
    PG8_STAGE(PG8_SB(1, 0), cB + kstep, voffB); PG8_STAGE(PG8_SA(1, 0), cA + kstep, voffA); PG8_STAGE(PG8_SB(1, 1), cB + hstepB + kstep, voffB);
    PG8_WAIT_V(6); PG8_BAR;
    for (;;) {
        const bool has_next = S.next(ui + 1, nxt);
        const char* nA = has_next ? (const char*)g.A + (size_t)nxt.pm * tstepA : cA; const char* nB = has_next ? (const char*)g.Bt + (size_t)nxt.pn * tstepB : cB;
        for (int t = 0; t < nt; t += 2) {
            const bool last = (t == nt - 2);
            const char* a1 = cA + (size_t)(t + 1) * kstep;
            const char* a2 = last ? nA : cA + (size_t)(t + 2) * kstep; const char* b2 = last ? nB : cB + (size_t)(t + 2) * kstep;
            const char* a3 = a2 + kstep; const char* b3 = b2 + kstep;
            PG8_LDB(B0, 0, 0); PG8_LDB(B1, 0, 1); PG8_SCHED; PG8_LDA(At, 0, 0); PG8_STAGE(PG8_SA(1, 1), a1 + hstepA, voffA);
            PG8_WAIT_V(8); PG8_WAIT_L(0); PG8_BAR; PG8_MMA(0, 0, At, B0); PG8_MMA(0, 1, At, B1); PG8_BAR; PG8_SCHED;
            PG8_LDA(At, 0, 1); PG8_STAGE(PG8_SB(0, 0), b2, voffB); PG8_STAGE(PG8_SB(0, 1), b2 + hstepB, voffB); PG8_STAGE(PG8_SA(0, 0), a2, voffA);
            PG8_WAIT_V(8); PG8_WAIT_L(0); PG8_BAR; PG8_MMA(1, 0, At, B0); PG8_MMA(1, 1, At, B1); PG8_BAR; PG8_SCHED;
            PG8_LDB(B0, 1, 0); PG8_LDB(B1, 1, 1); PG8_SCHED; PG8_LDA(At, 1, 0); PG8_STAGE(PG8_SA(0, 1), a2 + hstepA, voffA);
            PG8_WAIT_V(8); PG8_WAIT_L(0); PG8_BAR; PG8_MMA(0, 0, At, B0); PG8_MMA(0, 1, At, B1); PG8_BAR; PG8_SCHED;
            PG8_LDA(At, 1, 1); PG8_STAGE(PG8_SB(1, 0), b3, voffB); PG8_STAGE(PG8_SB(1, 1), b3 + hstepB, voffB); PG8_STAGE(PG8_SA(1, 0), a3, voffA);
            PG8_WAIT_V(8); PG8_WAIT_L(0); PG8_BAR; PG8_MMA(1, 0, At, B0); PG8_MMA(1, 1, At, B1); PG8_BAR; PG8_SCHED;
        }
        if (wr == 0) PG8_BAR;
        E(acc, cur, wr, wc, fr, fq);
        if (!has_next) break;
#pragma unroll
        for (int a = 0; a < 2; ++a)
#pragma unroll
            for (int b = 0; b < 2; ++b)
#pragma unroll
                for (int m = 0; m < 4; ++m)
#pragma unroll
                    for (int n = 0; n < 2; ++n) acc[a][b][m][n] = (f32x4){0.f, 0.f, 0.f, 0.f};
        cur = nxt; cA = nA; cB = nB; ++ui;
        if (wr == 1) PG8_BAR;
    }
    PG8_WAIT_V(0);
    PG8_BAR;
#undef PG8_SA
#undef PG8_SB
#undef PG8_STAGE
#undef PG8_LDA
#undef PG8_LDB
#undef PG8_MMA
#undef PG8_WAIT_V
#undef PG8_WAIT_L
#undef PG8_BAR
#undef PG8_SCHED
}
}

template <int VS, int D> __device__ __forceinline__ void tr_block(unsigned a, s16x4 (&l)[4], s16x4 (&h)[4]) {
    asm volatile("ds_read_b64_tr_b16 %0, %1 offset:%2" : "=v"(l[0]) : "v"(a), "i"(0 * VS + D * 64) : "memory");
    asm volatile("ds_read_b64_tr_b16 %0, %1 offset:%2" : "=v"(h[0]) : "v"(a), "i"(4 * VS + D * 64) : "memory");
    asm volatile("ds_read_b64_tr_b16 %0, %1 offset:%2" : "=v"(l[1]) : "v"(a), "i"(16 * VS + D * 64) : "memory");
    asm volatile("ds_read_b64_tr_b16 %0, %1 offset:%2" : "=v"(h[1]) : "v"(a), "i"(20 * VS + D * 64) : "memory");
    asm volatile("ds_read_b64_tr_b16 %0, %1 offset:%2" : "=v"(l[2]) : "v"(a), "i"(32 * VS + D * 64) : "memory");
    asm volatile("ds_read_b64_tr_b16 %0, %1 offset:%2" : "=v"(h[2]) : "v"(a), "i"(36 * VS + D * 64) : "memory");
    asm volatile("ds_read_b64_tr_b16 %0, %1 offset:%2" : "=v"(l[3]) : "v"(a), "i"(48 * VS + D * 64) : "memory");
    asm volatile("ds_read_b64_tr_b16 %0, %1 offset:%2" : "=v"(h[3]) : "v"(a), "i"(52 * VS + D * 64) : "memory");
}
#define TR_WAIT8(l, h) asm volatile("s_waitcnt lgkmcnt(8)" : "+v"(l[0]), "+v"(l[1]), "+v"(l[2]), "+v"(l[3]), "+v"(h[0]), "+v"(h[1]), "+v"(h[2]), "+v"(h[3]) :: "memory")
#define TR_WAIT0(l, h) asm volatile("s_waitcnt lgkmcnt(0)" : "+v"(l[0]), "+v"(l[1]), "+v"(l[2]), "+v"(l[3]), "+v"(h[0]), "+v"(h[1]), "+v"(h[2]), "+v"(h[3]) :: "memory")
#define PV4(d, l, h) do { _Pragma("unroll") for (int cc = 0; cc < 4; ++cc) { \
        const bf16x8 vf = (bf16x8){l[cc][0], l[cc][1], l[cc][2], l[cc][3], h[cc][0], h[cc][1], h[cc][2], h[cc][3]}; \
        o[d] = __builtin_amdgcn_mfma_f32_32x32x16_bf16(vf, __builtin_bit_cast(bf16x8, pw[cc]), o[d], 0, 0, 0); } } while (0)

__device__ __forceinline__ float fadd_s(float a, float b) { float r; asm("v_add_f32_e32 %0, %1, %2" : "=v"(r) : "v"(a), "v"(b)); return r; }
template <int DK, int DK1, int DV, bool MASK, bool NEGM = true, bool PF2 = false, int VAH = 1, bool SHIFT = false>
__device__ __forceinline__ void attn_core(LAS unsigned char* lds,
        const bf16_t* Qp, long ldq, const bf16_t* K1p, long ldk1, const bf16_t* K2p, long ldk2, const bf16_t* Vp, long ldv,
        int q0, int kt0, int kt1, int W, f32x16 (&o)[DV / 32], float& m_out, float& l_out) {
    constexpr int KS = DK * 2 + 16, VS = DV * 2 + 64, KBUF = 64 * KS, VBUF = 64 * VS;
    constexpr int KCH1 = DK1 / 8, NKC1 = 64 * KCH1, KPT1 = (NKC1 + 511) / 512, KCH2 = (DK - DK1) / 8, NKC2 = 64 * KCH2, KPT2 = (NKC2 + 511) / 512, KPT = KPT1 + KPT2;
    constexpr int VCH = DV / 8, NVC = 64 * VCH, VPT = (NVC + 511) / 512;
    static_assert(3 * KBUF + 3 * VBUF <= 131072, "attn lds");
    int tid = threadIdx.x; asm volatile("" : "+v"(tid));
    const int lane = tid & 63, wid = __builtin_amdgcn_readfirstlane(tid >> 6), r32 = lane & 31, hi = lane >> 5;
    LAS unsigned char* kbuf = lds; LAS unsigned char* vbuf = lds + 3 * KBUF;
    const int qlo = q0 + wid * 32, qrow = qlo + r32;
    bf16x8 qf[DK / 16];
#pragma unroll
    for (int c = 0; c < DK / 16; ++c) qf[c] = *(const bf16x8*)(Qp + (long)qrow * ldq + 16 * c + 8 * hi);
#pragma unroll
    for (int d = 0; d < DV / 32; ++d) o[d] = f32x16{};
    float mrun = 0.f, lrun = 0.f;
    u32x4 kreg0[KPT], vreg0[VPT], kreg1[KPT], vreg1[VPT];
#pragma unroll
    for (int i = 0; i < KPT; ++i) { kreg0[i] = (u32x4){0u, 0u, 0u, 0u}; kreg1[i] = kreg0[i]; }
#pragma unroll
    for (int i = 0; i < VPT; ++i) { vreg0[i] = (u32x4){0u, 0u, 0u, 0u}; vreg1[i] = vreg0[i]; }
    unsigned kgo[KPT], vgo[VPT]; int klo_[KPT], vlo_[VPT];
#pragma unroll
    for (int i = 0; i < KPT1; ++i) { const int e = (tid + 512 * i) % NKC1, row = e / KCH1, ch = e % KCH1; kgo[i] = (unsigned)(row * (int)ldk1 + ch * 8) * 2u; klo_[i] = row * KS + ch * 16; }
#pragma unroll
    for (int i = 0; i < KPT2; ++i) { const int e = (tid + 512 * i) % (NKC2 ? NKC2 : 1), row = e / (KCH2 ? KCH2 : 1), ch = e % (KCH2 ? KCH2 : 1); kgo[KPT1 + i] = (unsigned)(row * (int)ldk2 + ch * 8) * 2u; klo_[KPT1 + i] = row * KS + (KCH1 + ch) * 16; }
#pragma unroll
    for (int i = 0; i < VPT; ++i) { const int e = (tid + 512 * i) % NVC, row = e / VCH, ch = e % VCH; vgo[i] = (unsigned)(row * (int)ldv + ch * 8) * 2u; vlo_[i] = row * VS + ch * 16; }
#define ATT_LOAD(t, kreg, vreg) do { \
    const char* k1t_ = (const char*)(K1p + 64L * (t) * ldk1); const char* k2t_ = (const char*)(K2p + 64L * (t) * ldk2); const char* vt_ = (const char*)(Vp + 64L * (t) * ldv); \
    _Pragma("unroll") for (int i_ = 0; i_ < KPT1; ++i_) { kreg[i_] = *(const u32x4*)(k1t_ + (size_t)kgo[i_]); } \
    _Pragma("unroll") for (int i_ = 0; i_ < KPT2; ++i_) { kreg[KPT1 + i_] = *(const u32x4*)(k2t_ + (size_t)kgo[KPT1 + i_]); } \
    _Pragma("unroll") for (int i_ = 0; i_ < VPT; ++i_) { vreg[i_] = *(const u32x4*)(vt_ + (size_t)vgo[i_]); } } while (0)
#define ATT_STORE(b) do { \
    _Pragma("unroll") for (int i_ = 0; i_ < KPT1; ++i_) { if ((NKC1 % 512 == 0) || tid + 512 * i_ < NKC1) *(LAS u32x4*)(kbuf + (b) * KBUF + klo_[i_]) = kreg[i_]; } \
    _Pragma("unroll") for (int i_ = 0; i_ < KPT2; ++i_) { if ((NKC2 % 512 == 0) || tid + 512 * i_ < NKC2) *(LAS u32x4*)(kbuf + (b) * KBUF + klo_[KPT1 + i_]) = kreg[KPT1 + i_]; } \
    _Pragma("unroll") for (int i_ = 0; i_ < VPT; ++i_) { if ((NVC % 512 == 0) || tid + 512 * i_ < NVC) *(LAS u32x4*)(vbuf + (b) * VBUF + vlo_[i_]) = vreg[i_]; } } while (0)
#define ATT_STOREKV(kb_, vb_, kreg, vreg) do { \
    _Pragma("unroll") for (int i_ = 0; i_ < KPT1; ++i_) { if ((NKC1 % 512 == 0) || tid + 512 * i_ < NKC1) *(LAS u32x4*)(kbuf + (kb_) * KBUF + klo_[i_]) = kreg[i_]; } \
    _Pragma("unroll") for (int i_ = 0; i_ < KPT2; ++i_) { if ((NKC2 % 512 == 0) || tid + 512 * i_ < NKC2) *(LAS u32x4*)(kbuf + (kb_) * KBUF + klo_[KPT1 + i_]) = kreg[KPT1 + i_]; } \
    _Pragma("unroll") for (int i_ = 0; i_ < VPT; ++i_) { if ((NVC % 512 == 0) || tid + 512 * i_ < NVC) *(LAS u32x4*)(vbuf + (vb_) * VBUF + vlo_[i_]) = vreg[i_]; } } while (0)
    ATT_LOAD(kt0, kreg0, vreg0); ATT_STOREKV(0, 0, kreg0, vreg0);
    if (PF2) ATT_LOAD((kt0 + 1 < kt1 ? kt0 + 1 : kt1 - 1), kreg1, vreg1);
    __syncthreads();
    const int pr = (r32 & 0x13) | ((r32 & 8) >> 1) | ((r32 & 4) << 1);
    const int koff = pr * KS + hi * 16;
    const int voff = (8 * hi + ((lane & 15) >> 2)) * VS + (16 * ((lane >> 4) & 1) + 4 * (lane & 3)) * 2;
    int ta = kt0, tb = kt1;
    if (MASK) { int lo = (qlo - W) >> 6; if (qlo - W < 0) lo = 0; if (lo > ta) ta = lo; const int hi_t = ((qlo + 31) >> 6) + 1; if (hi_t < tb) tb = hi_t; }
    constexpr int NQ = 2 * (DK / 16), NPV = 4 * (DV / 32), VA = (36 + NQ - 1) / NQ, VC = 32 / NPV;
    f32x16 negm = f32x16{};
    f32x16 sA0 = f32x16{}, sA1 = f32x16{};
    u32x4 pw[4];
#pragma unroll
    for (int i = 0; i < 4; ++i) pw[i] = (u32x4){0u, 0u, 0u, 0u};
    s16x4 va_l[4], va_h[4], vb_l[4], vb_h[4];
#pragma unroll
    for (int i = 0; i < 4; ++i) { va_l[i] = (s16x4){0, 0, 0, 0}; va_h[i] = va_l[i]; vb_l[i] = va_l[i]; vb_h[i] = va_l[i]; }
    bool has_pend = false, started = false;
    int kb_cur = 0, vb_cur = 0, vb_prev = 0;
#define ATT_X1(t, S0, S1) do { if (doqk_) { \
                if (NEGM) { S0 = negm; S1 = negm; } else { S0 = f32x16{}; S1 = f32x16{}; } \
                const LAS unsigned char* kb = kbuf + kb_cur * KBUF + koff; \
                bf16x8 ka0 = *(const LAS bf16x8*)(kb), ka1 = *(const LAS bf16x8*)(kb + 32 * KS); \
                __builtin_amdgcn_s_setprio(1); \
                _Pragma("unroll") for (int c = 0; c < DK / 16; ++c) { \
                    bf16x8 kn0 = ka0, kn1 = ka1; \
                    if (c + 1 < DK / 16) { kn0 = *(const LAS bf16x8*)(kb + (c + 1) * 32); kn1 = *(const LAS bf16x8*)(kb + 32 * KS + (c + 1) * 32); } \
                    S0 = __builtin_amdgcn_mfma_f32_32x32x16_bf16(ka0, qf[c], S0, 0, 0, 0); \
                    S1 = __builtin_amdgcn_mfma_f32_32x32x16_bf16(ka1, qf[c], S1, 0, 0, 0); \
                    __builtin_amdgcn_sched_barrier(0); \
                    ka0 = kn0; ka1 = kn1; } \
                __builtin_amdgcn_s_setprio(0); \
                if (!NEGM) { _Pragma("unroll") for (int r = 0; r < 16; ++r) { S0[r] -= mrun; S1[r] -= mrun; } } \
            } } while (0)
#define ATT_X2(P0, P1) do { if (dopv_) { \
                float rs0_ = P0[0], rs1_ = P1[0], rs2_ = P0[1], rs3_ = P1[1]; \
                _Pragma("unroll") for (int r = 2; r < 16; r += 2) { rs0_ = fadd_s(rs0_, P0[r]); rs1_ = fadd_s(rs1_, P1[r]); rs2_ = fadd_s(rs2_, P0[r + 1]); rs3_ = fadd_s(rs3_, P1[r + 1]); } \
                lrun += (rs0_ + rs1_) + (rs2_ + rs3_); \
                u32x4 w; \
                w.x = pk2(P0[0], P0[1]); w.y = pk2(P0[2], P0[3]); w.z = pk2(P0[4], P0[5]); w.w = pk2(P0[6], P0[7]); pw[0] = w; \
                w.x = pk2(P0[8], P0[9]); w.y = pk2(P0[10], P0[11]); w.z = pk2(P0[12], P0[13]); w.w = pk2(P0[14], P0[15]); pw[1] = w; \
                w.x = pk2(P1[0], P1[1]); w.y = pk2(P1[2], P1[3]); w.z = pk2(P1[4], P1[5]); w.w = pk2(P1[6], P1[7]); pw[2] = w; \
                w.x = pk2(P1[8], P1[9]); w.y = pk2(P1[10], P1[11]); w.z = pk2(P1[12], P1[13]); w.w = pk2(P1[14], P1[15]); pw[3] = w; \
            } } while (0)
#define ATT_X3(t, S0, S1) do { if (doqk_) { \
                const int klo = 64 * (t); \
                if (MASK && ((klo + 63 > qlo) || (klo < qlo + 31 - W))) { \
                    const int rel = qrow - klo - 8 * hi, rel2 = rel - W; \
                    _Pragma("unroll") for (int r = 0; r < 16; ++r) { const int i = r >> 2, j = r & 3; const int c0 = 16 * (i >> 1) + 4 * (i & 1) + j, c1 = c0 + 32; \
                        S0[r] = (c0 <= rel && c0 >= rel2) ? S0[r] : NEGBIG; S1[r] = (c1 <= rel && c1 >= rel2) ? S1[r] : NEGBIG; } \
                } \
                float rm = fmaxf(fmaxf(S0[0], S1[0]), S0[1]); \
                _Pragma("unroll") for (int r = 1; r < 15; r += 2) { rm = fmaxf(fmaxf(rm, S1[r]), S0[r + 1]); rm = fmaxf(fmaxf(rm, S1[r + 1]), S0[r + 2 > 15 ? 15 : r + 2]); } \
                rm = fmaxf(rm, S1[15]); \
                { auto rr_ = __builtin_amdgcn_permlane32_swap(__float_as_uint(rm), __float_as_uint(rm), false, false); rm = fmaxf(__uint_as_float(rr_[0]), __uint_as_float(rr_[1])); } \
                const float dl = started ? ((rm > 8.f) ? rm : 0.f) : rm; \
                if (__builtin_amdgcn_ballot_w64(dl != 0.f) != 0ull) { \
                    mrun += dl; \
                    _Pragma("unroll") for (int r = 0; r < 16; ++r) { S0[r] -= dl; S1[r] -= dl; } \
                    if (NEGM) { _Pragma("unroll") for (int r = 0; r < 16; ++r) negm[r] = -mrun; } \
                    if (started) { fsc_ = __builtin_amdgcn_exp2f(-dl); lrun *= fsc_; resc_ = true; } \
                } \
            } } while (0)
#define ATT_X4() do { if (dopv_) { \
                const unsigned va_ = (unsigned)(size_t)(vbuf + vb_prev * VBUF + voff); \
                __builtin_amdgcn_s_setprio(1); \
                tr_block<VS, 0>(va_, va_l, va_h); \
                tr_block<VS, 1>(va_, vb_l, vb_h); \
                if (DV == 64) { TR_WAIT8(va_l, va_h); PV4(0, va_l, va_h); TR_WAIT0(vb_l, vb_h); PV4(1, vb_l, vb_h); } \
                else { TR_WAIT8(va_l, va_h); PV4(0, va_l, va_h); \
                    tr_block<VS, 2>(va_, va_l, va_h); TR_WAIT8(vb_l, vb_h); PV4(1, vb_l, vb_h); \
                    tr_block<VS, 3>(va_, vb_l, vb_h); TR_WAIT8(va_l, va_h); PV4(DV == 64 ? 0 : 2, va_l, va_h); \
                    TR_WAIT0(vb_l, vb_h); PV4(DV == 64 ? 1 : 3, vb_l, vb_h); } \
                __builtin_amdgcn_s_setprio(0); \
            } } while (0)
#define ATT_X5(S0, S1) do { if (doqk_) { \
                _Pragma("unroll") for (int r = 0; r < 16; ++r) { S0[r] = __builtin_amdgcn_exp2f(S0[r]); S1[r] = __builtin_amdgcn_exp2f(S1[r]); } \
            } } while (0)
#define ATT_STEP(t, KL, VL, KST, VST) do { \
        const bool more_ = ((t) + 1 < kt1); \
        { const int tl_ = (t) + (PF2 ? 2 : 1); ATT_LOAD((tl_ < kt1 ? tl_ : kt1 - 1), KL, VL); }     \
        __builtin_amdgcn_sched_barrier(0);     \
        const bool doqk_ = ((t) >= ta) && ((t) < tb); \
        const bool dopv_ = has_pend; \
        float fsc_ = 1.f; bool resc_ = false; \
        ATT_X2(sA0, sA1); ATT_X4(); \
        const int sl_n_ = (kb_cur == 2) ? 0 : kb_cur + 1; \
        if (grp2) { asm volatile("s_waitcnt lgkmcnt(0)" ::: "memory"); __builtin_amdgcn_s_barrier(); asm volatile("" ::: "memory"); } \
        ATT_X1(t, sA0, sA1); ATT_X3(t, sA0, sA1); ATT_X5(sA0, sA1); \
        if (resc_) { \
            _Pragma("unroll") for (int d = 0; d < DV / 32; ++d) _Pragma("unroll") for (int r = 0; r < 16; ++r) o[d][r] *= fsc_; \
        } \
        has_pend = doqk_; started = started || doqk_; \
        __builtin_amdgcn_sched_barrier(0); \
        ATT_STOREKV(sl_n_, sl_n_, KST, VST); \
        vb_prev = kb_cur; kb_cur = sl_n_; \
        if (!grp2) { asm volatile("s_waitcnt lgkmcnt(0)" ::: "memory"); __builtin_amdgcn_s_barrier(); asm volatile("" ::: "memory"); } \
    } while (0)
    const bool grp2 = SHIFT && (wid >= 4);
    for (int t = kt0; t <= kt1; t += 2) {
        if (PF2) { ATT_STEP(t, kreg0, vreg0, kreg1, vreg1); if (t + 1 <= kt1) ATT_STEP(t + 1, kreg1, vreg1, kreg0, vreg0); }
        else { ATT_STEP(t, kreg0, vreg0, kreg0, vreg0); if (t + 1 <= kt1) ATT_STEP(t + 1, kreg0, vreg0, kreg0, vreg0); }
    }
#undef ATT_STEP
#undef ATT_X1
#undef ATT_X2
#undef ATT_X3
#undef ATT_X4
#undef ATT_X5
#undef ATT_STOREKV
#undef ATT_LOAD
#undef ATT_STORE
    lrun += __shfl_xor(lrun, 32);
    m_out = mrun; l_out = lrun;
}

#define XB_TMO      128
#define XB_XCNT(j)  (256  + 64 * (j))
#define XB_XSUB(j)  (1280 + 64 * (j))
#define XB_XGEN(j)  (2304 + 64 * (j))
#define XB_TOP      3328
#define XB_TOPGEN   3392
#define XCD_BAR_WORDS 3456
#define XB_SPIN_CAP (1u << 20)
__device__ __forceinline__ unsigned xb_ld(unsigned* p)              { return __hip_atomic_load(p, __ATOMIC_RELAXED, __HIP_MEMORY_SCOPE_AGENT); }
__device__ __forceinline__ unsigned xb_add(unsigned* p, unsigned v) { return __hip_atomic_fetch_add(p, v, __ATOMIC_RELAXED, __HIP_MEMORY_SCOPE_AGENT); }
__device__ __forceinline__ unsigned xb_xcc_id() { return (unsigned)__builtin_amdgcn_s_getreg((3 << 11) | 20) & 0xFu; }
#define XB_SPIN(cond, bar) do { unsigned _sp = 0; while (cond) { __builtin_amdgcn_s_sleep(1); \
    if ((++_sp & 255u) == 0u) { if (xb_ld(&(bar)[XB_TMO])) break; if (_sp > XB_SPIN_CAP) { atomicAdd(&(bar)[XB_TMO], 1u); break; } } } } while (0)
struct XcdBarrier { unsigned* bar; unsigned x; volatile LAS unsigned* st; };
__device__ __forceinline__ XcdBarrier xcd_barrier_post(unsigned* bar, volatile LAS unsigned* st) {
    XcdBarrier b; b.bar = bar; b.x = xb_xcc_id(); b.st = st;
    if (threadIdx.x == 0) (void)xb_add(&bar[XB_XCNT(b.x)], 1u);
    return b;
}
__device__ __forceinline__ void xcd_barrier_complete(unsigned* bar, unsigned x, unsigned& nloc, unsigned& nx) {
    const unsigned G = gridDim.x * gridDim.y * gridDim.z;
    unsigned sum, cnt, mine, sp = 0u;
    for (;;) {
        sum = 0u; cnt = 0u; mine = 0u;
#pragma unroll
        for (unsigned j = 0; j < 16; ++j) { const unsigned c = xb_ld(&bar[XB_XCNT(j)]); sum += c; cnt += (c > 0u) ? 1u : 0u; mine = (j == x) ? c : mine; }
        if (sum == G) break;
        __builtin_amdgcn_s_sleep(1);
        if ((++sp & 255u) == 0u) { if (xb_ld(&bar[XB_TMO])) break; if (sp > XB_SPIN_CAP) { atomicAdd(&bar[XB_TMO], 1u); break; } }
    }
    nloc = mine > 0u ? mine : 1u; nx = cnt > 0u ? cnt : 1u;
}
__device__ __forceinline__ void xcd_barrier(const XcdBarrier& b) {
    asm volatile("s_waitcnt vmcnt(0)" ::: "memory");
    __syncthreads();
    if (threadIdx.x == 0) {
        unsigned* bar = b.bar;
        __builtin_amdgcn_s_waitcnt(0);
        unsigned nloc = b.st[0], nx = b.st[1];
        if (nloc == 0u) { xcd_barrier_complete(bar, b.x, nloc, nx); b.st[0] = nloc; b.st[1] = nx; }
        const unsigned old = xb_add(&bar[XB_XSUB(b.x)], 1u);
        const unsigned gen = old / nloc;
        if (old + 1u == (gen + 1u) * nloc) {
            __builtin_amdgcn_fence(__ATOMIC_RELEASE, "agent");
            asm volatile("s_waitcnt vmcnt(0)" ::: "memory");
            const unsigned og = xb_add(&bar[XB_TOP], 1u);
            const unsigned tg = og / nx;
            if (og + 1u == (tg + 1u) * nx) xb_add(&bar[XB_TOPGEN], 1u);
            else XB_SPIN(xb_ld(&bar[XB_TOPGEN]) == tg, bar);
            __builtin_amdgcn_fence(__ATOMIC_ACQUIRE, "agent");
            xb_add(&bar[XB_XGEN(b.x)], 1u);
            asm volatile("s_waitcnt vmcnt(0)" ::: "memory");
        } else {
            XB_SPIN(xb_ld(&bar[XB_XGEN(b.x)]) == gen, bar);
            __builtin_amdgcn_fence(__ATOMIC_ACQUIRE, "agent");
            asm volatile("s_waitcnt vmcnt(0)" ::: "memory");
        }
    }
    __syncthreads();
}

struct Args { const void* in[31]; float* out; unsigned char* ws; int ph_lo, ph_hi; };

__device__ __forceinline__ float wave_sum(float v) {
#pragma unroll
    for (int o = 1; o < 64; o <<= 1) v += __shfl_xor(v, o);
    return v;
}

__device__ __forceinline__ void transpose_items(const float* W, int K, int N, const float* gain, bf16_t* WT, int ldt, int row_off, LAS float* scr, int gw, int NGW, int lane) {
    const int nblk = N / 32, nitems = (K / 64) * nblk;
    for (int item = gw; item < nitems; item += NGW) {
        const int kb = item / nblk, nb = item % nblk, k0 = 64 * kb, n0 = 32 * nb;
        float tmp[32];
#pragma unroll
        for (int i = 0; i < 32; ++i) { const int kk = 2 * i + (lane >> 5); tmp[i] = W[(size_t)(k0 + kk) * N + n0 + (lane & 31)]; }
#pragma unroll
        for (int i = 0; i < 32; ++i) { const int kk = 2 * i + (lane >> 5); scr[kk * 33 + (lane & 31)] = tmp[i]; }
        asm volatile("s_waitcnt lgkmcnt(0)" ::: "memory");
        const int c = lane & 7;
        f32x4 g0 = {1.f, 1.f, 1.f, 1.f}, g1 = g0;
        if (gain) { g0 = *(const f32x4*)(gain + k0 + 8 * c); g1 = *(const f32x4*)(gain + k0 + 8 * c + 4); }
#pragma unroll
        for (int j = 0; j < 4; ++j) { const int n = (lane >> 3) + 8 * j; const LAS float* sp = scr + (8 * c) * 33 + n;
            u32x4 o; o.x = pk2(sp[0 * 33] * g0.x, sp[1 * 33] * g0.y); o.y = pk2(sp[2 * 33] * g0.z, sp[3 * 33] * g0.w); o.z = pk2(sp[4 * 33] * g1.x, sp[5 * 33] * g1.y); o.w = pk2(sp[6 * 33] * g1.z, sp[7 * 33] * g1.w);
            *(u32x4*)(WT + (size_t)(row_off + n0 + n) * ldt + k0 + 8 * c) = o; }
        asm volatile("s_waitcnt lgkmcnt(0)" ::: "memory");
    }
}

__global__ void __launch_bounds__(512) mk_fwd(Args args) {
    extern __shared__ __attribute__((aligned(16))) unsigned char lds_raw[];
    LAS unsigned char* lds = (LAS unsigned char*)lds_raw;
    cg::grid_group grid = cg::this_grid();
    volatile LAS unsigned* bst = (volatile LAS unsigned*)(lds + 131072 + 256);
    unsigned* barw = (unsigned*)(GAS unsigned*)(args.ws + WS_MISC + 65536);
    if (threadIdx.x < 2) bst[threadIdx.x] = 0u;
    if (blockIdx.x == 0) { for (int i = threadIdx.x; i < XCD_BAR_WORDS; i += 512) barw[i] = 0u; }
    __syncthreads();
    XcdBarrier xbar; xbar.bar = barw; xbar.x = 0; xbar.st = bst;
    bool posted = false;
    int rep = 0;
    for (int ph = args.ph_lo; ph < args.ph_hi; ++ph) {
    int tid = threadIdx.x; asm volatile("" : "+v"(tid));
    const int lane = tid & 63, wave = __builtin_amdgcn_readfirstlane(tid >> 6);
    const int G = gridDim.x, bid = blockIdx.x;
    const int gw = bid * 8 + wave, NGW = G * 8;
    const int vcu = (G % 8 == 0) ? (bid % 8) * (G / 8) + bid / 8 : bid;
    unsigned long long wsi_ = (unsigned long long)args.ws; asm volatile("" : "+s"(wsi_));
    unsigned char* ws = (unsigned char*)(GAS unsigned char*)wsi_;
    const float* x_in = TOG(const float, args.in[0]);
    float* outp = TOG(float, args.out);
    bf16_t* Wt = (bf16_t*)(ws + WS_W);
    bf16_t* XB = (bf16_t*)(ws + WS_XB);
    float* O1S = outp;
    (void)0;
    unsigned char* BIG = ws + WS_BIG;
    bf16_t* Z = (bf16_t*)(BIG + OB_Z);
    bf16_t* OA = (bf16_t*)(BIG + OB_OA);
    bf16_t* QD = (bf16_t*)(BIG + OB_QD);
    bf16_t* KVD = (bf16_t*)(BIG + OB_KVD);
    bf16_t* Hb = (bf16_t*)(BIG + OB_H);
    bf16_t* Y = (bf16_t*)(ws + WS_Y);
    bf16_t* QX = (bf16_t*)(ws + WS_Y);
    bf16_t* OX = (bf16_t*)(ws + WS_Y + 32 * MiB);
    bf16_t* KVMEM = (bf16_t*)(ws + WS_KVMEM);
    bf16_t* MN = (bf16_t*)(ws + WS_MN);
    float* SSQX = (float*)(ws + WS_SSQX);
    float* SSQZ = (float*)(ws + WS_SSQZ);
    float* RCOS = (float*)(ws + WS_ROPE);
    float* RSIN = RCOS + (size_t)T * 16;
    float* LSE = (float*)(ws + WS_LSE);
    float* MISC = (float*)(ws + WS_MISC);

        const int layer = (ph >= 14) ? 1 : 0;
        if (ph == 0 && (PHMASK & 1)) {
            LAS float* scr = (LAS float*)(lds + wave * 16384);
            const float* g_mix = TOG(const float, args.in[3]); const float* g_cross = TOG(const float, args.in[4]); const float* g_mlp = TOG(const float, args.in[9]);
            for (int l = 0; l < 2; ++l) {
                bf16_t* wl = Wt + l * LW;
                transpose_items(TOG(const float, args.in[6]) + (size_t)l * 1024 * 512, 1024, 512, g_cross + l * 1024, wl + OW_Q, 1024, 0, scr, gw, NGW, lane);
                transpose_items(TOG(const float, args.in[7]) + (size_t)l * 1024 * 1024, 1024, 1024, nullptr, wl + OW_KV, 1024, 0, scr, gw, NGW, lane);
                transpose_items(TOG(const float, args.in[8]) + (size_t)l * 512 * 1024, 512, 1024, nullptr, wl + OW_O, 512, 0, scr, gw, NGW, lane);
                transpose_items(TOG(const float, args.in[10]) + (size_t)l * 1024 * 4096, 1024, 4096, g_mlp + l * 1024, wl + OW_1, 1024, 0, scr, gw, NGW, lane);
                transpose_items(TOG(const float, args.in[11]) + (size_t)l * 4096 * 1024, 4096, 1024, nullptr, wl + OW_2, 4096, 0, scr, gw, NGW, lane);
            }
            transpose_items(TOG(const float, args.in[12]), 1024, 2560, g_mix, Wt + OW_ABIN, 1024, 0, scr, gw, NGW, lane);
            transpose_items(TOG(const float, args.in[13]), 1024, 1024, nullptr, Wt + OW_ABOUT, 1024, 0, scr, gw, NGW, lane);
            transpose_items(TOG(const float, args.in[18]), 1024, 2208, g_mix + 1024, Wt + OW_CDIN, 1024, 0, scr, gw, NGW, lane);
            transpose_items(TOG(const float, args.in[19]), 1024, 1024, nullptr, Wt + OW_CDOUT, 1024, 0, scr, gw, NGW, lane);
            transpose_items(TOG(const float, args.in[27]), 384, 768, TOG(const float, args.in[25]), Wt + OW_UQ, 384, 0, scr, gw, NGW, lane);
            transpose_items(TOG(const float, args.in[28]), 256, 512, TOG(const float, args.in[26]), Wt + OW_UKV, 256, 0, scr, gw, NGW, lane);
            transpose_items(TOG(const float, args.in[29]), 256, 512, TOG(const float, args.in[26]), Wt + OW_UKV, 256, 512, scr, gw, NGW, lane);
            { u32x4* zp = (u32x4*)(Wt + OW_CDIN + (size_t)2208 * 1024); const int n16 = 96 * 1024 * 2 / 16;
              for (int i = bid * 512 + tid; i < n16; i += G * 512) zp[i] = (u32x4){0u, 0u, 0u, 0u}; }
            for (int m = gw; m < T; m += NGW) {
                const f32x4* xr = (const f32x4*)(x_in + (size_t)m * D) + lane; float s = 0.f;
                unsigned long long* o8 = (unsigned long long*)(XB + (size_t)m * D) + lane;
#pragma unroll
                for (int j = 0; j < 4; ++j) { const f32x4 v = xr[64 * j]; s += (v.x * v.x + v.y * v.y) + (v.z * v.z + v.w * v.w);
                    o8[64 * j] = (unsigned long long)pk2(v.x, v.y) | ((unsigned long long)pk2(v.z, v.w) << 32); }
                s = wave_sum(s);
                if (lane < 16) SSQX[(size_t)m * 16 + lane] = (lane == 0) ? s : 0.f;
            }
            for (int mm = gw; mm < 2 * 1024; mm += NGW) {
                const int l = mm >> 10, m = mm & 1023;
                const f32x4* xr = (const f32x4*)(TOG(const float, args.in[1]) + (size_t)m * D) + lane; const f32x4* gr = (const f32x4*)(TOG(const float, args.in[5]) + l * D) + lane;
                f32x4 v[4]; float s = 0.f;
#pragma unroll
                for (int j = 0; j < 4; ++j) { v[j] = xr[64 * j]; s += (v[j].x * v[j].x + v[j].y * v[j].y) + (v[j].z * v[j].z + v[j].w * v[j].w); }
                const float r = 1.0f / sqrtf(wave_sum(s) * (1.f / D) + EPS);
                unsigned long long* o8 = (unsigned long long*)(MN + ((size_t)l * 1024 + m) * D) + lane;
#pragma unroll
                for (int j = 0; j < 4; ++j) { const f32x4 gg = gr[64 * j]; o8[64 * j] = (unsigned long long)pk2(v[j].x * r * gg.x, v[j].y * r * gg.y) | ((unsigned long long)pk2(v[j].z * r * gg.z, v[j].w * r * gg.w) << 32); }
            }
            for (int i = bid * 512 + tid; i < T * 16; i += G * 512) {
                const int row = i >> 4, fi = i & 15;
                const float invf = __builtin_amdgcn_exp2f(-(float)fi * 0.83048202372184058696f);
                const double rev = (double)(TOG(const int, args.in[2]))[row] * (double)invf * 0.15915494309189533577;
                const float fr = (float)(rev - rint(rev));
                RCOS[i] = __builtin_amdgcn_cosf(fr); RSIN[i] = __builtin_amdgcn_sinf(fr);
            }
            if (bid == 0 && wave == 0) {
                const float a = (TOG(const float, args.in[20]))[lane] * (TOG(const float, args.in[21]))[lane], b2 = (TOG(const float, args.in[22]))[lane] * (TOG(const float, args.in[23]))[lane];
                const float sa = wave_sum(a), sb = wave_sum(b2);
                if (lane == 0) MISC[0] = __expf(sa) - __expf(sb) + 0.35550906759097f;
            }
        }
        if ((PHMASK & 2) && (ph == 1 || ph == 5 || ph == 8 || ph == 10 || ph == 11 || ph == 14 || ph == 17)) {
            const int njobs = (ph == 1 || ph == 10 || ph == 11) ? 2 : 1;
            for (int j = 0; j < njobs; ++j) {
                pg8::Gemm g; pg8::EpiZ E;
                E.rs = SSQX; E.rs_stride = 16; E.rs_off = 0; E.rs_n4 = 4; E.rs_inv = 1.f / 1024.f; E.qs_end = 0; E.qscale = 1.f; E.act = 0; E.rope = 0; E.rope_g = -1;
                E.rcos = RCOS; E.rsin = RSIN; E.ssq = nullptr; E.ssq_stride = 0; E.rtab = (LAS float*)(lds + 131072 + 1024);
                int rot = 0;
                if (ph == 1 && j == 0) { g = pg8::Gemm{XB, Wt + OW_ABIN, T, 2560, 1024, 1024}; E.O = Z; E.ldc = 2560; E.qs_end = 512; E.qscale = 0.125f * LOG2E; }
                else if (ph == 1 || (ph == 10 && j == 1)) { const int l = (ph == 1) ? 0 : 1; g = pg8::Gemm{MN + (size_t)l * 1024 * 1024, Wt + l * LW + OW_KV, 1024, 1024, 1024, 1024}; E.O = KVMEM + (size_t)l * 1024 * 1024; E.ldc = 1024; E.rs = nullptr; rot = (ph == 1) ? 0 : 128; }
                else if (ph == 5 || ph == 14) { g = pg8::Gemm{XB, Wt + layer * LW + OW_Q, T, 512, 1024, 1024}; E.O = QX; E.ldc = 512; E.qs_end = 512; E.qscale = 0.08838834764831845f * LOG2E; }
                else if (ph == 8 || ph == 17) { g = pg8::Gemm{XB, Wt + layer * LW + OW_1, T, 4096, 1024, 1024}; E.O = Hb; E.ldc = 4096; E.act = 1; }
                else if (ph == 10) { g = pg8::Gemm{XB, Wt + OW_CDIN, T, 2304, 1024, 1024}; E.O = Z; E.ldc = 2304; E.qs_end = 512; E.qscale = 0.125f * LOG2E; E.rope = 1; E.rope_g = 68; E.ssq = SSQZ; E.ssq_stride = 72; }
                else if (ph == 11 && j == 0) { g = pg8::Gemm{Z + 1536, Wt + OW_UQ, T, 768, 384, 2304}; E.O = QD; E.ldc = 768; E.rs = SSQZ; E.rs_stride = 72; E.rs_off = 48; E.rs_n4 = 3; E.rs_inv = 1.f / 384.f;
                    E.qs_end = 768; E.qscale = 0.10206207261596577f * LOG2E; E.rope = 2; }
                else { g = pg8::Gemm{Z + 1920, Wt + OW_UKV, T, 1024, 256, 2304}; E.O = KVD; E.ldc = 1024; E.rs = SSQZ; E.rs_stride = 72; E.rs_off = 60; E.rs_n4 = 2; E.rs_inv = 1.f / 256.f; rot = 128; }
                pg8::StaticOrder S; S.init(g.M, g.N, G, (bid + rot) % G);
                pg8::gemm_phase<pg8::EpiZ>(lds, g, S, E);
            }
        }
        if ((PHMASK & 4) && (ph == 4 || ph == 7 || ph == 9 || ph == 13 || ph == 16 || ph == 18)) {
            pg8::Gemm g; pg8::EpiRes E; E.base32 = nullptr; E.base16 = XB; E.xb = XB; E.ssq = SSQX;
            if (ph == 4) { g = pg8::Gemm{Y, Wt + OW_ABOUT, T, 1024, 1024, 1024}; E.base32 = x_in; }
            else if (ph == 13) { g = pg8::Gemm{Y, Wt + OW_CDOUT, T, 1024, 1024, 1024}; }
            else if (ph == 7 || ph == 16) { g = pg8::Gemm{OX, Wt + layer * LW + OW_O, T, 1024, 512, 512}; }
            else { g = pg8::Gemm{Hb, Wt + layer * LW + OW_2, T, 1024, 4096, 4096}; }
            pg8::StaticOrder S; S.init(g.M, g.N, G, bid);
            pg8::gemm_phase<pg8::EpiRes>(lds, g, S, E);
        }
        if (ph == 2 && (PHMASK & 8)) {
            const int r32 = lane & 31, hi = lane >> 5;
            for (int u = vcu; u < 3072; u += G) {
                const int gp = u >> 10, v = u & 1023, bh = v >> 5, w = v & 31, b = bh >> 3, h = bh & 7;
                const int dil = (gp == 0) ? 1 : (gp == 1) ? 4 : 16, nu = 32 / dil, res = w / nu, n = w % nu;
                const bf16_t* base = Z + ((size_t)b * SEQ + res) * 2560 + h * 64;
                const long ld = 2560L * dil;
                f32x16 o[2]; float mr, lr;
                attn_core<64, 64, 64, true, true, true, 1, false>(lds, base, ld, base + 512, ld, base + 512, ld, base + 1024, ld, 256 * n, (4 * n - 2 < 0) ? 0 : 4 * n - 2, 4 * n + 4, 128, o, mr, lr);
                const float inv = 1.0f / lr;
                const int qrow = 256 * n + wave * 32 + r32;
                const size_t tok = (size_t)b * SEQ + res + (size_t)qrow * dil;
                bf16_t* op = OA + (size_t)gp * T * 512 + tok * 512 + h * 64;
#pragma unroll
                for (int d = 0; d < 2; ++d)
#pragma unroll
                    for (int i = 0; i < 4; ++i) { u32x2 wv; wv.x = pk2(o[d][4 * i] * inv, o[d][4 * i + 1] * inv); wv.y = pk2(o[d][4 * i + 2] * inv, o[d][4 * i + 3] * inv);
                        *(u32x2*)(op + 32 * d + 8 * i + 4 * hi) = wv; }
                if (hi == 0) LSE[(size_t)gp * T * 8 + tok * 8 + h] = mr + __builtin_amdgcn_logf(lr);
            }
            const float* cw = TOG(const float, args.in[14]); const float* cb = TOG(const float, args.in[15]); const float* lg = TOG(const float, args.in[16]); const float* lb = TOG(const float, args.in[17]);
            LAS float* gl = (LAS float*)lds;
            for (int cu = bid; cu < T / 32; cu += G) {
                const int t0 = cu * 32, bstart = (t0 / SEQ) * SEQ;
                for (int e = tid; e < 62 * 64; e += 512) {
                    const int row = e >> 6, ch = e & 63, tk = t0 - 30 + row;
                    f32x4 g0 = {0.f, 0.f, 0.f, 0.f}, g1 = g0;
                    if (tk >= bstart) {
                        const u32x4 uu = *(const u32x4*)(Z + (size_t)tk * 2560 + 1536 + ch * 8), gg = *(const u32x4*)(Z + (size_t)tk * 2560 + 2048 + ch * 8);
#pragma unroll
                        for (int q = 0; q < 4; ++q) {
                            const float u0 = bf2f(uu[q] & 0xffffu), u1 = bf2f(uu[q] >> 16), a0 = bf2f(gg[q] & 0xffffu), a1 = bf2f(gg[q] >> 16);
                            const float r0 = u0 * __builtin_amdgcn_rcpf(1.f + __expf(-a0)), r1 = u1 * __builtin_amdgcn_rcpf(1.f + __expf(-a1));
                            if (q < 2) { g0[2 * q] = r0; g0[2 * q + 1] = r1; } else { g1[2 * (q - 2)] = r0; g1[2 * (q - 2) + 1] = r1; }
                        }
                    }
                    *(LAS f32x4*)(gl + row * 512 + ch * 8) = g0; *(LAS f32x4*)(gl + row * 512 + ch * 8 + 4) = g1;
                }
                __syncthreads();
                {
                    float wv[31];
#pragma unroll
                    for (int j = 0; j < 31; ++j) wv[j] = cw[j * 512 + tid];
                    const float bias = cb[tid];
                    float res[32];
#pragma unroll
                    for (int blk = 0; blk < 4; ++blk) {
                        float in[38];
#pragma unroll
                        for (int j = 0; j < 38; ++j) in[j] = gl[(blk * 8 + j) * 512 + tid];
#pragma unroll
                        for (int i = 0; i < 8; ++i) { float a = bias;
#pragma unroll
                            for (int j = 0; j < 31; ++j) a += wv[j] * in[i + j];
                            res[blk * 8 + i] = a; }
                        __builtin_amdgcn_sched_barrier(0);
                    }
#pragma unroll
                    for (int i = 0; i < 32; ++i) gl[i * 512 + tid] = res[i];
                }
                __syncthreads();
#pragma unroll
                for (int k = 0; k < 4; ++k) {
                    const int tr = wave * 4 + k;
                    const f32x4 a = *(LAS f32x4*)(gl + tr * 512 + lane * 8), c = *(LAS f32x4*)(gl + tr * 512 + lane * 8 + 4);
                    const float mu = wave_sum((a.x + a.y) + (a.z + a.w) + (c.x + c.y) + (c.z + c.w)) * (1.f / 512.f);
                    const f32x4 da = a - mu, dc = c - mu;
                    const float var = wave_sum((da.x * da.x + da.y * da.y) + (da.z * da.z + da.w * da.w) + (dc.x * dc.x + dc.y * dc.y) + (dc.z * dc.z + dc.w * dc.w)) * (1.f / 512.f);
                    const float rstd = 1.0f / sqrtf(var + EPS);
                    const f32x4 ga = *(const f32x4*)(lg + lane * 8), gc = *(const f32x4*)(lg + lane * 8 + 4), ba = *(const f32x4*)(lb + lane * 8), bc = *(const f32x4*)(lb + lane * 8 + 4);
                    f32x4 ya = da * rstd * ga + ba, yc = dc * rstd * gc + bc;
#pragma unroll
                    for (int e = 0; e < 4; ++e) { ya[e] = ya[e] * __builtin_amdgcn_rcpf(1.f + __expf(-ya[e])); yc[e] = yc[e] * __builtin_amdgcn_rcpf(1.f + __expf(-yc[e])); }
                    u32x4 wv; wv.x = pk2(ya[0], ya[1]); wv.y = pk2(ya[2], ya[3]); wv.z = pk2(yc[0], yc[1]); wv.w = pk2(yc[2], yc[3]);
                    *(u32x4*)(Y + (size_t)(t0 + tr) * 1024 + 512 + lane * 8) = wv;
                }
                __syncthreads();
            }
        }
        if (ph == 3 && (PHMASK & 16)) {
            for (size_t i = (size_t)bid * 512 + tid; i < (size_t)T * 64; i += (size_t)G * 512) {
                const size_t tok = i >> 6; const int ch = (int)(i & 63), h = ch >> 3;
                const float l0 = LSE[tok * 8 + h], l1 = LSE[(size_t)T * 8 + tok * 8 + h], l2 = LSE[(size_t)2 * T * 8 + tok * 8 + h];
                const float mx = fmaxf(l0, fmaxf(l1, l2));
                float w0 = __builtin_amdgcn_exp2f(l0 - mx), w1 = __builtin_amdgcn_exp2f(l1 - mx), w2 = __builtin_amdgcn_exp2f(l2 - mx);
                const float inv = 1.0f / (w0 + w1 + w2); w0 *= inv; w1 *= inv; w2 *= inv;
                const u32x4 a = *(const u32x4*)(OA + tok * 512 + ch * 8), b = *(const u32x4*)(OA + (size_t)T * 512 + tok * 512 + ch * 8), c = *(const u32x4*)(OA + (size_t)2 * T * 512 + tok * 512 + ch * 8);
                u32x4 r;
#pragma unroll
                for (int q = 0; q < 4; ++q) {
                    const float lo = w0 * bf2f(a[q] & 0xffffu) + w1 * bf2f(b[q] & 0xffffu) + w2 * bf2f(c[q] & 0xffffu);
                    const float hh = w0 * bf2f(a[q] >> 16) + w1 * bf2f(b[q] >> 16) + w2 * bf2f(c[q] >> 16);
                    r[q] = pk2(lo, hh);
                }
                *(u32x4*)(Y + tok * 1024 + ch * 8) = r;
            }
        }
        if ((PHMASK & 32) && (ph == 6 || ph == 15)) {
            const int r32 = lane & 31, hi = lane >> 5;
            const bf16_t* KVl = KVMEM + (size_t)layer * 1024 * 1024;
            for (int u = vcu; u < 512; u += G) {
                const int bh = u >> 5, qb = u & 31, b = bh >> 2, h = bh & 3;
                const bf16_t* qp = QX + (size_t)b * SEQ * 512 + h * 128;
                const bf16_t* kp = KVl + (size_t)b * 256 * 1024 + h * 128;
                f32x16 o[4]; float mr, lr;
                attn_core<128, 128, 128, false, false, false, 1, false>(lds, qp, 512, kp, 1024, kp, 1024, kp + 512, 1024, 256 * qb, 0, 4, 1 << 30, o, mr, lr);
                const float inv = 1.0f / lr;
                bf16_t* op = OX + ((size_t)b * SEQ + 256 * qb + wave * 32 + r32) * 512 + h * 128;
#pragma unroll
                for (int d = 0; d < 4; ++d)
#pragma unroll
                    for (int i = 0; i < 4; ++i) { u32x2 wv; wv.x = pk2(o[d][4 * i] * inv, o[d][4 * i + 1] * inv); wv.y = pk2(o[d][4 * i + 2] * inv, o[d][4 * i + 3] * inv);
                        *(u32x2*)(op + 32 * d + 8 * i + 4 * hi) = wv; }
            }
        }
        if (ph == 12 && (PHMASK & 64)) {
            const int r32 = lane & 31, hi = lane >> 5;
            const float lam = MISC[0], osc = 0.64449093240903f;
            const float* sg = TOG(const float, args.in[24]);
#ifndef NO_C
            for (int p = vcu; p < 256; p += G) {
                const int bh = p >> 4, s = p & 15, b = bh >> 2, h = bh & 3;
                for (int half = 0; half < 2; ++half) {
                    const int qb = half ? 31 - s : s;
                    const size_t row = (size_t)b * SEQ + 256 * qb + wave * 32 + r32;
                    for (int mp = 0; mp < 2; ++mp) {
                        const bf16_t* zb = Z + (size_t)b * SEQ * 2304 + h * 128;
                        f32x16 o[4]; float mr, lr;
                        attn_core<64, 64, 128, true, false, true, 1, false>(lds, zb + mp * 64, 2304, zb + 512 + mp * 64, 2304, zb, 2304, zb + 1024, 2304, 256 * qb, 0, 4 * qb + 4, 1 << 30, o, mr, lr);
                        const float inv = 1.0f / lr;
                        float* sp = O1S + row * 512 + h * 128;
                        if (mp == 0) {
#pragma unroll
                            for (int d = 0; d < 4; ++d) {
#pragma unroll
                                for (int i = 0; i < 4; ++i) *(f32x4*)(sp + 32 * d + 8 * i + 4 * hi) = (f32x4){o[d][4 * i] * inv, o[d][4 * i + 1] * inv, o[d][4 * i + 2] * inv, o[d][4 * i + 3] * inv};
                                __builtin_amdgcn_sched_barrier(0); }
                        } else {
                            float ss = 0.f;
#pragma unroll
                            for (int d = 0; d < 4; ++d) {
#pragma unroll
                                for (int i = 0; i < 4; ++i) { const f32x4 a1 = *(const f32x4*)(sp + 32 * d + 8 * i + 4 * hi);
#pragma unroll
                                    for (int e = 0; e < 4; ++e) { const float dv = a1[e] - lam * (o[d][4 * i + e] * inv); o[d][4 * i + e] = dv; ss += dv * dv; } }
                                __builtin_amdgcn_sched_barrier(0); }
                            ss += __shfl_xor(ss, 32);
                            const float rn = osc / sqrtf(ss * (1.f / 128.f) + EPS);
                            bf16_t* op = Y + row * 1024 + h * 128;
#pragma unroll
                            for (int d = 0; d < 4; ++d) {
#pragma unroll
                                for (int i = 0; i < 4; ++i) { const f32x4 gg = *(const f32x4*)(sg + 32 * d + 8 * i + 4 * hi);
                                    u32x2 wv; wv.x = pk2(o[d][4 * i] * rn * gg[0], o[d][4 * i + 1] * rn * gg[1]); wv.y = pk2(o[d][4 * i + 2] * rn * gg[2], o[d][4 * i + 3] * rn * gg[3]);
                                    *(u32x2*)(op + 32 * d + 8 * i + 4 * hi) = wv; }
                                __builtin_amdgcn_sched_barrier(0); }
                        }
                    }
                }
            }
#endif
#ifndef NO_D
            for (int p = vcu; p < 512; p += G) {
                const int bh = p >> 4, s = p & 15, b = bh >> 3, h = bh & 7;
                for (int half = 0; half < 2; ++half) {
                    const int qb = half ? 31 - s : s;
                    const size_t row = (size_t)b * SEQ + 256 * qb + wave * 32 + r32;
                    f32x16 o[2]; float mr, lr;
                    attn_core<96, 64, 64, true, true, true, 1, false>(lds, QD + (size_t)b * SEQ * 768 + h * 96, 768, KVD + (size_t)b * SEQ * 1024 + h * 64, 1024, Z + (size_t)b * SEQ * 2304 + 2176, 2304,
                                                KVD + (size_t)b * SEQ * 1024 + 512 + h * 64, 1024, 256 * qb, 0, 4 * qb + 4, 1 << 30, o, mr, lr);
                    const float inv = 1.0f / lr;
                    bf16_t* op = Y + row * 1024 + 512 + h * 64;
#pragma unroll
                    for (int d = 0; d < 2; ++d)
#pragma unroll
                        for (int i = 0; i < 4; ++i) { u32x2 wv; wv.x = pk2(o[d][4 * i] * inv, o[d][4 * i + 1] * inv); wv.y = pk2(o[d][4 * i + 2] * inv, o[d][4 * i + 3] * inv);
                            *(u32x2*)(op + 32 * d + 8 * i + 4 * hi) = wv; }
                }
            }
#endif
        }
        if (ph == 19 && (PHMASK & 128)) {
            const float* fg = TOG(const float, args.in[30]);
            for (int m = gw; m < T; m += NGW) {
                float s = (lane < 16) ? SSQX[(size_t)m * 16 + lane] : 0.f;
                s = wave_sum(s);
                const float r = 1.0f / sqrtf(s * (1.f / D) + EPS);
                const u32x2* xr = (const u32x2*)(XB + (size_t)m * D) + lane; f32x4* orow = (f32x4*)(outp + (size_t)m * D) + lane; const f32x4* gr = (const f32x4*)fg + lane;
#pragma unroll
                for (int j = 0; j < 4; ++j) { const u32x2 w = xr[64 * j]; const f32x4 gg = gr[64 * j];
                    const f32x4 v = {bf2f(w.x & 0xffffu), bf2f(w.x >> 16), bf2f(w.y & 0xffffu), bf2f(w.y >> 16)}; orow[64 * j] = v * r * gg; }
            }
        }
        if (ph + 1 < args.ph_hi) {
            if (!posted) { grid.sync(); xbar = xcd_barrier_post(barw, bst); posted = true; }
            else xcd_barrier(xbar);
        }
        if (DUPMASK != 0) { if (((DUPMASK >> ph) & 1) && !rep) { rep = 1; --ph; } else rep = 0; }
    }
}

#ifndef MK_SPLIT
#define MK_SPLIT 0
#endif
extern "C" void kernel_launch(void* const* d_in, const int* in_sizes, int n_in, void* d_out, int out_size, void* d_ws, size_t ws_size, hipStream_t stream) {
    static int grid = 0;
    if (grid == 0) {
        if (n_in != 31 || ws_size < WS_END) { fprintf(stderr, "kernel_launch: unexpected n_in %d / ws %zu\n", n_in, ws_size); grid = -1; return; }
        int dev = 0, cus = 0, per_cu = 0;
        hipGetDevice(&dev);
        hipDeviceGetAttribute(&cus, hipDeviceAttributeMultiprocessorCount, dev);
        if (hipFuncSetAttribute((const void*)mk_fwd, hipFuncAttributeMaxDynamicSharedMemorySize, LDS_BYTES) != hipSuccess) { fprintf(stderr, "kernel_launch: hipFuncSetAttribute failed\n"); }
        if (hipOccupancyMaxActiveBlocksPerMultiprocessor(&per_cu, (const void*)mk_fwd, 512, LDS_BYTES) != hipSuccess || per_cu < 1) { fprintf(stderr, "kernel_launch: occupancy query gave %d\n", per_cu); per_cu = 1; }
        (void)hipGetLastError();
        grid = cus * per_cu;
        if (grid > 256) grid = 256;
        fprintf(stderr, "kernel_launch: grid %d (cus %d per_cu %d)\n", grid, cus, per_cu);
    }
    if (grid < 0) return;
    Args a{};
    for (int i = 0; i < 31; ++i) a.in[i] = d_in[i];
    a.out = (float*)d_out; a.ws = (unsigned char*)d_ws;
#if MK_SPLIT
    for (int ph = 0; ph < 20; ++ph) { a.ph_lo = ph; a.ph_hi = ph + 1; hipLaunchKernelGGL(mk_fwd, dim3(grid), dim3(512), LDS_BYTES, stream, a); }
#else
    a.ph_lo = 0; a.ph_hi = 20;
    void* kargs[] = {&a};
    hipError_t e = hipLaunchCooperativeKernel((const void*)mk_fwd, dim3(grid), dim3(512), kargs, LDS_BYTES, stream);
    if (e != hipSuccess) fprintf(stderr, "cooperative launch failed: %s (grid %d)\n", hipGetErrorString(e), grid);
#endif
}
```

```cpp
#include <hip/hip_runtime.h>
#include <hip/hip_cooperative_groups.h>
#include <cstdio>
#include <cstdint>
namespace cg = cooperative_groups;

#define LAS __attribute__((address_space(3)))
#define GAS __attribute__((address_space(1)))
#define TOG(T, p) ((T*)(GAS T*)(p))
typedef unsigned short bf16_t;
typedef short bf16x8 __attribute__((ext_vector_type(8)));
typedef short s16x4 __attribute__((ext_vector_type(4)));
typedef float f32x4 __attribute__((ext_vector_type(4)));
typedef float f32x16 __attribute__((ext_vector_type(16)));
typedef unsigned u32x4 __attribute__((ext_vector_type(4)));
typedef unsigned u32x2 __attribute__((ext_vector_type(2)));
typedef float f32x2_t __attribute__((ext_vector_type(2)));
typedef __bf16 bf16x2_t __attribute__((ext_vector_type(2)));

__device__ __forceinline__ unsigned pk2(float lo, float hi) { f32x2_t v = {lo, hi}; bf16x2_t b = __builtin_convertvector(v, bf16x2_t); return __builtin_bit_cast(unsigned, b); }
__device__ __forceinline__ float bf2f(unsigned h) { return __uint_as_float(h << 16); }

__device__ __forceinline__ float xsum16_32(float v) {
    { auto r = __builtin_amdgcn_permlane16_swap(__float_as_uint(v), __float_as_uint(v), false, false); v = __uint_as_float(r[0]) + __uint_as_float(r[1]); }
    { auto r = __builtin_amdgcn_permlane32_swap(__float_as_uint(v), __float_as_uint(v), false, false); v = __uint_as_float(r[0]) + __uint_as_float(r[1]); }
    return v;
}

constexpr int NB = 4, SEQ = 8192, T = NB * SEQ, D = 1024;
constexpr float EPS = 1e-6f;
constexpr float LOG2E = 1.4426950408889634f;
constexpr float NEGBIG = -1e30f;

constexpr size_t MiB = 1u << 20;
constexpr size_t WS_W = 0, WS_XB = 56 * MiB, WS_BIG = 120 * MiB, WS_Y = 376 * MiB, WS_SMALL = 440 * MiB;
constexpr size_t WS_KVMEM = WS_SMALL, WS_MN = WS_SMALL + 4 * MiB, WS_SSQX = WS_SMALL + 8 * MiB, WS_SSQZ = WS_SMALL + 10 * MiB,
                 WS_ROPE = WS_SMALL + 20 * MiB, WS_LSE = WS_SMALL + 24 * MiB, WS_MISC = WS_SMALL + 28 * MiB, WS_END = WS_SMALL + 29 * MiB;
constexpr size_t M1 = 1048576;
constexpr size_t LW = 10 * M1, OW_Q = 0, OW_KV = M1 / 2, OW_O = M1 + M1 / 2, OW_1 = 2 * M1, OW_2 = 6 * M1;
constexpr size_t OW_ABIN = 20 * M1, OW_ABOUT = OW_ABIN + 2560 * 1024, OW_CDIN = OW_ABOUT + M1, OW_CDOUT = OW_CDIN + 2304 * 1024,
                 OW_UQ = OW_CDOUT + M1, OW_UKV = OW_UQ + 768 * 384, OW_END = OW_UKV + 1024 * 256;
static_assert(OW_END * 2 <= 56 * MiB, "weights");
constexpr size_t OB_Z = 0;
constexpr size_t OB_OA = 160 * MiB;
constexpr size_t OB_QD = 144 * MiB;
constexpr size_t OB_KVD = 192 * MiB;
constexpr size_t OB_H = 0;

constexpr int LDS_BYTES = 147456;
#ifndef PHMASK
#define PHMASK 0xFF
#endif
#ifndef DUPMASK
#define DUPMASK 0
#endif

namespace pg8 {
constexpr int BM = 256, BK = 64, HALF = 128, HTB = HALF * BK * 2, STAGE_BYTES = 8 * HTB, NXCD = 8, WGM = 8;
__host__ __device__ __forceinline__ int lds_byte(int r, int c) { const int st = (r >> 4) * 2 + (c >> 5), rr = r & 15, cc = c & 31, ob = rr * 64 + cc * 2; return st * 1024 + (ob ^ (((ob >> 9) & 1) << 5)); }
__host__ __device__ __forceinline__ void stage_rc(int b, int& R, int& C) { const int st = b / 1024, sb = b % 1024, swz = sb ^ (((sb >> 9) & 1) << 5); R = (st >> 1) * 16 + swz / 64; C = (st & 1) * 32 + (swz % 64) / 2; }
__host__ __device__ __forceinline__ int perm32(int rho) { const int n = rho >> 4, i = rho & 15; return 8 * (i >> 2) + 4 * n + (i & 3); }

struct Unit { int pm, pn; };
struct Gemm { const bf16_t* A; const bf16_t* Bt; int M, N, K, lda; };

struct StaticOrder {
    int nM, nN, nwg, G, c;
    __device__ void init(int M, int N, int G_, int c_) { nM = M / BM; nN = N / BM; nwg = nM * nN; G = G_; c = c_; }
    __device__ bool next(int i, Unit& u) const {
        const long L = (long)i * G + c; if (L >= nwg) return false;
        int wgid = (int)L; { const int q = nwg / NXCD, r = nwg % NXCD, xcd = wgid % NXCD, off = wgid / NXCD; wgid = (xcd < r ? xcd * (q + 1) : r * (q + 1) + (xcd - r) * q) + off; }
        const int nig = WGM * nN, gid = wgid / nig, fm = gid * WGM, gsz = (nM - fm) < WGM ? (nM - fm) : WGM;
        u.pm = fm + ((wgid % nig) % gsz); u.pn = (wgid % nig) / gsz; return true;
    }
};


struct EpiZ {
    static constexpr bool PERM = true;
    bf16_t* O; int ldc;
    const float* rs; int rs_stride, rs_off, rs_n4; float rs_inv;
    LAS float* rtab;
    int qs_end; float qscale;
    int act;
    int rope, rope_g;
    const float* rcos; const float* rsin;
    float* ssq; int ssq_stride;
    __device__ __forceinline__ void operator()(const f32x4 (&acc)[2][2][4][2], const Unit& u, int wr, int wc, int fr, int fq) const {
        const int row0 = u.pm * BM + wr * 64 + fr;
        if (rs) {
            int t_ = threadIdx.x; asm volatile("" : "+v"(t_));
            const int rr_ = t_ >> 1, hh_ = t_ & 1;
            f32x4 s = {0.f, 0.f, 0.f, 0.f}; const float* p = rs + (size_t)(u.pm * BM + rr_) * rs_stride + rs_off;
            for (int k = hh_; k < rs_n4; k += 2) s += *(const f32x4*)(p + 4 * k);
            float tot = (s.x + s.y) + (s.z + s.w); tot += __shfl_xor(tot, 1);
            if (hh_ == 0) rtab[rr_] = __builtin_amdgcn_rsqf(tot * rs_inv + EPS);
            asm volatile("s_waitcnt lgkmcnt(0)" ::: "memory"); __builtin_amdgcn_s_barrier(); asm volatile("" ::: "memory");
        }
#pragma unroll
        for (int ai = 0; ai < 2; ++ai)
#pragma unroll
            for (int m = 0; m < 4; ++m) {
                const int row = row0 + ai * HALF + m * 16;
                const float r = rs ? rtab[wr * 64 + fr + ai * HALF + m * 16] : 1.f;
#pragma unroll
                for (int bj = 0; bj < 2; ++bj) {
                    const int colg = u.pn * BM + bj * HALF + wc * 32, gidx = colg >> 5, col = colg + 8 * fq;
                    f32x4 v0 = acc[ai][bj][m][0] * r, v1 = acc[ai][bj][m][1] * r;
                    if (act == 1) {
#pragma unroll
                        for (int e = 0; e < 4; ++e) { float a = fmaxf(v0[e], 0.f), b = fmaxf(v1[e], 0.f); v0[e] = a * a; v1[e] = b * b; }
                    }
                    if (ssq) {
                        float ss = (v0[0] * v0[0] + v0[1] * v0[1]) + (v0[2] * v0[2] + v0[3] * v0[3]) + (v1[0] * v1[0] + v1[1] * v1[1]) + (v1[2] * v1[2] + v1[3] * v1[3]);
                        ss = xsum16_32(ss);
                        if (fq == 0) ssq[(size_t)row * ssq_stride + gidx] = ss;
                    }
                    if (colg < qs_end) { v0 = v0 * qscale; v1 = v1 * qscale; }
                    const bool rg = (rope == 1) ? (gidx == rope_g) : ((rope == 2) ? (gidx % 3 == 2) : false);
                    if (rg) {
                        const int ci = 8 * (fq & 1);
                        const f32x4 c0 = *(const f32x4*)(rcos + (size_t)row * 16 + ci), c1 = *(const f32x4*)(rcos + (size_t)row * 16 + ci + 4);
                        const f32x4 s0 = *(const f32x4*)(rsin + (size_t)row * 16 + ci), s1 = *(const f32x4*)(rsin + (size_t)row * 16 + ci + 4);
                        const float sg = (fq < 2) ? -1.f : 1.f;
#pragma unroll
                        for (int e = 0; e < 4; ++e) {
                            const float p0 = __shfl_xor(v0[e], 32), p1 = __shfl_xor(v1[e], 32);
                            v0[e] = v0[e] * c0[e] + sg * p0 * s0[e];
                            v1[e] = v1[e] * c1[e] + sg * p1 * s1[e];
                        }
                    }
                    u32x4 w; w.x = pk2(v0[0], v0[1]); w.y = pk2(v0[2], v0[3]); w.z = pk2(v1[0], v1[1]); w.w = pk2(v1[2], v1[3]);
                    *(u32x4*)(O + (size_t)row * ldc + col) = w;
                }
                __builtin_amdgcn_sched_barrier(0);
            }
    }
};
struct EpiRes {
    static constexpr bool PERM = true;
    const bf16_t* base16; bf16_t* xb; float* ssq;
    __device__ __forceinline__ void operator()(const f32x4 (&acc)[2][2][4][2], const Unit& u, int wr, int wc, int fr, int fq) const {
        const int row0 = u.pm * BM + wr * 64 + fr;
        const size_t col0 = (size_t)u.pn * BM + wc * 32 + 8 * fq;
#pragma unroll
        for (int ai = 0; ai < 2; ++ai) {
            u32x4 bw[4][2];
#pragma unroll
            for (int m = 0; m < 4; ++m)
#pragma unroll
                for (int bj = 0; bj < 2; ++bj) bw[m][bj] = *(const u32x4*)(base16 + (size_t)(row0 + ai * HALF + m * 16) * D + col0 + bj * HALF);
            __builtin_amdgcn_sched_barrier(0);
#pragma unroll
            for (int m = 0; m < 4; ++m) {
                const int row = row0 + ai * HALF + m * 16; float ss = 0.f;
#pragma unroll
                for (int bj = 0; bj < 2; ++bj) {
                    const u32x4 b_ = bw[m][bj];
                    const f32x4 b0 = {bf2f(b_.x & 0xffffu), bf2f(b_.x >> 16), bf2f(b_.y & 0xffffu), bf2f(b_.y >> 16)};
                    const f32x4 b1 = {bf2f(b_.z & 0xffffu), bf2f(b_.z >> 16), bf2f(b_.w & 0xffffu), bf2f(b_.w >> 16)};
                    const f32x4 v0 = b0 + acc[ai][bj][m][0], v1 = b1 + acc[ai][bj][m][1];
                    u32x4 w; w.x = pk2(v0[0], v0[1]); w.y = pk2(v0[2], v0[3]); w.z = pk2(v1[0], v1[1]); w.w = pk2(v1[2], v1[3]);
                    *(u32x4*)(xb + (size_t)row * D + col0 + bj * HALF) = w;
                    ss += ((v0[0] * v0[0] + v0[1] * v0[1]) + (v0[2] * v0[2] + v0[3] * v0[3])) + ((v1[0] * v1[0] + v1[1] * v1[1]) + (v1[2] * v1[2] + v1[3] * v1[3]));
                }
                ss = xsum16_32(ss);
                if (fq == 0) ssq[(size_t)row * 16 + u.pn * 4 + wc] = ss;
            }
        }
    }
};

template <class Epi>
__device__ __forceinline__ void gemm_phase(LAS unsigned char* lds, const Gemm g, const StaticOrder& S, const Epi& E) {
    int tid = threadIdx.x; asm volatile("" : "+v"(tid));
    const int wid = __builtin_amdgcn_readfirstlane(tid >> 6), lane = tid & 63, wr = wid >> 2, wc = wid & 3, fr = lane & 15, fq = lane >> 4;
    const int K = g.K, nt = K / BK, lda = g.lda;
    unsigned voffA[2], voffB[2];
#pragma unroll
    for (int i = 0; i < 2; ++i) { int R, C; stage_rc(tid * 16 + i * 8192, R, C); const int Rb = Epi::PERM ? ((R & ~31) + perm32(R & 31)) : R;
        voffA[i] = (unsigned)(R * lda + C) * 2u; voffB[i] = (unsigned)(Rb * K + C) * 2u; }
    const size_t kstep = (size_t)(BK * 2);
    const size_t hstepA = (size_t)HALF * lda * 2, hstepB = (size_t)HALF * K * 2;
    const size_t tstepA = 2 * hstepA, tstepB = 2 * hstepB;
    const unsigned ldsw = (unsigned)wid * 1024u;
    const int aoff = lds_byte(wr * 64 + fr, fq * 8), boff = lds_byte(wc * 32 + fr, fq * 8);
#define PG8_SA(b, h) (((b) * 2 + (h)) * HTB)
#define PG8_SB(b, h) ((4 + (b) * 2 + (h)) * HTB)
#define PG8_STAGE(bufoff, gbase, voff) do { _Pragma("unroll") for (int _i = 0; _i < 2; ++_i) \
        __builtin_amdgcn_global_load_lds((const unsigned*)((const char*)(gbase) + (voff)[_i]), (LAS unsigned*)(lds + (bufoff) + ldsw + _i * 8192), 16, 0, 0); } while (0)
#define PG8_LDA(dst, b, h) do { _Pragma("unroll") for (int m = 0; m < 4; ++m) _Pragma("unroll") for (int k = 0; k < 2; ++k) dst[m][k] = *(const LAS bf16x8*)(lds + PG8_SA(b, h) + aoff + m * 2048 + k * 1024); } while (0)
#define PG8_LDB(dst, b, h) do { _Pragma("unroll") for (int n = 0; n < 2; ++n) _Pragma("unroll") for (int k = 0; k < 2; ++k) dst[n][k] = *(const LAS bf16x8*)(lds + PG8_SB(b, h) + boff + n * 2048 + k * 1024); } while (0)
#define PG8_MMA(ai, bj, At, Bt) do { __builtin_amdgcn_s_setprio(1); _Pragma("unroll") for (int m = 0; m < 4; ++m) _Pragma("unroll") for (int n = 0; n < 2; ++n) _Pragma("unroll") for (int k = 0; k < 2; ++k) \
        acc[ai][bj][m][n] = __builtin_amdgcn_mfma_f32_16x16x32_bf16(Bt[n][k], At[m][k], acc[ai][bj][m][n], 0, 0, 0); __builtin_amdgcn_s_setprio(0); } while (0)
#define PG8_WAIT_V(n) asm volatile("s_waitcnt vmcnt(" #n ")" ::: "memory")
#define PG8_WAIT_L(n) asm volatile("s_waitcnt lgkmcnt(" #n ")" ::: "memory")
#define PG8_BAR __builtin_amdgcn_s_barrier()
#define PG8_SCHED __builtin_amdgcn_sched_barrier(0)
    Unit cur, nxt; int ui = 0;
    if (!S.next(0, cur)) return;
    f32x4 acc[2][2][4][2];
#pragma unroll
    for (int a = 0; a < 2; ++a)
#pragma unroll
        for (int b = 0; b < 2; ++b)
#pragma unroll
            for (int m = 0; m < 4; ++m)
#pragma unroll
                for (int n = 0; n < 2; ++n) acc[a][b][m][n] = (f32x4){0.f, 0.f, 0.f, 0.f};
    bf16x8 At[4][2], B0[2][2], B1[2][2];
    const char* cA = (const char*)g.A + (size_t)cur.pm * tstepA; const char* cB = (const char*)g.Bt + (size_t)cur.pn * tstepB;
    PG8_STAGE(PG8_SB(0, 0), cB, voffB); PG8_STAGE(PG8_SB(0, 1), cB + hstepB, voffB); PG8_STAGE(PG8_SA(0, 0), cA, voffA); PG8_STAGE(PG8_SA(0, 1), cA + hstepA, voffA);
    if (wr == 1) PG8_BAR;
    PG8_WAIT_V(2); PG8_BAR;
    PG8_STAGE(PG8_SB(1, 0), cB + kstep, voffB); PG8_STAGE(PG8_SA(1, 0), cA + kstep, voffA); PG8_STAGE(PG8_SB(1, 1), cB + hstepB + kstep, voffB);
    PG8_WAIT_V(6); PG8_BAR;
    for (;;) {
        const bool has_next = S.next(ui + 1, nxt);
        const char* nA = has_next ? (const char*)g.A + (size_t)nxt.pm * tstepA : cA; const char* nB = has_next ? (const char*)g.Bt + (size_t)nxt.pn * tstepB : cB;
        for (int t = 0; t < nt; t += 2) {
            const bool last = (t == nt - 2);
            const char* a1 = cA + (size_t)(t + 1) * kstep;
            const char* a2 = last ? nA : cA + (size_t)(t + 2) * kstep; const char* b2 = last ? nB : cB + (size_t)(t + 2) * kstep;
            const char* a3 = a2 + kstep; const char* b3 = b2 + kstep;
            PG8_LDB(B0, 0, 0); PG8_LDB(B1, 0, 1); PG8_SCHED; PG8_LDA(At, 0, 0); PG8_STAGE(PG8_SA(1, 1), a1 + hstepA, voffA);
            PG8_WAIT_V(8); PG8_WAIT_L(0); PG8_BAR; PG8_MMA(0, 0, At, B0); PG8_MMA(0, 1, At, B1); PG8_BAR; PG8_SCHED;
            PG8_LDA(At, 0, 1); PG8_STAGE(PG8_SB(0, 0), b2, voffB); PG8_STAGE(PG8_SB(0, 1), b2 + hstepB, voffB); PG8_STAGE(PG8_SA(0, 0), a2, voffA);
            PG8_WAIT_V(8); PG8_WAIT_L(0); PG8_BAR; PG8_MMA(1, 0, At, B0); PG8_MMA(1, 1, At, B1); PG8_BAR; PG8_SCHED;
            PG8_LDB(B0, 1, 0); PG8_LDB(B1, 1, 1); PG8_SCHED; PG8_LDA(At, 1, 0); PG8_STAGE(PG8_SA(0, 1), a2 + hstepA, voffA);
            PG8_WAIT_V(8); PG8_WAIT_L(0); PG8_BAR; PG8_MMA(0, 0, At, B0); PG8_MMA(0, 1, At, B1); PG8_BAR; PG8_SCHED;
            PG8_LDA(At, 1, 1); PG8_STAGE(PG8_SB(1, 0), b3, voffB); PG8_STAGE(PG8_SB(1, 1), b3 + hstepB, voffB); PG8_STAGE(PG8_SA(1, 0), a3, voffA);
            PG8_WAIT_V(8); PG8_WAIT_L(0); PG8_BAR; PG8_MMA(1, 0, At, B0); PG8_MMA(1, 1, At, B1); PG8_BAR; PG8_SCHED;
        }
        if (wr == 0) PG8_BAR;
        E(acc, cur, wr, wc, fr, fq);
        if (!has_next) break;
#pragma unroll
        for (int a = 0; a < 2; ++a)
#pragma unroll
            for (int b = 0; b < 2; ++b)
#pragma unroll
                for (int m = 0; m < 4; ++m)
#pragma unroll
                    for (int n = 0; n < 2; ++n) acc[a][b][m][n] = (f32x4){0.f, 0.f, 0.f, 0.f};
        cur = nxt; cA = nA; cB = nB; ++ui;
        if (wr == 1) PG8_BAR;
    }
    PG8_WAIT_V(0);
    PG8_BAR;
#undef PG8_SA
#undef PG8_SB
#undef PG8_STAGE
#undef PG8_LDA
#undef PG8_LDB
#undef PG8_MMA
#undef PG8_WAIT_V
#undef PG8_WAIT_L
#undef PG8_BAR
#undef PG8_SCHED
}
}

template <int VS, int D> __device__ __forceinline__ void tr_block(unsigned a, s16x4 (&l)[4], s16x4 (&h)[4]) {
    asm volatile("ds_read_b64_tr_b16 %0, %1 offset:%2" : "=v"(l[0]) : "v"(a), "i"(0 * VS + D * 64) : "memory");
    asm volatile("ds_read_b64_tr_b16 %0, %1 offset:%2" : "=v"(h[0]) : "v"(a), "i"(4 * VS + D * 64) : "memory");
    asm volatile("ds_read_b64_tr_b16 %0, %1 offset:%2" : "=v"(l[1]) : "v"(a), "i"(16 * VS + D * 64) : "memory");
    asm volatile("ds_read_b64_tr_b16 %0, %1 offset:%2" : "=v"(h[1]) : "v"(a), "i"(20 * VS + D * 64) : "memory");
    asm volatile("ds_read_b64_tr_b16 %0, %1 offset:%2" : "=v"(l[2]) : "v"(a), "i"(32 * VS + D * 64) : "memory");
    asm volatile("ds_read_b64_tr_b16 %0, %1 offset:%2" : "=v"(h[2]) : "v"(a), "i"(36 * VS + D * 64) : "memory");
    asm volatile("ds_read_b64_tr_b16 %0, %1 offset:%2" : "=v"(l[3]) : "v"(a), "i"(48 * VS + D * 64) : "memory");
    asm volatile("ds_read_b64_tr_b16 %0, %1 offset:%2" : "=v"(h[3]) : "v"(a), "i"(52 * VS + D * 64) : "memory");
}
#define TR_WAIT8(l, h) asm volatile("s_waitcnt lgkmcnt(8)" : "+v"(l[0]), "+v"(l[1]), "+v"(l[2]), "+v"(l[3]), "+v"(h[0]), "+v"(h[1]), "+v"(h[2]), "+v"(h[3]) :: "memory")
#define TR_WAIT0(l, h) asm volatile("s_waitcnt lgkmcnt(0)" : "+v"(l[0]), "+v"(l[1]), "+v"(l[2]), "+v"(l[3]), "+v"(h[0]), "+v"(h[1]), "+v"(h[2]), "+v"(h[3]) :: "memory")
#define PV4(d, l, h) do { _Pragma("unroll") for (int cc = 0; cc < 4; ++cc) { \
        const bf16x8 vf = (bf16x8){l[cc][0], l[cc][1], l[cc][2], l[cc][3], h[cc][0], h[cc][1], h[cc][2], h[cc][3]}; \
        o[d] = __builtin_amdgcn_mfma_f32_32x32x16_bf16(vf, __builtin_bit_cast(bf16x8, pw[cc]), o[d], 0, 0, 0); } } while (0)

__device__ __forceinline__ float fadd_s(float a, float b) { float r; asm("v_add_f32_e32 %0, %1, %2" : "=v"(r) : "v"(a), "v"(b)); return r; }
template <int DK, int DK1, int DV, bool MASK, bool NEGM = true, bool PF2 = false, int VAH = 1, bool SHIFT = false>
__device__ __forceinline__ void attn_core(LAS unsigned char* lds,
        const bf16_t* Qp, long ldq, const bf16_t* K1p, long ldk1, const bf16_t* K2p, long ldk2, const bf16_t* Vp, long ldv,
        int q0, int kt0, int kt1, int W, f32x16 (&o)[DV / 32], float& m_out, float& l_out) {
    constexpr int KS = DK * 2 + 16, VS = DV * 2 + 64, KBUF = 64 * KS, VBUF = 64 * VS;
    constexpr int KCH1 = DK1 / 8, NKC1 = 64 * KCH1, KPT1 = (NKC1 + 511) / 512, KCH2 = (DK - DK1) / 8, NKC2 = 64 * KCH2, KPT2 = (NKC2 + 511) / 512, KPT = KPT1 + KPT2;
    constexpr int VCH = DV / 8, NVC = 64 * VCH, VPT = (NVC + 511) / 512;
    static_assert(3 * KBUF + 3 * VBUF <= 131072, "attn lds");
    int tid = threadIdx.x; asm volatile("" : "+v"(tid));
    const int lane = tid & 63, wid = __builtin_amdgcn_readfirstlane(tid >> 6), r32 = lane & 31, hi = lane >> 5;
    LAS unsigned char* kbuf = lds; LAS unsigned char* vbuf = lds + 3 * KBUF;
    const int qlo = q0 + wid * 32, qrow = qlo + r32;
    bf16x8 qf[DK / 16];
#pragma unroll
    for (int c = 0; c < DK / 16; ++c) qf[c] = *(const bf16x8*)(Qp + (long)qrow * ldq + 16 * c + 8 * hi);
#pragma unroll
    for (int d = 0; d < DV / 32; ++d) o[d] = f32x16{};
    float mrun = 0.f, lrun = 0.f;
    u32x4 kreg0[KPT], vreg0[VPT], kreg1[KPT], vreg1[VPT];
#pragma unroll
    for (int i = 0; i < KPT; ++i) { kreg0[i] = (u32x4){0u, 0u, 0u, 0u}; kreg1[i] = kreg0[i]; }
#pragma unroll
    for (int i = 0; i < VPT; ++i) { vreg0[i] = (u32x4){0u, 0u, 0u, 0u}; vreg1[i] = vreg0[i]; }
    unsigned kgo[KPT], vgo[VPT]; int klo_[KPT], vlo_[VPT];
#pragma unroll
    for (int i = 0; i < KPT1; ++i) { const int e = (tid + 512 * i) % NKC1, row = e / KCH1, ch = e % KCH1; kgo[i] = (unsigned)(row * (int)ldk1 + ch * 8) * 2u; klo_[i] = row * KS + ch * 16; }
#pragma unroll
    for (int i = 0; i < KPT2; ++i) { const int e = (tid + 512 * i) % (NKC2 ? NKC2 : 1), row = e / (KCH2 ? KCH2 : 1), ch = e % (KCH2 ? KCH2 : 1); kgo[KPT1 + i] = (unsigned)(row * (int)ldk2 + ch * 8) * 2u; klo_[KPT1 + i] = row * KS + (KCH1 + ch) * 16; }
#pragma unroll
    for (int i = 0; i < VPT; ++i) { const int e = (tid + 512 * i) % NVC, row = e / VCH, ch = e % VCH; vgo[i] = (unsigned)(row * (int)ldv + ch * 8) * 2u; vlo_[i] = row * VS + ch * 16; }
#define ATT_LOAD(t, kreg, vreg) do { \
    const char* k1t_ = (const char*)(K1p + 64L * (t) * ldk1); const char* k2t_ = (const char*)(K2p + 64L * (t) * ldk2); const char* vt_ = (const char*)(Vp + 64L * (t) * ldv); \
    _Pragma("unroll") for (int i_ = 0; i_ < KPT1; ++i_) { kreg[i_] = *(const u32x4*)(k1t_ + (size_t)kgo[i_]); } \
    _Pragma("unroll") for (int i_ = 0; i_ < KPT2; ++i_) { kreg[KPT1 + i_] = *(const u32x4*)(k2t_ + (size_t)kgo[KPT1 + i_]); } \
    _Pragma("unroll") for (int i_ = 0; i_ < VPT; ++i_) { vreg[i_] = *(const u32x4*)(vt_ + (size_t)vgo[i_]); } } while (0)
#define ATT_STORE(b) do { \
    _Pragma("unroll") for (int i_ = 0; i_ < KPT1; ++i_) { if ((NKC1 % 512 == 0) || tid + 512 * i_ < NKC1) *(LAS u32x4*)(kbuf + (b) * KBUF + klo_[i_]) = kreg[i_]; } \
    _Pragma("unroll") for (int i_ = 0; i_ < KPT2; ++i_) { if ((NKC2 % 512 == 0) || tid + 512 * i_ < NKC2) *(LAS u32x4*)(kbuf + (b) * KBUF + klo_[KPT1 + i_]) = kreg[KPT1 + i_]; } \
    _Pragma("unroll") for (int i_ = 0; i_ < VPT; ++i_) { if ((NVC % 512 == 0) || tid + 512 * i_ < NVC) *(LAS u32x4*)(vbuf + (b) * VBUF + vlo_[i_]) = vreg[i_]; } } while (0)
#define ATT_STOREKV(kb_, vb_, kreg, vreg) do { \
    _Pragma("unroll") for (int i_ = 0; i_ < KPT1; ++i_) { if ((NKC1 % 512 == 0) || tid + 512 * i_ < NKC1) *(LAS u32x4*)(kbuf + (kb_) * KBUF + klo_[i_]) = kreg[i_]; } \
    _Pragma("unroll") for (int i_ = 0; i_ < KPT2; ++i_) { if ((NKC2 % 512 == 0) || tid + 512 * i_ < NKC2) *(LAS u32x4*)(kbuf + (kb_) * KBUF + klo_[KPT1 + i_]) = kreg[KPT1 + i_]; } \
    _Pragma("unroll") for (int i_ = 0; i_ < VPT; ++i_) { if ((NVC % 512 == 0) || tid + 512 * i_ < NVC) *(LAS u32x4*)(vbuf + (vb_) * VBUF + vlo_[i_]) = vreg[i_]; } } while (0)
    ATT_LOAD(kt0, kreg0, vreg0); ATT_STOREKV(0, 0, kreg0, vreg0);
    if (PF2) ATT_LOAD((kt0 + 1 < kt1 ? kt0 + 1 : kt1 - 1), kreg1, vreg1);
    __syncthreads();
    const int pr = (r32 & 0x13) | ((r32 & 8) >> 1) | ((r32 & 4) << 1);
    const int koff = pr * KS + hi * 16;
    const int voff = (8 * hi + ((lane & 15) >> 2)) * VS + (16 * ((lane >> 4) & 1) + 4 * (lane & 3)) * 2;
    int ta = kt0, tb = kt1;
    if (MASK) { int lo = (qlo - W) >> 6; if (qlo - W < 0) lo = 0; if (lo > ta) ta = lo; const int hi_t = ((qlo + 31) >> 6) + 1; if (hi_t < tb) tb = hi_t; }
    constexpr int NQ = 2 * (DK / 16), NPV = 4 * (DV / 32), VA = (36 + NQ - 1) / NQ, VC = 32 / NPV;
    f32x16 negm = f32x16{};
    f32x16 sA0 = f32x16{}, sA1 = f32x16{};
    u32x4 pw[4];
#pragma unroll
    for (int i = 0; i < 4; ++i) pw[i] = (u32x4){0u, 0u, 0u, 0u};
    s16x4 va_l[4], va_h[4], vb_l[4], vb_h[4];
#pragma unroll
    for (int i = 0; i < 4; ++i) { va_l[i] = (s16x4){0, 0, 0, 0}; va_h[i] = va_l[i]; vb_l[i] = va_l[i]; vb_h[i] = va_l[i]; }
    bool has_pend = false, started = false;
    int kb_cur = 0, vb_cur = 0, vb_prev = 0;
#define ATT_X1(t, S0, S1) do { if (doqk_) { \
                if (NEGM) { S0 = negm; S1 = negm; } else { S0 = f32x16{}; S1 = f32x16{}; } \
                const LAS unsigned char* kb = kbuf + kb_cur * KBUF + koff; \
                bf16x8 ka0 = *(const LAS bf16x8*)(kb), ka1 = *(const LAS bf16x8*)(kb + 32 * KS); \
                __builtin_amdgcn_s_setprio(1); \
                _Pragma("unroll") for (int c = 0; c < DK / 16; ++c) { \
                    bf16x8 kn0 = ka0, kn1 = ka1; \
                    if (c + 1 < DK / 16) { kn0 = *(const LAS bf16x8*)(kb + (c + 1) * 32); kn1 = *(const LAS bf16x8*)(kb + 32 * KS + (c + 1) * 32); } \
                    S0 = __builtin_amdgcn_mfma_f32_32x32x16_bf16(ka0, qf[c], S0, 0, 0, 0); \
                    S1 = __builtin_amdgcn_mfma_f32_32x32x16_bf16(ka1, qf[c], S1, 0, 0, 0); \
                    __builtin_amdgcn_sched_barrier(0); \
                    ka0 = kn0; ka1 = kn1; } \
                __builtin_amdgcn_s_setprio(0); \
                if (!NEGM) { _Pragma("unroll") for (int r = 0; r < 16; ++r) { S0[r] -= mrun; S1[r] -= mrun; } } \
            } } while (0)
#define ATT_X2(P0, P1) do { if (dopv_) { \
                float rs0_ = P0[0], rs1_ = P1[0], rs2_ = P0[1], rs3_ = P1[1]; \
                _Pragma("unroll") for (int r = 2; r < 16; r += 2) { rs0_ = fadd_s(rs0_, P0[r]); rs1_ = fadd_s(rs1_, P1[r]); rs2_ = fadd_s(rs2_, P0[r + 1]); rs3_ = fadd_s(rs3_, P1[r + 1]); } \
                lrun += (rs0_ + rs1_) + (rs2_ + rs3_); \
                u32x4 w; \
                w.x = pk2(P0[0], P0[1]); w.y = pk2(P0[2], P0[3]); w.z = pk2(P0[4], P0[5]); w.w = pk2(P0[6], P0[7]); pw[0] = w; \
                w.x = pk2(P0[8], P0[9]); w.y = pk2(P0[10], P0[11]); w.z = pk2(P0[12], P0[13]); w.w = pk2(P0[14], P0[15]); pw[1] = w; \
                w.x = pk2(P1[0], P1[1]); w.y = pk2(P1[2], P1[3]); w.z = pk2(P1[4], P1[5]); w.w = pk2(P1[6], P1[7]); pw[2] = w; \
                w.x = pk2(P1[8], P1[9]); w.y = pk2(P1[10], P1[11]); w.z = pk2(P1[12], P1[13]); w.w = pk2(P1[14], P1[15]); pw[3] = w; \
            } } while (0)
#define ATT_X3(t, S0, S1) do { if (doqk_) { \
                const int klo = 64 * (t); \
                if (MASK && ((klo + 63 > qlo) || (klo < qlo + 31 - W))) { \
                    const int rel = qrow - klo - 8 * hi, rel2 = rel - W; \
                    _Pragma("unroll") for (int r = 0; r < 16; ++r) { const int i = r >> 2, j = r & 3; const int c0 = 16 * (i >> 1) + 4 * (i & 1) + j, c1 = c0 + 32; \
                        S0[r] = (c0 <= rel && c0 >= rel2) ? S0[r] : NEGBIG; S1[r] = (c1 <= rel && c1 >= rel2) ? S1[r] : NEGBIG; } \
                } \
                float rm = fmaxf(fmaxf(S0[0], S1[0]), S0[1]); \
                _Pragma("unroll") for (int r = 1; r < 15; r += 2) { rm = fmaxf(fmaxf(rm, S1[r]), S0[r + 1]); rm = fmaxf(fmaxf(rm, S1[r + 1]), S0[r + 2 > 15 ? 15 : r + 2]); } \
                rm = fmaxf(rm, S1[15]); \
                { auto rr_ = __builtin_amdgcn_permlane32_swap(__float_as_uint(rm), __float_as_uint(rm), false, false); rm = fmaxf(__uint_as_float(rr_[0]), __uint_as_float(rr_[1])); } \
                const float dl = started ? ((rm > 8.f) ? rm : 0.f) : rm; \
                if (__builtin_amdgcn_ballot_w64(dl != 0.f) != 0ull) { \
                    mrun += dl; \
                    _Pragma("unroll") for (int r = 0; r < 16; ++r) { S0[r] -= dl; S1[r] -= dl; } \
                    if (NEGM) { _Pragma("unroll") for (int r = 0; r < 16; ++r) negm[r] = -mrun; } \
                    if (started) { fsc_ = __builtin_amdgcn_exp2f(-dl); lrun *= fsc_; resc_ = true; } \
                } \
            } } while (0)
#define ATT_X4() do { if (dopv_) { \
                const unsigned va_ = (unsigned)(size_t)(vbuf + vb_prev * VBUF + voff); \
                __builtin_amdgcn_s_setprio(1); \
                tr_block<VS, 0>(va_, va_l, va_h); \
                tr_block<VS, 1>(va_, vb_l, vb_h); \
                if (DV == 64) { TR_WAIT8(va_l, va_h); PV4(0, va_l, va_h); TR_WAIT0(vb_l, vb_h); PV4(1, vb_l, vb_h); } \
                else { TR_WAIT8(va_l, va_h); PV4(0, va_l, va_h); \
                    tr_block<VS, 2>(va_, va_l, va_h); TR_WAIT8(vb_l, vb_h); PV4(1, vb_l, vb_h); \
                    tr_block<VS, 3>(va_, vb_l, vb_h); TR_WAIT8(va_l, va_h); PV4(DV == 64 ? 0 : 2, va_l, va_h); \
                    TR_WAIT0(vb_l, vb_h); PV4(DV == 64 ? 1 : 3, vb_l, vb_h); } \
                __builtin_amdgcn_s_setprio(0); \
            } } while (0)
#define ATT_X5(S0, S1) do { if (doqk_) { \
                _Pragma("unroll") for (int r = 0; r < 16; ++r) { S0[r] = __builtin_amdgcn_exp2f(S0[r]); S1[r] = __builtin_amdgcn_exp2f(S1[r]); } \
            } } while (0)
#define ATT_STEP(t, KL, VL, KST, VST) do { \
        const bool more_ = ((t) + 1 < kt1); \
        { const int tl_ = (t) + (PF2 ? 2 : 1); ATT_LOAD((tl_ < kt1 ? tl_ : kt1 - 1), KL, VL); }     \
        __builtin_amdgcn_sched_barrier(0);     \
        const bool doqk_ = ((t) >= ta) && ((t) < tb); \
        const bool dopv_ = has_pend; \
        float fsc_ = 1.f; bool resc_ = false; \
        ATT_X2(sA0, sA1); ATT_X4(); \
        const int sl_n_ = (kb_cur == 2) ? 0 : kb_cur + 1; \
        if (grp2) { asm volatile("s_waitcnt lgkmcnt(0)" ::: "memory"); __builtin_amdgcn_s_barrier(); asm volatile("" ::: "memory"); } \
        ATT_X1(t, sA0, sA1); ATT_X3(t, sA0, sA1); ATT_X5(sA0, sA1); \
        if (resc_) { \
            _Pragma("unroll") for (int d = 0; d < DV / 32; ++d) _Pragma("unroll") for (int r = 0; r < 16; ++r) o[d][r] *= fsc_; \
        } \
        has_pend = doqk_; started = started || doqk_; \
        __builtin_amdgcn_sched_barrier(0); \
        ATT_STOREKV(sl_n_, sl_n_, KST, VST); \
        vb_prev = kb_cur; kb_cur = sl_n_; \
        if (!grp2) { asm volatile("s_waitcnt lgkmcnt(0)" ::: "memory"); __builtin_amdgcn_s_barrier(); asm volatile("" ::: "memory"); } \
    } while (0)
    const bool grp2 = SHIFT && (wid >= 4);
    for (int t = kt0; t <= kt1; t += 2) {
        if (PF2) { ATT_STEP(t, kreg0, vreg0, kreg1, vreg1); if (t + 1 <= kt1) ATT_STEP(t + 1, kreg1, vreg1, kreg0, vreg0); }
        else { ATT_STEP(t, kreg0, vreg0, kreg0, vreg0); if (t + 1 <= kt1) ATT_STEP(t + 1, kreg0, vreg0, kreg0, vreg0); }
    }
#undef ATT_STEP
#undef ATT_X1
#undef ATT_X2
#undef ATT_X3
#undef ATT_X4
#undef ATT_X5
#undef ATT_STOREKV
#undef ATT_LOAD
#undef ATT_STORE
    lrun += __shfl_xor(lrun, 32);
    m_out = mrun; l_out = lrun;
}

#define XB_TMO      128
#define XB_XCNT(j)  (256  + 64 * (j))
#define XB_XSUB(j)  (1280 + 64 * (j))
#define XB_XGEN(j)  (2304 + 64 * (j))
#define XB_TOP      3328
#define XB_TOPGEN   3392
#define XCD_BAR_WORDS 3456
#define XB_SPIN_CAP (1u << 20)
__device__ __forceinline__ unsigned xb_ld(unsigned* p)              { return __hip_atomic_load(p, __ATOMIC_RELAXED, __HIP_MEMORY_SCOPE_AGENT); }
__device__ __forceinline__ unsigned xb_add(unsigned* p, unsigned v) { return __hip_atomic_fetch_add(p, v, __ATOMIC_RELAXED, __HIP_MEMORY_SCOPE_AGENT); }
__device__ __forceinline__ unsigned xb_xcc_id() { return (unsigned)__builtin_amdgcn_s_getreg((3 << 11) | 20) & 0xFu; }
#define XB_SPIN(cond, bar) do { unsigned _sp = 0; while (cond) { __builtin_amdgcn_s_sleep(1); \
    if ((++_sp & 255u) == 0u) { if (xb_ld(&(bar)[XB_TMO])) break; if (_sp > XB_SPIN_CAP) { atomicAdd(&(bar)[XB_TMO], 1u); break; } } } } while (0)
struct XcdBarrier { unsigned* bar; unsigned x; volatile LAS unsigned* st; };
__device__ __forceinline__ XcdBarrier xcd_barrier_post(unsigned* bar, volatile LAS unsigned* st) {
    XcdBarrier b; b.bar = bar; b.x = xb_xcc_id(); b.st = st;
    if (threadIdx.x == 0) (void)xb_add(&bar[XB_XCNT(b.x)], 1u);
    return b;
}
__device__ __forceinline__ void xcd_barrier_complete(unsigned* bar, unsigned x, unsigned& nloc, unsigned& nx) {
    const unsigned G = gridDim.x * gridDim.y * gridDim.z;
    unsigned sum, cnt, mine, sp = 0u;
    for (;;) {
        sum = 0u; cnt = 0u; mine = 0u;
#pragma unroll
        for (unsigned j = 0; j < 16; ++j) { const unsigned c = xb_ld(&bar[XB_XCNT(j)]); sum += c; cnt += (c > 0u) ? 1u : 0u; mine = (j == x) ? c : mine; }
        if (sum == G) break;
        __builtin_amdgcn_s_sleep(1);
        if ((++sp & 255u) == 0u) { if (xb_ld(&bar[XB_TMO])) break; if (sp > XB_SPIN_CAP) { atomicAdd(&bar[XB_TMO], 1u); break; } }
    }
    nloc = mine > 0u ? mine : 1u; nx = cnt > 0u ? cnt : 1u;
}
__device__ __forceinline__ void xcd_barrier(const XcdBarrier& b) {
    asm volatile("s_waitcnt vmcnt(0)" ::: "memory");
    __syncthreads();
    if (threadIdx.x == 0) {
        unsigned* bar = b.bar;
        __builtin_amdgcn_s_waitcnt(0);
        unsigned nloc = b.st[0], nx = b.st[1];
        if (nloc == 0u) { xcd_barrier_complete(bar, b.x, nloc, nx); b.st[0] = nloc; b.st[1] = nx; }
        const unsigned old = xb_add(&bar[XB_XSUB(b.x)], 1u);
        const unsigned gen = old / nloc;
        if (old + 1u == (gen + 1u) * nloc) {
            __builtin_amdgcn_fence(__ATOMIC_RELEASE, "agent");
            asm volatile("s_waitcnt vmcnt(0)" ::: "memory");
            const unsigned og = xb_add(&bar[XB_TOP], 1u);
            const unsigned tg = og / nx;
            if (og + 1u == (tg + 1u) * nx) xb_add(&bar[XB_TOPGEN], 1u);
            else XB_SPIN(xb_ld(&bar[XB_TOPGEN]) == tg, bar);
            __builtin_amdgcn_fence(__ATOMIC_ACQUIRE, "agent");
            xb_add(&bar[XB_XGEN(b.x)], 1u);
            asm volatile("s_waitcnt vmcnt(0)" ::: "memory");
        } else {
            XB_SPIN(xb_ld(&bar[XB_XGEN(b.x)]) == gen, bar);
            __builtin_amdgcn_fence(__ATOMIC_ACQUIRE, "agent");
            asm volatile("s_waitcnt vmcnt(0)" ::: "memory");
        }
    }
    __syncthreads();
}

struct Args { const void* in[31]; float* out; unsigned char* ws; int ph_lo, ph_hi; };

__device__ __forceinline__ float wave_sum(float v) {
#pragma unroll
    for (int o = 1; o < 64; o <<= 1) v += __shfl_xor(v, o);
    return v;
}

__device__ __forceinline__ void transpose_items(const float* W, int K, int N, const float* gain, bf16_t* WT, int ldt, int row_off, LAS float* scr, int gw, int NGW, int lane) {
    const int nblk = N / 32, nitems = (K / 64) * nblk;
    for (int item = gw; item < nitems; item += NGW) {
        const int kb = item / nblk, nb = item % nblk, k0 = 64 * kb, n0 = 32 * nb;
        float tmp[32];
#pragma unroll
        for (int i = 0; i < 32; ++i) { const int kk = 2 * i + (lane >> 5); tmp[i] = W[(size_t)(k0 + kk) * N + n0 + (lane & 31)]; }
#pragma unroll
        for (int i = 0; i < 32; ++i) { const int kk = 2 * i + (lane >> 5); scr[kk * 33 + (lane & 31)] = tmp[i]; }
        asm volatile("s_waitcnt lgkmcnt(0)" ::: "memory");
        const int c = lane & 7;
        f32x4 g0 = {1.f, 1.f, 1.f, 1.f}, g1 = g0;
        if (gain) { g0 = *(const f32x4*)(gain + k0 + 8 * c); g1 = *(const f32x4*)(gain + k0 + 8 * c + 4); }
#pragma unroll
        for (int j = 0; j < 4; ++j) { const int n = (lane >> 3) + 8 * j; const LAS float* sp = scr + (8 * c) * 33 + n;
            u32x4 o; o.x = pk2(sp[0 * 33] * g0.x, sp[1 * 33] * g0.y); o.y = pk2(sp[2 * 33] * g0.z, sp[3 * 33] * g0.w); o.z = pk2(sp[4 * 33] * g1.x, sp[5 * 33] * g1.y); o.w = pk2(sp[6 * 33] * g1.z, sp[7 * 33] * g1.w);
            *(u32x4*)(WT + (size_t)(row_off + n0 + n) * ldt + k0 + 8 * c) = o; }
        asm volatile("s_waitcnt lgkmcnt(0)" ::: "memory");
    }
}

__global__ void __launch_bounds__(512) mk_fwd(Args args) {
    extern __shared__ __attribute__((aligned(16))) unsigned char lds_raw[];
    LAS unsigned char* lds = (LAS unsigned char*)lds_raw;
    cg::grid_group grid = cg::this_grid();
    volatile LAS unsigned* bst = (volatile LAS unsigned*)(lds + 131072 + 256);
    unsigned* barw = (unsigned*)(GAS unsigned*)(args.ws + WS_MISC + 65536);
    if (threadIdx.x < 2) bst[threadIdx.x] = 0u;
    if (blockIdx.x == 0) { for (int i = threadIdx.x; i < XCD_BAR_WORDS; i += 512) barw[i] = 0u; }
    __syncthreads();
    XcdBarrier xbar; xbar.bar = barw; xbar.x = 0; xbar.st = bst;
    bool posted = false;
    int rep = 0;
    for (int ph = args.ph_lo; ph < args.ph_hi; ++ph) {
    int tid = threadIdx.x; asm volatile("" : "+v"(tid));
    const int lane = tid & 63, wave = __builtin_amdgcn_readfirstlane(tid >> 6);
    const int G = gridDim.x, bid = blockIdx.x;
    const int gw = bid * 8 + wave, NGW = G * 8;
    const int vcu = (G % 8 == 0) ? (bid % 8) * (G / 8) + bid / 8 : bid;
    unsigned long long wsi_ = (unsigned long long)args.ws; asm volatile("" : "+s"(wsi_));
    unsigned char* ws = (unsigned char*)(GAS unsigned char*)wsi_;
    const float* x_in = TOG(const float, args.in[0]);
    float* outp = TOG(float, args.out);
    bf16_t* Wt = (bf16_t*)(ws + WS_W);
    bf16_t* XB = (bf16_t*)(ws + WS_XB);
    float* O1S = outp;
    (void)0;
    unsigned char* BIG = ws + WS_BIG;
    bf16_t* Z = (bf16_t*)(BIG + OB_Z);
    bf16_t* OA = (bf16_t*)(BIG + OB_OA);
    bf16_t* QD = (bf16_t*)(BIG + OB_QD);
    bf16_t* KVD = (bf16_t*)(BIG + OB_KVD);
    bf16_t* Hb = (bf16_t*)(BIG + OB_H);
    bf16_t* Y = (bf16_t*)(ws + WS_Y);
    bf16_t* QX = (bf16_t*)(ws + WS_Y);
    bf16_t* OX = (bf16_t*)(ws + WS_Y + 32 * MiB);
    bf16_t* KVMEM = (bf16_t*)(ws + WS_KVMEM);
    bf16_t* MN = (bf16_t*)(ws + WS_MN);
    float* SSQX = (float*)(ws + WS_SSQX);
    float* SSQZ = (float*)(ws + WS_SSQZ);
    float* RCOS = (float*)(ws + WS_ROPE);
    float* RSIN = RCOS + (size_t)T * 16;
    float* LSE = (float*)(ws + WS_LSE);
    float* MISC = (float*)(ws + WS_MISC);

        const int layer = (ph >= 14) ? 1 : 0;
        if (ph == 0 && (PHMASK & 1)) {
            LAS float* scr = (LAS float*)(lds + wave * 16384);
            const float* g_mix = TOG(const float, args.in[3]); const float* g_cross = TOG(const float, args.in[4]); const float* g_mlp = TOG(const float, args.in[9]);
            for (int l = 0; l < 2; ++l) {
                bf16_t* wl = Wt + l * LW;
                transpose_items(TOG(const float, args.in[6]) + (size_t)l * 1024 * 512, 1024, 512, g_cross + l * 1024, wl + OW_Q, 1024, 0, scr, gw, NGW, lane);
                transpose_items(TOG(const float, args.in[7]) + (size_t)l * 1024 * 1024, 1024, 1024, nullptr, wl + OW_KV, 1024, 0, scr, gw, NGW, lane);
                transpose_items(TOG(const float, args.in[8]) + (size_t)l * 512 * 1024, 512, 1024, nullptr, wl + OW_O, 512, 0, scr, gw, NGW, lane);
                transpose_items(TOG(const float, args.in[10]) + (size_t)l * 1024 * 4096, 1024, 4096, g_mlp + l * 1024, wl + OW_1, 1024, 0, scr, gw, NGW, lane);
                transpose_items(TOG(const float, args.in[11]) + (size_t)l * 4096 * 1024, 4096, 1024, nullptr, wl + OW_2, 4096, 0, scr, gw, NGW, lane);
            }
            transpose_items(TOG(const float, args.in[12]), 1024, 2560, g_mix, Wt + OW_ABIN, 1024, 0, scr, gw, NGW, lane);
            transpose_items(TOG(const float, args.in[13]), 1024, 1024, nullptr, Wt + OW_ABOUT, 1024, 0, scr, gw, NGW, lane);
            transpose_items(TOG(const float, args.in[18]), 1024, 2208, g_mix + 1024, Wt + OW_CDIN, 1024, 0, scr, gw, NGW, lane);
            transpose_items(TOG(const float, args.in[19]), 1024, 1024, nullptr, Wt + OW_CDOUT, 1024, 0, scr, gw, NGW, lane);
            transpose_items(TOG(const float, args.in[27]), 384, 768, TOG(const float, args.in[25]), Wt + OW_UQ, 384, 0, scr, gw, NGW, lane);
            transpose_items(TOG(const float, args.in[28]), 256, 512, TOG(const float, args.in[26]), Wt + OW_UKV, 256, 0, scr, gw, NGW, lane);
            transpose_items(TOG(const float, args.in[29]), 256, 512, TOG(const float, args.in[26]), Wt + OW_UKV, 256, 512, scr, gw, NGW, lane);
            { u32x4* zp = (u32x4*)(Wt + OW_CDIN + (size_t)2208 * 1024); const int n16 = 96 * 1024 * 2 / 16;
              for (int i = bid * 512 + tid; i < n16; i += G * 512) zp[i] = (u32x4){0u, 0u, 0u, 0u}; }
            for (int m = gw; m < T; m += NGW) {
                const f32x4* xr = (const f32x4*)(x_in + (size_t)m * D) + lane; float s = 0.f;
                unsigned long long* o8 = (unsigned long long*)(XB + (size_t)m * D) + lane;
#pragma unroll
                for (int j = 0; j < 4; ++j) { const f32x4 v = xr[64 * j]; s += (v.x * v.x + v.y * v.y) + (v.z * v.z + v.w * v.w);
                    o8[64 * j] = (unsigned long long)pk2(v.x, v.y) | ((unsigned long long)pk2(v.z, v.w) << 32); }
                s = wave_sum(s);
                if (lane < 16) SSQX[(size_t)m * 16 + lane] = (lane == 0) ? s : 0.f;
            }
            for (int mm = gw; mm < 2 * 1024; mm += NGW) {
                const int l = mm >> 10, m = mm & 1023;
                const f32x4* xr = (const f32x4*)(TOG(const float, args.in[1]) + (size_t)m * D) + lane; const f32x4* gr = (const f32x4*)(TOG(const float, args.in[5]) + l * D) + lane;
                f32x4 v[4]; float s = 0.f;
#pragma unroll
                for (int j = 0; j < 4; ++j) { v[j] = xr[64 * j]; s += (v[j].x * v[j].x + v[j].y * v[j].y) + (v[j].z * v[j].z + v[j].w * v[j].w); }
                const float r = 1.0f / sqrtf(wave_sum(s) * (1.f / D) + EPS);
                unsigned long long* o8 = (unsigned long long*)(MN + ((size_t)l * 1024 + m) * D) + lane;
#pragma unroll
                for (int j = 0; j < 4; ++j) { const f32x4 gg = gr[64 * j]; o8[64 * j] = (unsigned long long)pk2(v[j].x * r * gg.x, v[j].y * r * gg.y) | ((unsigned long long)pk2(v[j].z * r * gg.z, v[j].w * r * gg.w) << 32); }
            }
            for (int i = bid * 512 + tid; i < T * 16; i += G * 512) {
                const int row = i >> 4, fi = i & 15;
                const float invf = __builtin_amdgcn_exp2f(-(float)fi * 0.83048202372184058696f);
                const double rev = (double)(TOG(const int, args.in[2]))[row] * (double)invf * 0.15915494309189533577;
                const float fr = (float)(rev - rint(rev));
                RCOS[i] = __builtin_amdgcn_cosf(fr); RSIN[i] = __builtin_amdgcn_sinf(fr);
            }
            if (bid == 0 && wave == 0) {
                const float a = (TOG(const float, args.in[20]))[lane] * (TOG(const float, args.in[21]))[lane], b2 = (TOG(const float, args.in[22]))[lane] * (TOG(const float, args.in[23]))[lane];
                const float sa = wave_sum(a), sb = wave_sum(b2);
                if (lane == 0) MISC[0] = __expf(sa) - __expf(sb) + 0.35550906759097f;
            }
        }
        if ((PHMASK & 2) && (ph == 1 || ph == 5 || ph == 8 || ph == 10 || ph == 11 || ph == 14 || ph == 17)) {
            const int njobs = (ph == 1 || ph == 10 || ph == 11) ? 2 : 1;
            for (int j = 0; j < njobs; ++j) {
                pg8::Gemm g; pg8::EpiZ E;
                E.rs = SSQX; E.rs_stride = 16; E.rs_off = 0; E.rs_n4 = 4; E.rs_inv = 1.f / 1024.f; E.qs_end = 0; E.qscale = 1.f; E.act = 0; E.rope = 0; E.rope_g = -1;
                E.rcos = RCOS; E.rsin = RSIN; E.ssq = nullptr; E.ssq_stride = 0; E.rtab = (LAS float*)(lds + 131072 + 1024);
                int rot = 0;
                if (ph == 1 && j == 0) { g = pg8::Gemm{XB, Wt + OW_ABIN, T, 2560, 1024, 1024}; E.O = Z; E.ldc = 2560; E.qs_end = 512; E.qscale = 0.125f * LOG2E; }
                else if (ph == 1 || (ph == 10 && j == 1)) { const int l = (ph == 1) ? 0 : 1; g = pg8::Gemm{MN + (size_t)l * 1024 * 1024, Wt + l * LW + OW_KV, 1024, 1024, 1024, 1024}; E.O = KVMEM + (size_t)l * 1024 * 1024; E.ldc = 1024; E.rs = nullptr; rot = (ph == 1) ? 0 : 128; }
                else if (ph == 5 || ph == 14) { g = pg8::Gemm{XB, Wt + layer * LW + OW_Q, T, 512, 1024, 1024}; E.O = QX; E.ldc = 512; E.qs_end = 512; E.qscale = 0.08838834764831845f * LOG2E; }
                else if (ph == 8 || ph == 17) { g = pg8::Gemm{XB, Wt + layer * LW + OW_1, T, 4096, 1024, 1024}; E.O = Hb; E.ldc = 4096; E.act = 1; }
                else if (ph == 10) { g = pg8::Gemm{XB, Wt + OW_CDIN, T, 2304, 1024, 1024}; E.O = Z; E.ldc = 2304; E.qs_end = 512; E.qscale = 0.125f * LOG2E; E.rope = 1; E.rope_g = 68; E.ssq = SSQZ; E.ssq_stride = 72; }
                else if (ph == 11 && j == 0) { g = pg8::Gemm{Z + 1536, Wt + OW_UQ, T, 768, 384, 2304}; E.O = QD; E.ldc = 768; E.rs = SSQZ; E.rs_stride = 72; E.rs_off = 48; E.rs_n4 = 3; E.rs_inv = 1.f / 384.f;
                    E.qs_end = 768; E.qscale = 0.10206207261596577f * LOG2E; E.rope = 2; }
                else { g = pg8::Gemm{Z + 1920, Wt + OW_UKV, T, 1024, 256, 2304}; E.O = KVD; E.ldc = 1024; E.rs = SSQZ; E.rs_stride = 72; E.rs_off = 60; E.rs_n4 = 2; E.rs_inv = 1.f / 256.f; rot = 128; }
                pg8::StaticOrder S; S.init(g.M, g.N, G, (bid + rot) % G);
                pg8::gemm_phase<pg8::EpiZ>(lds, g, S, E);
            }
        }
        if ((PHMASK & 4) && (ph == 4 || ph == 7 || ph == 9 || ph == 13 || ph == 16 || ph == 18)) {
            pg8::Gemm g; pg8::EpiRes E; E.base16 = XB; E.xb = XB; E.ssq = SSQX;
            if (ph == 4) { g = pg8::Gemm{Y, Wt + OW_ABOUT, T, 1024, 1024, 1024}; }
            else if (ph == 13) { g = pg8::Gemm{Y, Wt + OW_CDOUT, T, 1024, 1024, 1024}; }
            else if (ph == 7 || ph == 16) { g = pg8::Gemm{OX, Wt + layer * LW + OW_O, T, 1024, 512, 512}; }
            else { g = pg8::Gemm{Hb, Wt + layer * LW + OW_2, T, 1024, 4096, 4096}; }
            pg8::StaticOrder S; S.init(g.M, g.N, G, bid);
            pg8::gemm_phase<pg8::EpiRes>(lds, g, S, E);
        }
        if (ph == 2 && (PHMASK & 8)) {
            const int r32 = lane & 31, hi = lane >> 5;
            for (int u = vcu; u < 3072; u += G) {
                const int gp = u >> 10, v = u & 1023, bh = v >> 5, w = v & 31, b = bh >> 3, h = bh & 7;
                const int dil = (gp == 0) ? 1 : (gp == 1) ? 4 : 16, nu = 32 / dil, res = w / nu, n = w % nu;
                const bf16_t* base = Z + ((size_t)b * SEQ + res) * 2560 + h * 64;
                const long ld = 2560L * dil;
                f32x16 o[2]; float mr, lr;
                attn_core<64, 64, 64, true, true, true, 1, false>(lds, base, ld, base + 512, ld, base + 512, ld, base + 1024, ld, 256 * n, (4 * n - 2 < 0) ? 0 : 4 * n - 2, 4 * n + 4, 128, o, mr, lr);
                const float inv = 1.0f / lr;
                const int qrow = 256 * n + wave * 32 + r32;
                const size_t tok = (size_t)b * SEQ + res + (size_t)qrow * dil;
                bf16_t* op = OA + (size_t)gp * T * 512 + tok * 512 + h * 64;
#pragma unroll
                for (int d = 0; d < 2; ++d)
#pragma unroll
                    for (int i = 0; i < 4; ++i) { u32x2 wv; wv.x = pk2(o[d][4 * i] * inv, o[d][4 * i + 1] * inv); wv.y = pk2(o[d][4 * i + 2] * inv, o[d][4 * i + 3] * inv);
                        *(u32x2*)(op + 32 * d + 8 * i + 4 * hi) = wv; }
                if (hi == 0) LSE[(size_t)gp * T * 8 + tok * 8 + h] = mr + __builtin_amdgcn_logf(lr);
            }
            const float* cw = TOG(const float, args.in[14]); const float* cb = TOG(const float, args.in[15]); const float* lg = TOG(const float, args.in[16]); const float* lb = TOG(const float, args.in[17]);
            LAS float* gl = (LAS float*)lds;
            for (int cu = bid; cu < T / 32; cu += G) {
                const int t0 = cu * 32, bstart = (t0 / SEQ) * SEQ;
                for (int e = tid; e < 62 * 64; e += 512) {
                    const int row = e >> 6, ch = e & 63, tk = t0 - 30 + row;
                    f32x4 g0 = {0.f, 0.f, 0.f, 0.f}, g1 = g0;
                    if (tk >= bstart) {
                        const u32x4 uu = *(const u32x4*)(Z + (size_t)tk * 2560 + 1536 + ch * 8), gg = *(const u32x4*)(Z + (size_t)tk * 2560 + 2048 + ch * 8);
#pragma unroll
                        for (int q = 0; q < 4; ++q) {
                            const float u0 = bf2f(uu[q] & 0xffffu), u1 = bf2f(uu[q] >> 16), a0 = bf2f(gg[q] & 0xffffu), a1 = bf2f(gg[q] >> 16);
                            const float r0 = u0 * __builtin_amdgcn_rcpf(1.f + __expf(-a0)), r1 = u1 * __builtin_amdgcn_rcpf(1.f + __expf(-a1));
                            if (q < 2) { g0[2 * q] = r0; g0[2 * q + 1] = r1; } else { g1[2 * (q - 2)] = r0; g1[2 * (q - 2) + 1] = r1; }
                        }
                    }
                    *(LAS f32x4*)(gl + row * 512 + ch * 8) = g0; *(LAS f32x4*)(gl + row * 512 + ch * 8 + 4) = g1;
                }
                __syncthreads();
                {
                    float wv[31];
#pragma unroll
                    for (int j = 0; j < 31; ++j) wv[j] = cw[j * 512 + tid];
                    const float bias = cb[tid];
                    float res[32];
#pragma unroll
                    for (int blk = 0; blk < 4; ++blk) {
                        float in[38];
#pragma unroll
                        for (int j = 0; j < 38; ++j) in[j] = gl[(blk * 8 + j) * 512 + tid];
#pragma unroll
                        for (int i = 0; i < 8; ++i) { float a = bias;
#pragma unroll
                            for (int j = 0; j < 31; ++j) a += wv[j] * in[i + j];
                            res[blk * 8 + i] = a; }
                        __builtin_amdgcn_sched_barrier(0);
                    }
#pragma unroll
                    for (int i = 0; i < 32; ++i) gl[i * 512 + tid] = res[i];
                }
                __syncthreads();
#pragma unroll
                for (int k = 0; k < 4; ++k) {
                    const int tr = wave * 4 + k;
                    const f32x4 a = *(LAS f32x4*)(gl + tr * 512 + lane * 8), c = *(LAS f32x4*)(gl + tr * 512 + lane * 8 + 4);
                    const float mu = wave_sum((a.x + a.y) + (a.z + a.w) + (c.x + c.y) + (c.z + c.w)) * (1.f / 512.f);
                    const f32x4 da = a - mu, dc = c - mu;
                    const float var = wave_sum((da.x * da.x + da.y * da.y) + (da.z * da.z + da.w * da.w) + (dc.x * dc.x + dc.y * dc.y) + (dc.z * dc.z + dc.w * dc.w)) * (1.f / 512.f);
                    const float rstd = 1.0f / sqrtf(var + EPS);
                    const f32x4 ga = *(const f32x4*)(lg + lane * 8), gc = *(const f32x4*)(lg + lane * 8 + 4), ba = *(const f32x4*)(lb + lane * 8), bc = *(const f32x4*)(lb + lane * 8 + 4);
                    f32x4 ya = da * rstd * ga + ba, yc = dc * rstd * gc + bc;
#pragma unroll
                    for (int e = 0; e < 4; ++e) { ya[e] = ya[e] * __builtin_amdgcn_rcpf(1.f + __expf(-ya[e])); yc[e] = yc[e] * __builtin_amdgcn_rcpf(1.f + __expf(-yc[e])); }
                    u32x4 wv; wv.x = pk2(ya[0], ya[1]); wv.y = pk2(ya[2], ya[3]); wv.z = pk2(yc[0], yc[1]); wv.w = pk2(yc[2], yc[3]);
                    *(u32x4*)(Y + (size_t)(t0 + tr) * 1024 + 512 + lane * 8) = wv;
                }
                __syncthreads();
            }
        }
        if (ph == 3 && (PHMASK & 16)) {
            for (size_t i = (size_t)bid * 512 + tid; i < (size_t)T * 64; i += (size_t)G * 512) {
                const size_t tok = i >> 6; const int ch = (int)(i & 63), h = ch >> 3;
                const float l0 = LSE[tok * 8 + h], l1 = LSE[(size_t)T * 8 + tok * 8 + h], l2 = LSE[(size_t)2 * T * 8 + tok * 8 + h];
                const float mx = fmaxf(l0, fmaxf(l1, l2));
                float w0 = __builtin_amdgcn_exp2f(l0 - mx), w1 = __builtin_amdgcn_exp2f(l1 - mx), w2 = __builtin_amdgcn_exp2f(l2 - mx);
                const float inv = 1.0f / (w0 + w1 + w2); w0 *= inv; w1 *= inv; w2 *= inv;
                const u32x4 a = *(const u32x4*)(OA + tok * 512 + ch * 8), b = *(const u32x4*)(OA + (size_t)T * 512 + tok * 512 + ch * 8), c = *(const u32x4*)(OA + (size_t)2 * T * 512 + tok * 512 + ch * 8);
                u32x4 r;
#pragma unroll
                for (int q = 0; q < 4; ++q) {
                    const float lo = w0 * bf2f(a[q] & 0xffffu) + w1 * bf2f(b[q] & 0xffffu) + w2 * bf2f(c[q] & 0xffffu);
                    const float hh = w0 * bf2f(a[q] >> 16) + w1 * bf2f(b[q] >> 16) + w2 * bf2f(c[q] >> 16);
                    r[q] = pk2(lo, hh);
                }
                *(u32x4*)(Y + tok * 1024 + ch * 8) = r;
            }
        }
        if ((PHMASK & 32) && (ph == 6 || ph == 15)) {
            const int r32 = lane & 31, hi = lane >> 5;
            const bf16_t* KVl = KVMEM + (size_t)layer * 1024 * 1024;
            for (int u = vcu; u < 512; u += G) {
                const int bh = u >> 5, qb = u & 31, b = bh >> 2, h = bh & 3;
                const bf16_t* qp = QX + (size_t)b * SEQ * 512 + h * 128;
                const bf16_t* kp = KVl + (size_t)b * 256 * 1024 + h * 128;
                f32x16 o[4]; float mr, lr;
                attn_core<128, 128, 128, false, false, false, 1, false>(lds, qp, 512, kp, 1024, kp, 1024, kp + 512, 1024, 256 * qb, 0, 4, 1 << 30, o, mr, lr);
                const float inv = 1.0f / lr;
                bf16_t* op = OX + ((size_t)b * SEQ + 256 * qb + wave * 32 + r32) * 512 + h * 128;
#pragma unroll
                for (int d = 0; d < 4; ++d)
#pragma unroll
                    for (int i = 0; i < 4; ++i) { u32x2 wv; wv.x = pk2(o[d][4 * i] * inv, o[d][4 * i + 1] * inv); wv.y = pk2(o[d][4 * i + 2] * inv, o[d][4 * i + 3] * inv);
                        *(u32x2*)(op + 32 * d + 8 * i + 4 * hi) = wv; }
            }
        }
        if (ph == 12 && (PHMASK & 64)) {
            const int r32 = lane & 31, hi = lane >> 5;
            const float lam = MISC[0], osc = 0.64449093240903f;
            const float* sg = TOG(const float, args.in[24]);
#ifndef NO_C
            for (int p = vcu; p < 256; p += G) {
                const int bh = p >> 4, s = p & 15, b = bh >> 2, h = bh & 3;
                for (int half = 0; half < 2; ++half) {
                    const int qb = half ? 31 - s : s;
                    const size_t row = (size_t)b * SEQ + 256 * qb + wave * 32 + r32;
                    for (int mp = 0; mp < 2; ++mp) {
                        const bf16_t* zb = Z + (size_t)b * SEQ * 2304 + h * 128;
                        f32x16 o[4]; float mr, lr;
                        attn_core<64, 64, 128, true, false, true, 1, false>(lds, zb + mp * 64, 2304, zb + 512 + mp * 64, 2304, zb, 2304, zb + 1024, 2304, 256 * qb, 0, 4 * qb + 4, 1 << 30, o, mr, lr);
                        const float inv = 1.0f / lr;
                        float* sp = O1S + row * 512 + h * 128;
                        if (mp == 0) {
#pragma unroll
                            for (int d = 0; d < 4; ++d) {
#pragma unroll
                                for (int i = 0; i < 4; ++i) *(f32x4*)(sp + 32 * d + 8 * i + 4 * hi) = (f32x4){o[d][4 * i] * inv, o[d][4 * i + 1] * inv, o[d][4 * i + 2] * inv, o[d][4 * i + 3] * inv};
                                __builtin_amdgcn_sched_barrier(0); }
                        } else {
                            float ss = 0.f;
#pragma unroll
                            for (int d = 0; d < 4; ++d) {
#pragma unroll
                                for (int i = 0; i < 4; ++i) { const f32x4 a1 = *(const f32x4*)(sp + 32 * d + 8 * i + 4 * hi);
#pragma unroll
                                    for (int e = 0; e < 4; ++e) { const float dv = a1[e] - lam * (o[d][4 * i + e] * inv); o[d][4 * i + e] = dv; ss += dv * dv; } }
                                __builtin_amdgcn_sched_barrier(0); }
                            ss += __shfl_xor(ss, 32);
                            const float rn = osc / sqrtf(ss * (1.f / 128.f) + EPS);
                            bf16_t* op = Y + row * 1024 + h * 128;
#pragma unroll
                            for (int d = 0; d < 4; ++d) {
#pragma unroll
                                for (int i = 0; i < 4; ++i) { const f32x4 gg = *(const f32x4*)(sg + 32 * d + 8 * i + 4 * hi);
                                    u32x2 wv; wv.x = pk2(o[d][4 * i] * rn * gg[0], o[d][4 * i + 1] * rn * gg[1]); wv.y = pk2(o[d][4 * i + 2] * rn * gg[2], o[d][4 * i + 3] * rn * gg[3]);
                                    *(u32x2*)(op + 32 * d + 8 * i + 4 * hi) = wv; }
                                __builtin_amdgcn_sched_barrier(0); }
                        }
                    }
                }
            }
#endif
#ifndef NO_D
            for (int p = vcu; p < 512; p += G) {
                const int bh = p >> 4, s = p & 15, b = bh >> 3, h = bh & 7;
                for (int half = 0; half < 2; ++half) {
                    const int qb = half ? 31 - s : s;
                    const size_t row = (size_t)b * SEQ + 256 * qb + wave * 32 + r32;
                    f32x16 o[2]; float mr, lr;
                    attn_core<96, 64, 64, true, true, true, 1, false>(lds, QD + (size_t)b * SEQ * 768 + h * 96, 768, KVD + (size_t)b * SEQ * 1024 + h * 64, 1024, Z + (size_t)b * SEQ * 2304 + 2176, 2304,
                                                KVD + (size_t)b * SEQ * 1024 + 512 + h * 64, 1024, 256 * qb, 0, 4 * qb + 4, 1 << 30, o, mr, lr);
                    const float inv = 1.0f / lr;
                    bf16_t* op = Y + row * 1024 + 512 + h * 64;
#pragma unroll
                    for (int d = 0; d < 2; ++d)
#pragma unroll
                        for (int i = 0; i < 4; ++i) { u32x2 wv; wv.x = pk2(o[d][4 * i] * inv, o[d][4 * i + 1] * inv); wv.y = pk2(o[d][4 * i + 2] * inv, o[d][4 * i + 3] * inv);
                            *(u32x2*)(op + 32 * d + 8 * i + 4 * hi) = wv; }
                }
            }
#endif
        }
        if (ph == 19 && (PHMASK & 128)) {
            const float* fg = TOG(const float, args.in[30]);
            for (int m = gw; m < T; m += NGW) {
                float s = (lane < 16) ? SSQX[(size_t)m * 16 + lane] : 0.f;
                s = wave_sum(s);
                const float r = 1.0f / sqrtf(s * (1.f / D) + EPS);
                const u32x2* xr = (const u32x2*)(XB + (size_t)m * D) + lane; f32x4* orow = (f32x4*)(outp + (size_t)m * D) + lane; const f32x4* gr = (const f32x4*)fg + lane;
#pragma unroll
                for (int j = 0; j < 4; ++j) { const u32x2 w = xr[64 * j]; const f32x4 gg = gr[64 * j];
                    const f32x4 v = {bf2f(w.x & 0xffffu), bf2f(w.x >> 16), bf2f(w.y & 0xffffu), bf2f(w.y >> 16)}; orow[64 * j] = v * r * gg; }
            }
        }
        if (ph + 1 < args.ph_hi) {
            if (!posted) { grid.sync(); xbar = xcd_barrier_post(barw, bst); posted = true; }
            else xcd_barrier(xbar);
        }
        if (DUPMASK != 0) { if (((DUPMASK >> ph) & 1) && !rep) { rep = 1; --ph; } else rep = 0; }
    }
}

#ifndef MK_SPLIT
#define MK_SPLIT 0
#endif
extern "C" void kernel_launch(void* const* d_in, const int* in_sizes, int n_in, void* d_out, int out_size, void* d_ws, size_t ws_size, hipStream_t stream) {
    static int grid = 0;
    if (grid == 0) {
        if (n_in != 31 || ws_size < WS_END) { fprintf(stderr, "kernel_launch: unexpected n_in %d / ws %zu\n", n_in, ws_size); grid = -1; return; }
        int dev = 0, cus = 0, per_cu = 0;
        hipGetDevice(&dev);
        hipDeviceGetAttribute(&cus, hipDeviceAttributeMultiprocessorCount, dev);
        if (hipFuncSetAttribute((const void*)mk_fwd, hipFuncAttributeMaxDynamicSharedMemorySize, LDS_BYTES) != hipSuccess) { fprintf(stderr, "kernel_launch: hipFuncSetAttribute failed\n"); }
        if (hipOccupancyMaxActiveBlocksPerMultiprocessor(&per_cu, (const void*)mk_fwd, 512, LDS_BYTES) != hipSuccess || per_cu < 1) { fprintf(stderr, "kernel_launch: occupancy query gave %d\n", per_cu); per_cu = 1; }
        (void)hipGetLastError();
        grid = cus * per_cu;
        if (grid > 256) grid = 256;
        fprintf(stderr, "kernel_launch: grid %d (cus %d per_cu %d)\n", grid, cus, per_cu);
    }
    if (grid < 0) return;
    Args a{};
    for (int i = 0; i < 31; ++i) a.in[i] = d_in[i];
    a.out = (float*)d_out; a.ws = (unsigned char*)d_ws;
#if MK_SPLIT
    for (int ph = 0; ph < 20; ++ph) { a.ph_lo = ph; a.ph_hi = ph + 1; hipLaunchKernelGGL(mk_fwd, dim3(grid), dim3(512), LDS_BYTES, stream, a); }
#else
    a.ph_lo = 0; a.ph_hi = 20;
    void* kargs[] = {&a};
    hipError_t e = hipLaunchCooperativeKernel((const void*)mk_fwd, dim3(grid), dim3(512), kargs, LDS_BYTES, stream);
    if (e != hipSuccess) fprintf(stderr, "cooperative launch failed: %s (grid %d)\n", hipGetErrorString(e), grid);
#endif
}
```
